# Optimizing an MI355X kernel written in HIP

```python
import jax, jax.numpy as jnp
from jax import lax
import numpy as np

D_MODEL = 1024
BATCH = 2
SEQ = 16384
DEPTH = 2
DEC_BATCH = 32
DEC_SEQ = 32
PAST_LEN = 2048

CHUNK = 64
PLE_DIM = 256
NORM_EPS = 1e-6

A_HEADS = 8
A_HEAD_DIM = 64
A_WIDTH = A_HEADS * A_HEAD_DIM
A_PREV_CHUNKS = 8
A_WIN = A_PREV_CHUNKS * CHUNK
A_BAND = A_WIN + CHUNK
A_REL_MAX = 256
A_REL_SIZE = CHUNK + A_REL_MAX

B_HEADS = 4
B_HEAD_DIM = 128
B_WIDTH = B_HEADS * B_HEAD_DIM
ROPE_BASE = 10000.0

C_HEADS = 8
C_HEAD_DIM = 64
C_WIDTH = C_HEADS * C_HEAD_DIM
C_RANK_W = 64
C_RANK_A = 64
C_RANK_G = 128
C_SIZES = (C_WIDTH, C_WIDTH, C_WIDTH, C_RANK_W, C_RANK_A, C_RANK_G)
C_SHIFT_WIDTH = sum(C_SIZES)
C_GN_EPS = 64e-5

N_BRANCHES = 3
BRANCH_WIDTH = 512
D_FF = ((8 * D_MODEL // 3 + 255) // 256) * 256
IN_SIZES = (A_WIDTH, A_WIDTH, A_WIDTH, B_WIDTH, B_WIDTH, B_WIDTH, B_WIDTH, C_SHIFT_WIDTH, N_BRANCHES * D_MODEL)
IN_WIDTH = sum(IN_SIZES)

kernel_name = "hybrid_streaming_encoder_step"


def _split(z, sizes):
    out, off = [], 0
    for s in sizes:
        out.append(z[..., off:off + s])
        off += s
    return out


def _rms_norm(x, gain=None):
    xf = x.astype(jnp.float32)
    y = xf * lax.rsqrt(jnp.mean(xf * xf, axis=-1, keepdims=True) + NORM_EPS)
    if gain is not None:
        y = y * gain.astype(jnp.float32)
    return y.astype(x.dtype)


def _band_attend(q, k, v, q_pos, k_pos, rel_bias):
    f32 = jnp.float32
    s = jnp.einsum("bqhd,bkhd->bhqk", q.astype(f32), k.astype(f32)) * (A_HEAD_DIM ** -0.5)
    rel = q_pos[:, None] - k_pos[None, :]
    idx = jnp.clip(rel, -(CHUNK - 1), A_REL_MAX) + (CHUNK - 1)
    s = s + rel_bias.astype(f32)[:, idx][None]
    q_chunk = q_pos // CHUNK
    k_chunk = k_pos // CHUNK
    ok = (k_pos[None, :] >= 0) & (k_chunk[None, :] <= q_chunk[:, None]) & (k_chunk[None, :] >= q_chunk[:, None] - A_PREV_CHUNKS)
    s = jnp.where(ok[None, None], s, -1e30)
    p = jax.nn.softmax(s, axis=-1)
    return jnp.einsum("bhqk,bkhd->bqhd", p, v.astype(f32)).astype(q.dtype)


def _band_attention_prompt(q, k, v, rel_bias):
    B, L, H, Dh = q.shape
    pad = jnp.zeros((B, A_WIN, H, Dh), k.dtype)
    kp = jnp.concatenate([pad, k], axis=1)
    vp = jnp.concatenate([pad, v], axis=1)

    def one_chunk(c):
        start = c * CHUNK
        q_c = lax.dynamic_slice_in_dim(q, start, CHUNK, axis=1)
        k_b = lax.dynamic_slice_in_dim(kp, start, A_BAND, axis=1)
        v_b = lax.dynamic_slice_in_dim(vp, start, A_BAND, axis=1)
        q_pos = start + jnp.arange(CHUNK, dtype=jnp.int32)
        k_pos = start - A_WIN + jnp.arange(A_BAND, dtype=jnp.int32)
        return _band_attend(q_c, k_b, v_b, q_pos, k_pos, rel_bias)

    out = lax.map(one_chunk, jnp.arange(L // CHUNK, dtype=jnp.int32))
    return jnp.moveaxis(out, 0, 1).reshape(B, L, H * Dh)


def _rotary(x, pos):
    half = x.shape[-1] // 2
    inv = ROPE_BASE ** (-jnp.arange(half, dtype=jnp.float32) / half)
    ang = pos.astype(jnp.float32)[:, None] * inv[None, :]
    cos = jnp.cos(ang)[None, :, None, :]
    sin = jnp.sin(ang)[None, :, None, :]
    x1, x2 = x[..., :half], x[..., half:]
    return jnp.concatenate([x1 * cos - x2 * sin, x1 * sin + x2 * cos], axis=-1)


def _retention_log_gamma():
    return jnp.log1p(-jnp.exp2(-5.0 - jnp.arange(B_HEADS, dtype=jnp.float32)))


def _retention_chunk(S, qkv):
    q, k, v = qkv
    L = q.shape[1]
    log_g = _retention_log_gamma()
    n = jnp.arange(L)
    diff = n[:, None] - n[None, :]
    dmat = jnp.where(diff >= 0, jnp.exp(log_g[:, None, None] * jnp.maximum(diff, 0)), 0.0)
    scores = jnp.einsum("blhd,bmhd->bhlm", q, k) * dmat[None]
    o_inner = jnp.einsum("bhlm,bmhe->blhe", scores, v)
    decay_q = jnp.exp(log_g[None, :] * (n[:, None] + 1))
    o_cross = jnp.einsum("blhd,bhde->blhe", q, S) * decay_q[None, :, :, None]
    decay_k = jnp.exp(log_g[None, :] * (L - 1 - n)[:, None])
    S_new = jnp.exp(log_g * L)[None, :, None, None] * S + jnp.einsum("blhd,blhe->bhde", k * decay_k[None, :, :, None], v)
    return S_new, o_inner + o_cross


def _retention(q, k, v, S0):
    B, L, H, _ = q.shape
    c = min(CHUNK, L)
    nc = L // c

    def to_chunks(t):
        return jnp.moveaxis(t.reshape(B, nc, c, H, t.shape[-1]), 1, 0)

    S, o = lax.scan(_retention_chunk, S0, (to_chunks(q), to_chunks(k), to_chunks(v)))
    return jnp.moveaxis(o, 0, 1).reshape(B, L, H, -1), S


def _token_shift(z, prev, mu):
    z_prev = jnp.concatenate([prev, z[:, :-1]], axis=1)
    return z + (z_prev - z) * mu


def _rwkv7_scan(r, w, k, v, kk, a, S0):
    def step(S, inp):
        r_t, w_t, k_t, v_t, kk_t, a_t = inp
        sa = jnp.einsum("bhij,bhj->bhi", S, -kk_t)
        S = S * w_t[:, :, None, :] + sa[..., None] * (kk_t * a_t)[:, :, None, :] + v_t[..., None] * k_t[:, :, None, :]
        return S, jnp.einsum("bhij,bhj->bhi", S, r_t)

    xs = tuple(jnp.moveaxis(t, 1, 0) for t in (r, w, k, v, kk, a))
    S, y = lax.scan(step, S0, xs)
    return jnp.moveaxis(y, 0, 1), S


def _rwkv7(r, k, v, w_lo, a_lo, g_lo, S0, lw):
    B, L, _ = r.shape
    f32 = jnp.float32
    w_log = -jax.nn.softplus(-(lw["c_w0"].astype(f32) + jnp.tanh(w_lo) @ lw["c_w2"].astype(f32))) - 0.5
    decay = jnp.exp(-jnp.exp(w_log))
    a = jax.nn.sigmoid(lw["c_a0"].astype(f32) + a_lo @ lw["c_a2"].astype(f32))
    g = jax.nn.sigmoid(g_lo) @ lw["c_g2"].astype(f32)

    def heads(t):
        return t.reshape(B, L, C_HEADS, C_HEAD_DIM)

    kk = heads(k * lw["c_k_k"].astype(f32))
    kk = kk / jnp.maximum(jnp.sqrt(jnp.sum(kk * kk, axis=-1, keepdims=True)), 1e-12)
    k = k * (1.0 + (a - 1.0) * lw["c_k_a"].astype(f32))
    rh, kh, vh = heads(r), heads(k), heads(v)
    y, S = _rwkv7_scan(rh, heads(decay), kh, vh, kk, heads(a), S0)
    mu = jnp.mean(y, axis=-1, keepdims=True)
    var = jnp.mean(jnp.square(y - mu), axis=-1, keepdims=True)
    yn = ((y - mu) * lax.rsqrt(var + C_GN_EPS)).reshape(B, L, C_WIDTH) * lw["c_ln_w"].astype(f32) + lw["c_ln_b"].astype(f32)
    bonus = jnp.sum(rh * kh * lw["c_r_k"].astype(f32), axis=-1, keepdims=True) * vh
    return (yn + bonus.reshape(B, L, C_WIDTH)) * g, S


def _layer(x, p_l, pos0, a_ck, a_cv, ret_s0, rwkv_s0, shift_prev, lw):
    B, L, _ = x.shape
    dt = x.dtype
    f32 = jnp.float32
    pos = pos0 + jnp.arange(L, dtype=jnp.int32)
    h = _rms_norm(x, lw["norm_mix"])
    z = h @ lw["w_in"]
    aq, ak, av, bq, bk, bv, bg, cz, gl = _split(z, IN_SIZES)

    aq = _rms_norm(aq.reshape(B, L, A_HEADS, A_HEAD_DIM), lw["a_q_norm"])
    ak = _rms_norm(ak.reshape(B, L, A_HEADS, A_HEAD_DIM), lw["a_k_norm"])
    av = av.reshape(B, L, A_HEADS, A_HEAD_DIM)
    if a_ck is None:
        oa = _band_attention_prompt(aq, ak, av, lw["a_rel_bias"])
        keep = min(A_WIN, L)
        new_ak, new_av = ak[:, L - keep:], av[:, L - keep:]
    else:
        n_c = a_ck.shape[1]
        k_all = jnp.concatenate([a_ck.astype(dt), ak], axis=1)
        v_all = jnp.concatenate([a_cv.astype(dt), av], axis=1)
        k_pos = jnp.concatenate([pos0 - n_c + jnp.arange(n_c, dtype=jnp.int32), pos])
        oa = _band_attend(aq, k_all, v_all, pos, k_pos, lw["a_rel_bias"]).reshape(B, L, A_WIDTH)
        new_ak, new_av = ak, av

    bq = _rotary(bq.reshape(B, L, B_HEADS, B_HEAD_DIM).astype(f32), pos)
    bk = _rotary(bk.reshape(B, L, B_HEADS, B_HEAD_DIM).astype(f32), pos) * (B_HEAD_DIM ** -0.5)
    bv = bv.reshape(B, L, B_HEADS, B_HEAD_DIM).astype(f32)
    ob, new_ret = _retention(bq, bk, bv, ret_s0.astype(f32))
    ob = (_rms_norm(ob).reshape(B, L, B_WIDTH) * jax.nn.silu(bg.astype(f32))).astype(dt)

    cs = _token_shift(cz, shift_prev.astype(dt), lw["c_shift_mu"])
    new_shift = cz[:, -1:]
    cr, ck, cv, cw_lo, ca_lo, cg_lo = _split(cs.astype(f32), C_SIZES)
    oc, new_rwkv = _rwkv7(cr, ck, cv, cw_lo, ca_lo, cg_lo, rwkv_s0.astype(f32), lw)
    oc = oc.astype(dt)

    gl = gl.reshape(B, L, N_BRANCHES, D_MODEL)
    wb = lw["w_branch"]
    m = (jax.nn.sigmoid(gl[:, :, 0]) * (oa @ wb[0])
         + jax.nn.sigmoid(gl[:, :, 1]) * (ob @ wb[1])
         + jax.nn.sigmoid(gl[:, :, 2]) * (oc @ wb[2]))
    x = x + m @ lw["w_out"]

    hf = _rms_norm(x, lw["norm_ffn"])
    x = x + (jax.nn.silu(hf @ lw["w_ffn_gate"]) * (hf @ lw["w_ffn_up"])) @ lw["w_ffn_down"]

    e = _rms_norm(p_l.astype(dt) @ lw["w_ple_proj"], lw["ple_norm"])
    gate = jax.nn.sigmoid(_rms_norm(x) @ lw["w_ple_gate"])
    x = x + gate * e
    return x, (new_ak, new_av, new_ret, new_rwkv, new_shift)


def setup_inputs(seed: int = 0) -> dict:
    key = jax.random.key(seed)
    keys = jax.random.split(key, 40)
    cnt = [0]
    f32 = jnp.float32

    def nk():
        cnt[0] += 1
        return keys[cnt[0] - 1]

    def nrm(shape, scale):
        return scale * jax.random.normal(nk(), shape, f32)

    def unif(shape, lo, hi):
        return jax.random.uniform(nk(), shape, f32, lo, hi)

    a_cache = min(A_WIN, PAST_LEN)
    return {
        "x_prompt": nrm((BATCH, SEQ, D_MODEL), 1.0),
        "x_sample": nrm((DEC_BATCH, DEC_SEQ, D_MODEL), 1.0),
        "p_prompt": nrm((DEPTH, BATCH, SEQ, PLE_DIM), 1.0),
        "p_sample": nrm((DEPTH, DEC_BATCH, DEC_SEQ, PLE_DIM), 1.0),
        "cache_a_k": nrm((DEPTH, DEC_BATCH, a_cache, A_HEADS, A_HEAD_DIM), 1.0),
        "cache_a_v": nrm((DEPTH, DEC_BATCH, a_cache, A_HEADS, A_HEAD_DIM), 1.0),
        "state_ret": nrm((DEPTH, DEC_BATCH, B_HEADS, B_HEAD_DIM, B_HEAD_DIM), 0.5),
        "state_rwkv": nrm((DEPTH, DEC_BATCH, C_HEADS, C_HEAD_DIM, C_HEAD_DIM), 0.5),
        "state_rwkv_shift": nrm((DEPTH, DEC_BATCH, 1, C_SHIFT_WIDTH), 1.0),
        "norm_mix": 1.0 + nrm((DEPTH, D_MODEL), 0.02),
        "w_in": nrm((DEPTH, D_MODEL, IN_WIDTH), D_MODEL ** -0.5),
        "a_q_norm": 1.0 + nrm((DEPTH, A_HEAD_DIM), 0.02),
        "a_k_norm": 1.0 + nrm((DEPTH, A_HEAD_DIM), 0.02),
        "a_rel_bias": nrm((DEPTH, A_HEADS, A_REL_SIZE), 0.1),
        "c_shift_mu": unif((DEPTH, C_SHIFT_WIDTH), 0.1, 0.9),
        "c_w0": unif((DEPTH, C_WIDTH), -6.5, -1.5),
        "c_w2": nrm((DEPTH, C_RANK_W, C_WIDTH), 0.1),
        "c_a0": nrm((DEPTH, C_WIDTH), 0.1),
        "c_a2": nrm((DEPTH, C_RANK_A, C_WIDTH), 0.1),
        "c_g2": nrm((DEPTH, C_RANK_G, C_WIDTH), C_RANK_G ** -0.5),
        "c_k_k": 0.85 + nrm((DEPTH, C_WIDTH), 0.02),
        "c_k_a": 1.0 + nrm((DEPTH, C_WIDTH), 0.02),
        "c_r_k": nrm((DEPTH, C_HEADS, C_HEAD_DIM), 0.1),
        "c_ln_w": 1.0 + nrm((DEPTH, C_WIDTH), 0.02),
        "c_ln_b": nrm((DEPTH, C_WIDTH), 0.01),
        "w_branch": nrm((DEPTH, N_BRANCHES, BRANCH_WIDTH, D_MODEL), BRANCH_WIDTH ** -0.5),
        "w_out": nrm((DEPTH, D_MODEL, D_MODEL), D_MODEL ** -0.5),
        "norm_ffn": 1.0 + nrm((DEPTH, D_MODEL), 0.02),
        "w_ffn_gate": nrm((DEPTH, D_MODEL, D_FF), D_MODEL ** -0.5),
        "w_ffn_up": nrm((DEPTH, D_MODEL, D_FF), D_MODEL ** -0.5),
        "w_ffn_down": nrm((DEPTH, D_FF, D_MODEL), D_FF ** -0.5),
        "w_ple_proj": nrm((DEPTH, PLE_DIM, D_MODEL), PLE_DIM ** -0.5),
        "ple_norm": 1.0 + nrm((DEPTH, D_MODEL), 0.02),
        "w_ple_gate": nrm((DEPTH, D_MODEL, D_MODEL), D_MODEL ** -0.5),
    }


def reference(x_prompt, x_sample, p_prompt, p_sample, cache_a_k, cache_a_v, state_ret, state_rwkv, state_rwkv_shift,
              norm_mix, w_in, a_q_norm, a_k_norm, a_rel_bias, c_shift_mu, c_w0, c_w2, c_a0, c_a2, c_g2,
              c_k_k, c_k_a, c_r_k, c_ln_w, c_ln_b, w_branch, w_out, norm_ffn, w_ffn_gate, w_ffn_up, w_ffn_down,
              w_ple_proj, ple_norm, w_ple_gate):
    def layer_weights(i):
        return dict(norm_mix=norm_mix[i], w_in=w_in[i], a_q_norm=a_q_norm[i], a_k_norm=a_k_norm[i],
                    a_rel_bias=a_rel_bias[i], c_shift_mu=c_shift_mu[i], c_w0=c_w0[i], c_w2=c_w2[i],
                    c_a0=c_a0[i], c_a2=c_a2[i], c_g2=c_g2[i], c_k_k=c_k_k[i], c_k_a=c_k_a[i], c_r_k=c_r_k[i],
                    c_ln_w=c_ln_w[i], c_ln_b=c_ln_b[i], w_branch=w_branch[i], w_out=w_out[i],
                    norm_ffn=norm_ffn[i], w_ffn_gate=w_ffn_gate[i], w_ffn_up=w_ffn_up[i],
                    w_ffn_down=w_ffn_down[i], w_ple_proj=w_ple_proj[i], ple_norm=ple_norm[i],
                    w_ple_gate=w_ple_gate[i])

    bp = x_prompt.shape[0]
    ret0 = jnp.zeros((bp, B_HEADS, B_HEAD_DIM, B_HEAD_DIM), jnp.float32)
    rwkv0 = jnp.zeros((bp, C_HEADS, C_HEAD_DIM, C_HEAD_DIM), jnp.float32)
    shift0 = jnp.zeros((bp, 1, C_SHIFT_WIDTH), x_prompt.dtype)
    y_prompt = x_prompt
    st_p = []
    for i in range(DEPTH):
        y_prompt, st = _layer(y_prompt, p_prompt[i], 0, None, None, ret0, rwkv0, shift0, layer_weights(i))
        st_p.append(st)

    y_sample = x_sample
    st_s = []
    for i in range(DEPTH):
        y_sample, st = _layer(y_sample, p_sample[i], PAST_LEN, cache_a_k[i], cache_a_v[i], state_ret[i],
                              state_rwkv[i], state_rwkv_shift[i], layer_weights(i))
        st_s.append(st)

    a_k_prompt = jnp.stack([s[0] for s in st_p])
    a_v_prompt = jnp.stack([s[1] for s in st_p])
    ret_prompt = jnp.stack([s[2] for s in st_p])
    rwkv_prompt = jnp.stack([s[3] for s in st_p])
    shift_prompt = jnp.stack([s[4] for s in st_p])
    a_k_sample = jnp.stack([s[0] for s in st_s])
    a_v_sample = jnp.stack([s[1] for s in st_s])
    ret_sample = jnp.stack([s[2] for s in st_s])
    rwkv_sample = jnp.stack([s[3] for s in st_s])
    shift_sample = jnp.stack([s[4] for s in st_s])
    return (y_prompt, y_sample, a_k_prompt, a_v_prompt, ret_prompt, rwkv_prompt, shift_prompt,
            a_k_sample, a_v_sample, ret_sample, rwkv_sample, shift_sample)
```

```cpp
#include <hip/hip_runtime.h>
#include <hip/hip_cooperative_groups.h>
#include <cstdio>
#include <cstdint>
namespace cg = cooperative_groups;


#ifndef MK_PER_PHASE
#define MK_PER_PHASE 0
#endif

#define LAS __attribute__((address_space(3)))
typedef unsigned short bf16_t;
typedef short bf16x8 __attribute__((ext_vector_type(8)));
typedef float f32x4 __attribute__((ext_vector_type(4)));
typedef unsigned u32x4 __attribute__((ext_vector_type(4)));
typedef unsigned u32x2 __attribute__((ext_vector_type(2)));

constexpr int T_ALL = 33792, T_P = 32768, SEQ = 16384, DM = 1024, ZW = 5376, FF = 2816;
constexpr int AQ = 0, AK = 512, AV = 1024, BQ = 1536, BK = 2048, BV = 2560, BG = 3072, CR = 3584, CK = 4096, CV = 4608, CLO = 5120;
constexpr float EPS = 1e-6f;
constexpr int NPH_LAYER = 16, NPHASES = 1 + 2 * NPH_LAYER;
constexpr size_t O_YP = 0, O_AKP = 34603008, O_AVP = 35651584, O_RETP = 36700160, O_RWP = 36962304, O_SHP = 37093376,
                 O_AKS = 37100544, O_AVS = 38149120, O_RETS = 39197696, O_RWS = 43392000, O_SHS = 45489152;
constexpr size_t MiB = 1u << 20;
constexpr size_t WS_W = 1 * MiB, WS_XNB = 43 * MiB, WS_LOB = 109 * MiB, WS_ZB = 126 * MiB, WS_BONUS = 473 * MiB, WS_CZB = 475 * MiB, WS_END = 477 * MiB;
constexpr size_t WS_YPHI = 478 * MiB, WS_SMID = 495 * MiB, WS_SP1 = 496 * MiB, WS_PHI = 497 * MiB, WS_END2 = 498 * MiB;
constexpr size_t WS_H = WS_ZB + 66 * MiB, WS_XB = WS_ZB + 248 * MiB;
constexpr size_t W_Z = 0, W_GL = 5505024, W_BD = 8650752, W_B = 9043968, W_O = 10616832, W_GU = 11665408, W_D = 17432576, W_P = 20316160, W_PG = 20578304;
constexpr int LDS_BYTES = 147456;

struct Params { const float* in[34]; float* out; unsigned char* ws; int ph_lo, ph_hi; };

__device__ __forceinline__ const float* ld_in(const Params& P, int i) { asm volatile("" : "+s"(i)); return P.in[i]; }
#define PIN(i) ld_in(P, i)
__device__ __forceinline__ int tid_opaque() { int t = threadIdx.x; asm volatile("" : "+v"(t)); return t; }
__device__ __forceinline__ int bid_opaque() { int b = blockIdx.x; asm volatile("" : "+s"(b)); return b; }
typedef __bf16 bf16x2v __attribute__((ext_vector_type(2)));
typedef float f32x2v __attribute__((ext_vector_type(2)));
__device__ __forceinline__ unsigned cvt_pk_bf16(float lo, float hi) { f32x2v v = {lo, hi}; bf16x2v b = __builtin_convertvector(v, bf16x2v); return __builtin_bit_cast(unsigned, b); }
__device__ __forceinline__ float bflo(unsigned w) { return __uint_as_float(w << 16); }
__device__ __forceinline__ float bfhi(unsigned w) { return __uint_as_float(w & 0xffff0000u); }
__device__ __forceinline__ float bf2f(bf16_t b) { return __uint_as_float((unsigned)b << 16); }
__device__ __forceinline__ bf16_t f2bf(float f) { return (bf16_t)(cvt_pk_bf16(f, f) & 0xffffu); }
__device__ __forceinline__ void unpack8(u32x4 w, float* f) { f[0] = bflo(w.x); f[1] = bfhi(w.x); f[2] = bflo(w.y); f[3] = bfhi(w.y); f[4] = bflo(w.z); f[5] = bfhi(w.z); f[6] = bflo(w.w); f[7] = bfhi(w.w); }
__device__ __forceinline__ u32x4 pack8(const float* f) { u32x4 w; w.x = cvt_pk_bf16(f[0], f[1]); w.y = cvt_pk_bf16(f[2], f[3]); w.z = cvt_pk_bf16(f[4], f[5]); w.w = cvt_pk_bf16(f[6], f[7]); return w; }
__device__ __forceinline__ float sigmoidf_(float x) { return __builtin_amdgcn_rcpf(1.f + __builtin_amdgcn_exp2f(-1.4426950408889634f * x)); }
__device__ __forceinline__ float wave_sum(float v) {
#pragma unroll
    for (int o = 1; o < 64; o <<= 1) v += __shfl_xor(v, o);
    return v;
}
__device__ __forceinline__ float sum8(float v) { v += __shfl_xor(v, 1); v += __shfl_xor(v, 2); v += __shfl_xor(v, 4); return v; }
template <int CTRL> __device__ __forceinline__ float dppf(float x) { return __builtin_bit_cast(float, __builtin_amdgcn_update_dpp(0, __builtin_bit_cast(int, x), CTRL, 0xf, 0xf, false)); }
__device__ __forceinline__ float red16(float x) { x += dppf<0xB1>(x); x += dppf<0x4E>(x); x += dppf<0x141>(x); x += dppf<0x140>(x); return x; }
__device__ __forceinline__ float gamma_l2(int h) { return __log2f(1.f - __builtin_amdgcn_exp2f(-5.f - (float)h)); }
#define LDSW() asm volatile("s_waitcnt lgkmcnt(0)" ::: "memory")

constexpr int BM = 256, BKT = 64, HALF = 128, HTB = HALF * BKT * 2;
__device__ __forceinline__ int lds_byte(int r, int c) { const int st = (r >> 4) * 2 + (c >> 5), rr = r & 15, cc = c & 31, ob = rr * 64 + cc * 2; return st * 1024 + (ob ^ (((ob >> 9) & 1) << 5)); }
__device__ __forceinline__ void stage_rc(int b, int& R, int& C) { const int st = b / 1024, sb = b % 1024, swz = sb ^ (((sb >> 9) & 1) << 5); R = (st >> 1) * 16 + swz / 64; C = (st & 1) * 32 + (swz % 64) / 2; }
__device__ __forceinline__ int perm32(int rho) { const int n = rho >> 4, i = rho & 15; return 8 * (i >> 2) + 4 * n + (i & 3); }

struct Unit { const char* a; const char* b; int pm, pn, aux; };
struct GemmDesc {
    const char* A; const char* B; int lda, ldb, K, nM, nN, sched, epi, perm;
    bf16_t* d0; int ldc0; bf16_t* d1; float* x; bf16_t* z;
};
__device__ __forceinline__ void tile_map(int L, int nM, int nN, int& pm, int& pn) {
    const int nwg = nM * nN; int wgid = L;
    { const int q = nwg / 8, r = nwg % 8, xcd = wgid % 8, off = wgid / 8; wgid = (xcd < r ? xcd * (q + 1) : r * (q + 1) + (xcd - r) * q) + off; }
    const int nig = 8 * nN, gid = wgid / nig, fm = gid * 8, gsz = (nM - fm) < 8 ? (nM - fm) : 8;
    pm = fm + ((wgid % nig) % gsz); pn = (wgid % nig) / gsz;
}
__device__ __forceinline__ int gl_off(int b) { return b == 0 ? 512 : (b == 1 ? 2048 : 4096); }
__device__ __forceinline__ int br_off(int b) { return b == 0 ? AQ : (b == 1 ? BQ : CR); }
__device__ __forceinline__ bool unit_next(const GemmDesc& g, int i, int G, int c, Unit& u) {
    const int nwg = g.nM * g.nN;
    if (g.sched == 0) {
        const long L = (long)i * G + c; if (L >= nwg) return false;
        tile_map((int)L, g.nM, g.nN, u.pm, u.pn); u.aux = 0;
        u.a = g.A + (size_t)u.pm * 256 * g.lda * 2; u.b = g.B + (size_t)u.pn * 256 * g.ldb * 2; return true;
    } else {
        const long L = (long)(i / 3) * G + c; if (L >= nwg) return false;
        const int b = i % 3; tile_map((int)L, g.nM, g.nN, u.pm, u.pn); u.aux = b;
        u.a = g.A + (size_t)u.pm * 256 * g.lda * 2 + br_off(b) * 2; u.b = g.B + (size_t)b * 1024 * 512 * 2 + (size_t)u.pn * 256 * g.ldb * 2; return true;
    }
}
__device__ __forceinline__ void gemm_epilogue(const GemmDesc& g, const f32x4 (&acc)[2][2][4][2], const Unit& u, int wr, int wc, int fr, int fq) {
    const int row0 = u.pm * BM + wr * 64 + fr;
    if (g.epi == 4) {
        const int col0 = u.pn * BM + wc * 32 + 4 * fq;
#pragma unroll
        for (int ai = 0; ai < 2; ++ai)
#pragma unroll
            for (int m = 0; m < 4; ++m) { const size_t ro = (size_t)(row0 + ai * HALF + m * 16) * DM + col0;
#pragma unroll
                for (int bj = 0; bj < 2; ++bj)
#pragma unroll
                    for (int n = 0; n < 2; ++n) { f32x4* p = (f32x4*)(g.x + ro + bj * HALF + n * 16); const f32x4 v = *p + acc[ai][bj][m][n]; *p = v;
                        if (g.d1) { u32x2 w; w.x = cvt_pk_bf16(v[0], v[1]); w.y = cvt_pk_bf16(v[2], v[3]); *(u32x2*)(g.d1 + ro + bj * HALF + n * 16) = w; } } }
        return;
    }
    const int cl = wc * 32 + 8 * fq;
    if (g.epi == 5) {
#pragma unroll
        for (int ai = 0; ai < 2; ++ai)
#pragma unroll
            for (int m = 0; m < 4; ++m) { const size_t ro = (size_t)(row0 + ai * HALF + m * 16) * g.ldc0 + u.pn * 128 + cl; float h[8];
#pragma unroll
                for (int n = 0; n < 2; ++n)
#pragma unroll
                    for (int e = 0; e < 4; ++e) { const float gt = acc[ai][0][m][n][e], up = acc[ai][1][m][n][e]; h[n * 4 + e] = gt * sigmoidf_(gt) * up; }
                *(u32x4*)(g.d0 + ro) = pack8(h); }
        return;
    }
    bf16_t* base = g.d0; int ldc = g.ldc0, colt = u.pn * BM; bool sg = false;
    if (g.epi == 1) { if (u.pn >= 4) { base = g.z; ldc = ZW; colt = BG + (u.pn - 4) * BM; } }
    else if (g.epi == 2) { colt = gl_off(u.pn >> 2) + (u.pn & 3) * BM; sg = true; }
    const bool gated = (g.epi == 3); const int gcol = gated ? gl_off(u.aux) : 0;
#pragma unroll
    for (int ai = 0; ai < 2; ++ai)
#pragma unroll
        for (int m = 0; m < 4; ++m) { const int row = row0 + ai * HALF + m * 16;
#pragma unroll
            for (int bj = 0; bj < 2; ++bj) { float v[8];
#pragma unroll
                for (int n = 0; n < 2; ++n)
#pragma unroll
                    for (int e = 0; e < 4; ++e) v[n * 4 + e] = acc[ai][bj][m][n][e];
                bf16_t* dp = base + (size_t)row * ldc + colt + bj * HALF + cl;
                if (sg) {
#pragma unroll
                    for (int e = 0; e < 8; ++e) v[e] = sigmoidf_(v[e]);
                }
                if (gated) { float gt[8]; unpack8(*(const u32x4*)(g.z + (size_t)row * ZW + gcol + u.pn * BM + bj * HALF + cl), gt);
#pragma unroll
                    for (int e = 0; e < 8; ++e) v[e] *= gt[e];
                    if (u.aux > 0) { float pv[8]; unpack8(*(const u32x4*)dp, pv);
#pragma unroll
                        for (int e = 0; e < 8; ++e) v[e] += pv[e]; } }
                *(u32x4*)dp = pack8(v); } }
}

__device__ __forceinline__ void gemm_phase(LAS unsigned char* lds, const GemmDesc& g) {
    const int tid = tid_opaque(), wid = __builtin_amdgcn_readfirstlane(tid >> 6), lane = tid & 63, wr = wid >> 2, wc = wid & 3, fr = lane & 15, fq = lane >> 4;
    const int G = gridDim.x, cb = bid_opaque();
    const int K = g.K, nt = K / BKT;
    unsigned voffA[2], voffB[2];
#pragma unroll
    for (int i = 0; i < 2; ++i) { int R, C; stage_rc(tid * 16 + i * 8192, R, C); const int Rb = g.perm ? ((R & ~31) + perm32(R & 31)) : R;
        voffA[i] = (unsigned)(R * g.lda + C) * 2u; voffB[i] = (unsigned)(Rb * g.ldb + C) * 2u; }
    const size_t kstep = (size_t)(BKT * 2);
    const size_t hstepA = (size_t)HALF * g.lda * 2, hstepB = (size_t)HALF * g.ldb * 2;
    const unsigned ldsw = (unsigned)wid * 1024u;
    const int aoff = lds_byte(wr * 64 + fr, fq * 8), boff = lds_byte(wc * 32 + fr, fq * 8);
#define PG8_SA(b, h) (((b) * 2 + (h)) * HTB)
#define PG8_SB(b, h) ((4 + (b) * 2 + (h)) * HTB)
#define PG8_STAGE(bufoff, gbase, voff) do { _Pragma("unroll") for (int _i = 0; _i < 2; ++_i) \
        __builtin_amdgcn_global_load_lds((const unsigned*)((const char*)(gbase) + (voff)[_i]), (LAS unsigned*)(lds + (bufoff) + ldsw + _i * 8192), 16, 0, 0); } while (0)
#define PG8_LDA(dst, b, h) do { _Pragma("unroll") for (int m = 0; m < 4; ++m) _Pragma("unroll") for (int k = 0; k < 2; ++k) dst[m][k] = *(const LAS bf16x8*)(lds + PG8_SA(b, h) + aoff + m * 2048 + k * 1024); } while (0)
#define PG8_LDB(dst, b, h) do { _Pragma("unroll") for (int n = 0; n < 2; ++n) _Pragma("unroll") for (int k = 0; k < 2; ++k) dst[n][k] = *(const LAS bf16x8*)(lds + PG8_SB(b, h) + boff + n * 2048 + k * 1024); } while (0)
#define PG8_MMA(ai, bj, At, Bt) do { __builtin_amdgcn_s_setprio(1); _Pragma("unroll") for (int m = 0; m < 4; ++m) _Pragma("unroll") for (int n = 0; n < 2; ++n) _Pragma("unroll") for (int k = 0; k < 2; ++k) \
        acc[ai][bj][m][n] = __builtin_amdgcn_mfma_f32_16x16x32_bf16(Bt[n][k], At[m][k], acc[ai][bj][m][n], 0, 0, 0); __builtin_amdgcn_s_setprio(0); } while (0)
#define PG8_WAIT_V(n) asm volatile("s_waitcnt vmcnt(" #n ")" ::: "memory")
#define PG8_WAIT_L(n) asm volatile("s_waitcnt lgkmcnt(" #n ")" ::: "memory")
#define PG8_BAR __builtin_amdgcn_s_barrier()
#define PG8_SCHED __builtin_amdgcn_sched_barrier(0)
    Unit cur, nxt; int ui = 0;
    if (!unit_next(g, 0, G, cb, cur)) return;
    f32x4 acc[2][2][4][2];
#pragma unroll
    for (int a = 0; a < 2; ++a)
#pragma unroll
        for (int b = 0; b < 2; ++b)
#pragma unroll
            for (int m = 0; m < 4; ++m)
#pragma unroll
                for (int n = 0; n < 2; ++n) acc[a][b][m][n] = (f32x4){0.f, 0.f, 0.f, 0.f};
    bf16x8 At[4][2], B0[2][2], B1[2][2];
    const char* cA = cur.a; const char* cB = cur.b;
    PG8_STAGE(PG8_SB(0, 0), cB, voffB); PG8_STAGE(PG8_SB(0, 1), cB + hstepB, voffB); PG8_STAGE(PG8_SA(0, 0), cA, voffA); PG8_STAGE(PG8_SA(0, 1), cA + hstepA, voffA);
    if (wr == 1) PG8_BAR;
    PG8_WAIT_V(2); PG8_BAR;
    PG8_STAGE(PG8_SB(1, 0), cB + kstep, voffB); PG8_STAGE(PG8_SA(1, 0), cA + kstep, voffA); PG8_STAGE(PG8_SB(1, 1), cB + hstepB + kstep, voffB);
    PG8_WAIT_V(6); PG8_BAR;
    for (;;) {
        const bool has_next = unit_next(g, ui + 1, G, cb, nxt);
        const char* nA = has_next ? nxt.a : cA; const char* nB = has_next ? nxt.b : cB;
        for (int t = 0; t < nt; t += 2) {
            const bool last = (t == nt - 2);
            const char* a1 = cA + (size_t)(t + 1) * kstep;
            const char* a2 = last ? nA : cA + (size_t)(t + 2) * kstep; const char* b2 = last ? nB : cB + (size_t)(t + 2) * kstep;
            const char* a3 = a2 + kstep; const char* b3 = b2 + kstep;
            PG8_LDB(B0, 0, 0); PG8_LDB(B1, 0, 1); PG8_SCHED; PG8_LDA(At, 0, 0); PG8_STAGE(PG8_SA(1, 1), a1 + hstepA, voffA);
            PG8_WAIT_V(8); PG8_WAIT_L(0); PG8_BAR; PG8_MMA(0, 0, At, B0); PG8_MMA(0, 1, At, B1); PG8_BAR; PG8_SCHED;
            PG8_LDA(At, 0, 1); PG8_STAGE(PG8_SB(0, 0), b2, voffB); PG8_STAGE(PG8_SB(0, 1), b2 + hstepB, voffB); PG8_STAGE(PG8_SA(0, 0), a2, voffA);
            PG8_WAIT_V(8); PG8_WAIT_L(0); PG8_BAR; PG8_MMA(1, 0, At, B0); PG8_MMA(1, 1, At, B1); PG8_BAR; PG8_SCHED;
            PG8_LDB(B0, 1, 0); PG8_LDB(B1, 1, 1); PG8_SCHED; PG8_LDA(At, 1, 0); PG8_STAGE(PG8_SA(0, 1), a2 + hstepA, voffA);
            PG8_WAIT_V(8); PG8_WAIT_L(0); PG8_BAR; PG8_MMA(0, 0, At, B0); PG8_MMA(0, 1, At, B1); PG8_BAR; PG8_SCHED;
            PG8_LDA(At, 1, 1); PG8_STAGE(PG8_SB(1, 0), b3, voffB); PG8_STAGE(PG8_SB(1, 1), b3 + hstepB, voffB); PG8_STAGE(PG8_SA(1, 0), a3, voffA);
            PG8_WAIT_V(8); PG8_WAIT_L(0); PG8_BAR; PG8_MMA(1, 0, At, B0); PG8_MMA(1, 1, At, B1); PG8_BAR; PG8_SCHED;
        }
        if (wr == 0) PG8_BAR;
        gemm_epilogue(g, acc, cur, wr, wc, fr, fq);
        if (!has_next) break;
#pragma unroll
        for (int a = 0; a < 2; ++a)
#pragma unroll
            for (int b = 0; b < 2; ++b)
#pragma unroll
                for (int m = 0; m < 4; ++m)
#pragma unroll
                    for (int n = 0; n < 2; ++n) acc[a][b][m][n] = (f32x4){0.f, 0.f, 0.f, 0.f};
        cur = nxt; cA = nA; cB = nB; ++ui;
        if (wr == 1) PG8_BAR;
    }
    PG8_WAIT_V(0);
    PG8_BAR;
}

struct MatDesc { const float* W; int ldw, col0, K, N; bf16_t* T; int ldt, koff, rowmode, rowoff; };
__device__ __forceinline__ MatDesc get_mat(const Params& P, int l, int m) {
    bf16_t* wb = (bf16_t*)(P.ws + WS_W); MatDesc d; d.col0 = 0; d.koff = 0; d.rowmode = 0; d.rowoff = 0;
    switch (m) {
    case 0: d.W = PIN(10) + (size_t)l * 1024 * 8448; d.ldw = 8448; d.K = 1024; d.N = 5376; d.T = wb + W_Z; d.ldt = 1024; break;
    case 1: d.W = PIN(10) + (size_t)l * 1024 * 8448; d.ldw = 8448; d.col0 = 5376; d.K = 1024; d.N = 3072; d.T = wb + W_GL; d.ldt = 1024; break;
    case 2: d.W = PIN(16) + (size_t)l * 64 * 512; d.ldw = 512; d.K = 64; d.N = 512; d.T = wb + W_BD; d.ldt = 256; break;
    case 3: d.W = PIN(18) + (size_t)l * 64 * 512; d.ldw = 512; d.K = 64; d.N = 512; d.T = wb + W_BD; d.ldt = 256; d.koff = 64; d.rowoff = 512; break;
    case 4: d.W = PIN(19) + (size_t)l * 128 * 512; d.ldw = 512; d.K = 128; d.N = 512; d.T = wb + W_BD; d.ldt = 256; d.koff = 128; d.rowoff = 1024; break;
    case 5: case 6: case 7: d.W = PIN(25) + (size_t)(l * 3 + (m - 5)) * 512 * 1024; d.ldw = 1024; d.K = 512; d.N = 1024; d.T = wb + W_B + (size_t)(m - 5) * 1024 * 512; d.ldt = 512; break;
    case 8: d.W = PIN(26) + (size_t)l * 1024 * 1024; d.ldw = 1024; d.K = 1024; d.N = 1024; d.T = wb + W_O; d.ldt = 1024; break;
    case 9: d.W = PIN(28) + (size_t)l * 1024 * FF; d.ldw = FF; d.K = 1024; d.N = FF; d.T = wb + W_GU; d.ldt = 1024; d.rowmode = 1; break;
    case 10: d.W = PIN(29) + (size_t)l * 1024 * FF; d.ldw = FF; d.K = 1024; d.N = FF; d.T = wb + W_GU; d.ldt = 1024; d.rowmode = 1; d.rowoff = 128; break;
    case 11: d.W = PIN(30) + (size_t)l * FF * 1024; d.ldw = 1024; d.K = FF; d.N = 1024; d.T = wb + W_D; d.ldt = FF; break;
    case 12: d.W = PIN(31) + (size_t)l * 256 * 1024; d.ldw = 1024; d.K = 256; d.N = 1024; d.T = wb + W_P; d.ldt = 256; break;
    default: d.W = PIN(33) + (size_t)l * 1024 * 1024; d.ldw = 1024; d.K = 1024; d.N = 1024; d.T = wb + W_PG; d.ldt = 1024; break;
    }
    return d;
}
__device__ __forceinline__ void convert_weights(const Params& P, int l, LAS unsigned char* lds) {
    const int tid = tid_opaque(), lane = tid & 63, wave = tid >> 6;
    LAS float* scr = (LAS float*)(lds + wave * 8704);
    const int gw = bid_opaque() * 8 + wave, NGW = gridDim.x * 8;
    for (int m = 0; m < 14; ++m) {
        const MatDesc d = get_mat(P, l, m);
        const int nblk = d.N / 32, nit = (d.K / 64) * nblk;
        for (int it = gw; it < nit; it += NGW) {
            const int kb = it / nblk, nb = it % nblk, k0 = 64 * kb, n0 = 32 * nb;
#pragma unroll 8
            for (int i = 0; i < 32; ++i) { const int kk = 2 * i + (lane >> 5); scr[kk * 33 + (lane & 31)] = d.W[(size_t)(k0 + kk) * d.ldw + d.col0 + n0 + (lane & 31)]; }
            LDSW();
            const int c = lane & 7;
#pragma unroll
            for (int j = 0; j < 4; ++j) { const int n = (lane >> 3) + 8 * j; const LAS float* s = scr + (8 * c) * 33 + n;
                u32x4 o; o.x = cvt_pk_bf16(s[0 * 33], s[1 * 33]); o.y = cvt_pk_bf16(s[2 * 33], s[3 * 33]); o.z = cvt_pk_bf16(s[4 * 33], s[5 * 33]); o.w = cvt_pk_bf16(s[6 * 33], s[7 * 33]);
                const int ng = n0 + n; const int drow = d.rowoff + (d.rowmode ? (256 * (ng >> 7) + (ng & 127)) : ng);
                *(u32x4*)(d.T + (size_t)drow * d.ldt + d.koff + k0 + 8 * c) = o; }
            LDSW();
        }
    }
    bf16_t* bd = (bf16_t*)(P.ws + WS_W) + W_BD;
    for (int e = bid_opaque() * 512 + tid; e < 1536 * 32; e += gridDim.x * 512) {
        const int row = e >> 5, k8 = (e & 31) * 8; const int blk = row >> 9;
        const bool diag = (blk == 0) ? (k8 < 64) : (blk == 1 ? (k8 >= 64 && k8 < 128) : (k8 >= 128));
        if (!diag) *(u32x4*)(bd + (size_t)row * 256 + k8) = (u32x4){0u, 0u, 0u, 0u};
    }
}

__device__ __forceinline__ void row_norm_pass(const Params& P, int l, int mode) {
    const int tid_ = tid_opaque(); const int lane = tid_ & 63, wave = tid_ >> 6;
    const int gw = bid_opaque() * 8 + wave, NGW = gridDim.x * 8;
    const float* gain = (mode == 2 ? PIN(27) : PIN(9)) + (size_t)l * DM;
    bf16_t* dst = (bf16_t*)(P.ws + (mode == 2 ? WS_ZB : WS_XNB));
    f32x4 gv[4];
#pragma unroll
    for (int j = 0; j < 4; ++j) gv[j] = *((const f32x4*)gain + lane + 64 * j);
    for (int r = gw; r < T_ALL; r += NGW) {
        const float* src = (mode == 0) ? (r < T_P ? PIN(0) + (size_t)r * DM : PIN(1) + (size_t)(r - T_P) * DM) : P.out + (size_t)r * DM;
        f32x4 v[4]; float s = 0.f;
#pragma unroll
        for (int j = 0; j < 4; ++j) { v[j] = *((const f32x4*)src + lane + 64 * j); s += v[j][0] * v[j][0] + v[j][1] * v[j][1] + v[j][2] * v[j][2] + v[j][3] * v[j][3]; }
        const float rs = rsqrtf(wave_sum(s) * (1.f / DM) + EPS);
#pragma unroll
        for (int j = 0; j < 4; ++j) {
            if (mode == 0) *((f32x4*)(P.out + (size_t)r * DM) + lane + 64 * j) = v[j];
            const f32x4 o = v[j] * rs * gv[j]; u32x2 w; w.x = cvt_pk_bf16(o[0], o[1]); w.y = cvt_pk_bf16(o[2], o[3]);
            *((u32x2*)(dst + (size_t)r * DM) + lane + 64 * j) = w; }
        if (mode == 2) {
            const float* pr = (r < T_P) ? PIN(2) + ((size_t)l * T_P + r) * 256 : PIN(3) + ((size_t)l * 1024 + (r - T_P)) * 256;
            const f32x4 pv = *((const f32x4*)pr + lane); u32x2 w; w.x = cvt_pk_bf16(pv[0], pv[1]); w.y = cvt_pk_bf16(pv[2], pv[3]);
            *((u32x2*)((bf16_t*)(P.ws + WS_LOB) + (size_t)r * 256) + lane) = w;
        }
    }
}
__device__ __forceinline__ void finish_pass(const Params& P, int l) {
    const int tid_ = tid_opaque(); const int lane = tid_ & 63, wave = tid_ >> 6;
    const int gw = bid_opaque() * 8 + wave, NGW = gridDim.x * 8;
    const float* gp = PIN(32) + (size_t)l * DM; const float* gn = PIN(9) + (size_t)(l < 1 ? l + 1 : l) * DM;
    bf16_t* GR = (bf16_t*)(P.ws + WS_ZB); bf16_t* EB = (bf16_t*)(P.ws + WS_XNB);
    for (int r = gw; r < T_ALL; r += NGW) {
        f32x4 x[4], gr[4], e[4]; float sx = 0.f, se = 0.f;
#pragma unroll
        for (int j = 0; j < 4; ++j) { x[j] = *((const f32x4*)(P.out + (size_t)r * DM) + lane + 64 * j);
            const u32x2 a = *((const u32x2*)(GR + (size_t)r * DM) + lane + 64 * j), b = *((const u32x2*)(EB + (size_t)r * DM) + lane + 64 * j);
            gr[j] = (f32x4){bflo(a.x), bfhi(a.x), bflo(a.y), bfhi(a.y)}; e[j] = (f32x4){bflo(b.x), bfhi(b.x), bflo(b.y), bfhi(b.y)};
#pragma unroll
            for (int k = 0; k < 4; ++k) { sx += x[j][k] * x[j][k]; se += e[j][k] * e[j][k]; } }
        const float rx = rsqrtf(wave_sum(sx) * (1.f / DM) + EPS), re = rsqrtf(wave_sum(se) * (1.f / DM) + EPS);
        float s2 = 0.f;
#pragma unroll
        for (int j = 0; j < 4; ++j) { const f32x4 g4 = *((const f32x4*)gp + lane + 64 * j);
#pragma unroll
            for (int k = 0; k < 4; ++k) { const float xn = x[j][k] + sigmoidf_(gr[j][k] * rx) * (e[j][k] * re * g4[k]); x[j][k] = xn; s2 += xn * xn; }
            *((f32x4*)(P.out + (size_t)r * DM) + lane + 64 * j) = x[j]; }
        if (l < 1) {
            const float r2 = rsqrtf(wave_sum(s2) * (1.f / DM) + EPS);
#pragma unroll
            for (int j = 0; j < 4; ++j) { const f32x4 g4 = *((const f32x4*)gn + lane + 64 * j); const f32x4 o = x[j] * r2 * g4; u32x2 w; w.x = cvt_pk_bf16(o[0], o[1]); w.y = cvt_pk_bf16(o[2], o[3]);
                *((u32x2*)(EB + (size_t)r * DM) + lane + 64 * j) = w; }
        }
    }
}

__device__ __forceinline__ void e1_phase(const Params& P, int l, LAS unsigned char* lds) {
    const int tid = tid_opaque(), tok = tid >> 3, sub = tid & 7, wave = tid >> 6, lane = tid & 63, fr = lane & 15, fq = lane >> 4;
    bf16_t* Z = (bf16_t*)(P.ws + WS_ZB);
    LAS bf16_t* L0 = (LAS bf16_t*)lds;
    LAS bf16_t* L1 = (LAS bf16_t*)(lds + 18432);
    for (int it = bid_opaque(); it < 528 * 7; it += gridDim.x) {
        const int tile = it / 7, job = it % 7, r0 = tile * 64, row = r0 + tok;
        const bool prompt = tile < 512; const int sr = row - T_P;
        bf16_t* zr = Z + (size_t)row * ZW;
        if (job < 2) {
            u32x4 rq[4], rk[4], rv[4];
#pragma unroll
            for (int q = 0; q < 4; ++q) { const int hc = (job * 4 + q) * 64 + sub * 8; rq[q] = *(const u32x4*)(zr + AQ + hc); rk[q] = *(const u32x4*)(zr + AK + hc); rv[q] = *(const u32x4*)(zr + AV + hc); }
            const float* gq = PIN(11) + l * 64 + sub * 8; const float* gk = PIN(12) + l * 64 + sub * 8;
#pragma unroll
            for (int q = 0; q < 4; ++q) { const int h = job * 4 + q; float f[8], o[8];
                unpack8(rq[q], f);
                float ss = 0.f;
#pragma unroll
                for (int e = 0; e < 8; ++e) ss += f[e] * f[e];
                float rs = rsqrtf(sum8(ss) * (1.f / 64.f) + EPS);
#pragma unroll
                for (int e = 0; e < 8; ++e) o[e] = f[e] * rs * gq[e];
                *(u32x4*)(zr + AQ + h * 64 + sub * 8) = pack8(o);
                unpack8(rk[q], f);
                ss = 0.f;
#pragma unroll
                for (int e = 0; e < 8; ++e) ss += f[e] * f[e];
                rs = rsqrtf(sum8(ss) * (1.f / 64.f) + EPS);
#pragma unroll
                for (int e = 0; e < 8; ++e) o[e] = f[e] * rs * gk[e];
                *(u32x4*)(zr + AK + h * 64 + sub * 8) = pack8(o);
                float vv[8]; const u32x4 vraw = rv[q]; unpack8(vraw, vv);
                float* ok = nullptr; float* ov = nullptr;
                if (prompt) { const int b = row >> 14, t = row & (SEQ - 1); if (t >= SEQ - 512) { const size_t o_ = (((size_t)(l * 2 + b) * 512 + (t - (SEQ - 512))) * 512 + h * 64 + sub * 8); ok = P.out + O_AKP + o_; ov = P.out + O_AVP + o_; } }
                else { const size_t o_ = ((size_t)(l * 1024 + sr) * 512 + h * 64 + sub * 8); ok = P.out + O_AKS + o_; ov = P.out + O_AVS + o_; }
                if (ok) { *(f32x4*)ok = (f32x4){o[0], o[1], o[2], o[3]}; *(f32x4*)(ok + 4) = (f32x4){o[4], o[5], o[6], o[7]};
                          *(f32x4*)ov = (f32x4){vv[0], vv[1], vv[2], vv[3]}; *(f32x4*)(ov + 4) = (f32x4){vv[4], vv[5], vv[6], vv[7]}; }
                if (prompt) {
#pragma unroll
                    for (int e = 0; e < 8; ++e) L0[q * 4608 + (sub * 8 + e) * 72 + tok] = ((const unsigned short*)&vraw)[e];
                } }
            if (prompt) {
                __syncthreads();
#pragma unroll
                for (int q = 0; q < 4; ++q) { const u32x4 w = *(const LAS u32x4*)(L0 + q * 4608 + tok * 72 + sub * 8);
                    *(u32x4*)(Z + (size_t)(r0 + tok) * ZW + AV + (job * 4 + q) * 64 + sub * 8) = w; }
                __syncthreads();
            }
        } else if (job < 6) {
            const int h = job - 2; const int pos = prompt ? (row & (SEQ - 1)) : (2048 + (sr & 31));
            float cs[8], sn[8];
#pragma unroll
            for (int e = 0; e < 8; ++e) { const float inv = __builtin_amdgcn_exp2f(-(float)(sub * 8 + e) * (13.287712379549449f / 64.f)); const float ang = (float)pos * inv;
                const float n = rintf(ang * 0.15915494309189535f); float rr = fmaf(-n, 6.2831855f, ang); rr = fmaf(-n, -1.7484555e-7f, rr); cs[e] = __cosf(rr); sn[e] = __sinf(rr); }
            float x1[8], x2[8], o1[8], o2[8];
            unpack8(*(const u32x4*)(zr + BQ + h * 128 + sub * 8), x1); unpack8(*(const u32x4*)(zr + BQ + h * 128 + 64 + sub * 8), x2);
#pragma unroll
            for (int e = 0; e < 8; ++e) { o1[e] = x1[e] * cs[e] - x2[e] * sn[e]; o2[e] = x1[e] * sn[e] + x2[e] * cs[e]; }
            *(u32x4*)(zr + BQ + h * 128 + sub * 8) = pack8(o1); *(u32x4*)(zr + BQ + h * 128 + 64 + sub * 8) = pack8(o2);
            unpack8(*(const u32x4*)(zr + BK + h * 128 + sub * 8), x1); unpack8(*(const u32x4*)(zr + BK + h * 128 + 64 + sub * 8), x2);
#pragma unroll
            for (int e = 0; e < 8; ++e) { o1[e] = (x1[e] * cs[e] - x2[e] * sn[e]) * 0.08838834764831845f; o2[e] = (x1[e] * sn[e] + x2[e] * cs[e]) * 0.08838834764831845f; }
            *(u32x4*)(zr + BK + h * 128 + sub * 8) = pack8(o1); *(u32x4*)(zr + BK + h * 128 + 64 + sub * 8) = pack8(o2);
            if (prompt) {
                const float dk = __builtin_amdgcn_exp2f(gamma_l2(h) * (float)(63 - tok));
                const u32x4 va = *(const u32x4*)(zr + BV + h * 128 + sub * 8), vb = *(const u32x4*)(zr + BV + h * 128 + 64 + sub * 8);
#pragma unroll
                for (int e = 0; e < 8; ++e) { L0[(sub * 8 + e) * 72 + tok] = f2bf(o1[e] * dk); L0[(64 + sub * 8 + e) * 72 + tok] = f2bf(o2[e] * dk);
                    L1[(sub * 8 + e) * 72 + tok] = ((const unsigned short*)&va)[e]; L1[(64 + sub * 8 + e) * 72 + tok] = ((const unsigned short*)&vb)[e]; }
                __syncthreads();
                const int b = row >> 14, c = (r0 & (SEQ - 1)) >> 6;
                bf16_t* St = (bf16_t*)(P.ws + WS_XNB) + ((size_t)((b * 4 + h) * 256 + c)) * 16384;
                const bf16x8 vb0 = *(const LAS bf16x8*)(L1 + (16 * wave + fr) * 72 + 8 * fq), vb1 = *(const LAS bf16x8*)(L1 + (16 * wave + fr) * 72 + 32 + 8 * fq);
#pragma unroll
                for (int dkt = 0; dkt < 8; ++dkt) {
                    const bf16x8 ka0 = *(const LAS bf16x8*)(L0 + (16 * dkt + fr) * 72 + 8 * fq), ka1 = *(const LAS bf16x8*)(L0 + (16 * dkt + fr) * 72 + 32 + 8 * fq);
                    f32x4 a = (f32x4){0.f, 0.f, 0.f, 0.f};
                    a = __builtin_amdgcn_mfma_f32_16x16x32_bf16(ka0, vb0, a, 0, 0, 0); a = __builtin_amdgcn_mfma_f32_16x16x32_bf16(ka1, vb1, a, 0, 0, 0);
                    u32x2 w; w.x = cvt_pk_bf16(a[0], a[1]); w.y = cvt_pk_bf16(a[2], a[3]);
                    *(u32x2*)(St + (size_t)(16 * wave + fr) * 128 + 16 * dkt + 4 * fq) = w;
                }
#pragma unroll
                for (int q = 0; q < 2; ++q) { const int idx = tid + q * 512, i = idx >> 4, hh = (idx >> 3) & 1, pc = idx & 7;
                    const u32x4 w = *(const LAS u32x4*)(L1 + (64 * hh + i) * 72 + pc * 8);
                    *(u32x4*)(Z + (size_t)(r0 + i) * ZW + BV + h * 128 + hh * 64 + pc * 8) = w; }
                __syncthreads();
            }
        } else {
            bool first; const float* sh = nullptr;
            if (prompt) first = (row & (SEQ - 1)) == 0; else { first = (sr & 31) == 0; sh = PIN(8) + ((size_t)l * 32 + (sr >> 5)) * 1792; }
            const float* mu = PIN(14) + (size_t)l * 1792;
            bf16_t* LO = (bf16_t*)(P.ws + WS_LOB) + (size_t)row * 256;
#pragma unroll
            for (int ch = 0; ch < 4; ++ch) { const int lc = sub * 32 + ch * 8, cp = 1536 + lc; float cur[8], prv[8], o[8];
                unpack8(*(const u32x4*)(zr + CLO + lc), cur);
                if (!first) unpack8(*(const u32x4*)(zr - ZW + CLO + lc), prv);
                else {
#pragma unroll
                    for (int e = 0; e < 8; ++e) prv[e] = sh ? sh[cp + e] : 0.f; }
#pragma unroll
                for (int e = 0; e < 8; ++e) { const float c_ = cur[e] + (prv[e] - cur[e]) * mu[cp + e];
                    o[e] = (lc < 64) ? (1.f - 2.f * __builtin_amdgcn_rcpf(__expf(2.f * c_) + 1.f)) : (lc < 128 ? c_ : sigmoidf_(c_)); }
                *(u32x4*)(LO + lc) = pack8(o); }
            bool lastt; float* so;
            if (prompt) { lastt = (row & (SEQ - 1)) == SEQ - 1; so = P.out + O_SHP + (size_t)(l * 2 + (row >> 14)) * 1792; }
            else { lastt = (sr & 31) == 31; so = P.out + O_SHS + (size_t)(l * 32 + (sr >> 5)) * 1792; }
            if (lastt) { for (int q = 0; q < 28; ++q) { const int c0 = (sub * 28 + q) * 8; float f[8]; unpack8(*(const u32x4*)(zr + CR + c0), f);
                    *(f32x4*)(so + c0) = (f32x4){f[0], f[1], f[2], f[3]}; *(f32x4*)(so + c0 + 4) = (f32x4){f[4], f[5], f[6], f[7]}; } }
            if (tid < 192) *(u32x4*)((bf16_t*)(P.ws + WS_CZB) + (size_t)tile * 1536 + tid * 8) = *(const u32x4*)(Z + (size_t)(r0 + 63) * ZW + CR + tid * 8);
        }
    }
}

__device__ __forceinline__ void p2_phase(const Params& P, int l, LAS unsigned char* lds) {
    bf16_t* Z = (bf16_t*)(P.ws + WS_ZB);
    for (int it = bid_opaque(); it < 64 + 128 + 512; it += gridDim.x) {
        const int tid = tid_opaque(), lane = tid & 63, wave = tid >> 6;
#ifdef DBG_P2_SKIP_SAMPLE
        if (it >= 64) continue;
#endif
        if (it < 64) {
            const int e4 = it * 512 + tid, chain = e4 >> 12, idx = (e4 & 4095) * 4, h = chain & 3, b = chain >> 2;
            const float g64 = __builtin_amdgcn_exp2f(gamma_l2(h) * 64.f);
            bf16_t* St = (bf16_t*)(P.ws + WS_XNB) + (size_t)chain * 256 * 16384 + idx;
            float s0 = 0.f, s1 = 0.f, s2 = 0.f, s3 = 0.f;
#pragma unroll 16
            for (int c = 0; c < 256; ++c) { const u32x2 d = *(const u32x2*)(St + (size_t)c * 16384);
                s0 = s0 * g64 + bflo(d.x); s1 = s1 * g64 + bfhi(d.x); s2 = s2 * g64 + bflo(d.y); s3 = s3 * g64 + bfhi(d.y);
                u32x2 w; w.x = cvt_pk_bf16(s0, s1); w.y = cvt_pk_bf16(s2, s3); *(u32x2*)(St + (size_t)c * 16384) = w; }
            const int dv = idx >> 7, dk = idx & 127; float* o = P.out + O_RETP + ((size_t)((l * 2 + b) * 4 + h)) * 16384 + dv;
            o[(size_t)dk * 128] = s0; o[(size_t)(dk + 1) * 128] = s1; o[(size_t)(dk + 2) * 128] = s2; o[(size_t)(dk + 3) * 128] = s3;
        } else if (it < 192) {
            const int si = it - 64, s = si >> 2, h = si & 3, rb = T_P + s * 32;
            LAS float* q = (LAS float*)lds; LAS float* k = q + 4096; LAS float* v = k + 4096; LAS float* A = v + 4096; LAS float* ob = A + 1024;
            const float lg = gamma_l2(h);
            { const int n = tid >> 4, sg = tid & 15; const bf16_t* zr = Z + (size_t)(rb + n) * ZW + h * 128 + sg * 8; float f[8];
              const u32x4 wq = *(const u32x4*)(zr + BQ), wk = *(const u32x4*)(zr + BK), wv = *(const u32x4*)(zr + BV);
              unpack8(wq, f); *(LAS f32x4*)(q + n * 128 + sg * 8) = (f32x4){f[0], f[1], f[2], f[3]}; *(LAS f32x4*)(q + n * 128 + sg * 8 + 4) = (f32x4){f[4], f[5], f[6], f[7]};
              unpack8(wk, f); *(LAS f32x4*)(k + n * 128 + sg * 8) = (f32x4){f[0], f[1], f[2], f[3]}; *(LAS f32x4*)(k + n * 128 + sg * 8 + 4) = (f32x4){f[4], f[5], f[6], f[7]};
              unpack8(wv, f); *(LAS f32x4*)(v + n * 128 + sg * 8) = (f32x4){f[0], f[1], f[2], f[3]}; *(LAS f32x4*)(v + n * 128 + sg * 8 + 4) = (f32x4){f[4], f[5], f[6], f[7]}; }
            __syncthreads();
            for (int e = tid; e < 1024; e += 512) { const int n = e >> 5, m = e & 31; float a = 0.f;
                if (m <= n) {
#pragma unroll 8
                    for (int d = 0; d < 128; d += 4) { const f32x4 q4 = *(const LAS f32x4*)(q + n * 128 + d), k4 = *(const LAS f32x4*)(k + m * 128 + d); a += q4[0] * k4[0] + q4[1] * k4[1] + q4[2] * k4[2] + q4[3] * k4[3]; }
                    a *= __builtin_amdgcn_exp2f(lg * (float)(n - m)); }
                A[e] = a; }
            __syncthreads();
            const float* S0 = PIN(6) + ((size_t)((l * 32 + s) * 4 + h)) * 16384;
            { const int e = tid & 127, ng = tid >> 7; float acc[8];
#pragma unroll
              for (int i = 0; i < 8; ++i) acc[i] = 0.f;
#pragma unroll 4
              for (int d = 0; d < 128; d += 4) { const float s0 = S0[(size_t)d * 128 + e], s1 = S0[(size_t)(d + 1) * 128 + e], s2 = S0[(size_t)(d + 2) * 128 + e], s3 = S0[(size_t)(d + 3) * 128 + e];
#pragma unroll
                  for (int i = 0; i < 8; ++i) { const f32x4 q4 = *(const LAS f32x4*)(q + (ng * 8 + i) * 128 + d); acc[i] += q4[0] * s0 + q4[1] * s1 + q4[2] * s2 + q4[3] * s3; } }
#pragma unroll
              for (int i = 0; i < 8; ++i) { const int n = ng * 8 + i; float a = acc[i] * __builtin_amdgcn_exp2f(lg * (float)(n + 1));
                  for (int m = 0; m <= n; ++m) a += A[n * 32 + m] * v[m * 128 + e];
                  ob[n * 128 + e] = a; }
              const int dg = tid >> 7; float* so = P.out + O_RETS + ((size_t)((l * 32 + s) * 4 + h)) * 16384; const float g32 = __builtin_amdgcn_exp2f(lg * 32.f);
              float vd[32];
#pragma unroll
              for (int m = 0; m < 32; ++m) vd[m] = v[m * 128 + e] * __builtin_amdgcn_exp2f(lg * (float)(31 - m));
#pragma unroll 2
              for (int d = dg * 32; d < dg * 32 + 32; d += 4) { float a0 = g32 * S0[(size_t)d * 128 + e], a1 = g32 * S0[(size_t)(d + 1) * 128 + e], a2 = g32 * S0[(size_t)(d + 2) * 128 + e], a3 = g32 * S0[(size_t)(d + 3) * 128 + e];
#pragma unroll
                  for (int m = 0; m < 32; ++m) { const f32x4 k4 = *(const LAS f32x4*)(k + m * 128 + d); a0 += k4[0] * vd[m]; a1 += k4[1] * vd[m]; a2 += k4[2] * vd[m]; a3 += k4[3] * vd[m]; }
                  so[(size_t)d * 128 + e] = a0; so[(size_t)(d + 1) * 128 + e] = a1; so[(size_t)(d + 2) * 128 + e] = a2; so[(size_t)(d + 3) * 128 + e] = a3; }
            }
            __syncthreads();
            { const int e = tid & 127, ng = tid >> 7;
              for (int i = 0; i < 8; ++i) { const int n = ng * 8 + i; float ss = 0.f;
#pragma unroll 8
                  for (int d = 0; d < 128; d += 4) { const f32x4 o4 = *(const LAS f32x4*)(ob + n * 128 + d); ss += o4[0] * o4[0] + o4[1] * o4[1] + o4[2] * o4[2] + o4[3] * o4[3]; }
                  const float rs = rsqrtf(ss * (1.f / 128.f) + EPS); bf16_t* zr = Z + (size_t)(rb + n) * ZW + h * 128 + e; const float gt = bf2f(zr[BG]);
                  zr[BQ] = f2bf(ob[n * 128 + e] * rs * gt * sigmoidf_(gt)); } }
            __syncthreads();
        } else {
            const int si = it - 192, s = si >> 4, h = (si >> 1) & 7, qh = si & 1, rb = T_P + s * 32, rq = rb + qh * 16;
            LAS float* q = (LAS float*)lds; LAS float* sc = q + 1024; LAS float* red = sc + 16 * 544;
            const float* ck = PIN(4) + ((size_t)(l * 32 + s) * 512) * 512 + h * 64; const float* cv = PIN(5) + ((size_t)(l * 32 + s) * 512) * 512 + h * 64;
            const float* bias = PIN(13) + (size_t)(l * 8 + h) * 320;
            for (int e = tid; e < 1024; e += 512) q[e] = bf2f(Z[(size_t)(rq + (e >> 6)) * ZW + AQ + h * 64 + (e & 63)]);
            __syncthreads();
            { const int key = tid; float kr[64];
#pragma unroll
                for (int d4 = 0; d4 < 16; ++d4) { const f32x4 t = *(const f32x4*)(ck + (size_t)key * 512 + d4 * 4); kr[d4 * 4] = t[0]; kr[d4 * 4 + 1] = t[1]; kr[d4 * 4 + 2] = t[2]; kr[d4 * 4 + 3] = t[3]; }
                for (int n = 0; n < 16; ++n) { float a = 0.f;
#pragma unroll
                    for (int d = 0; d < 64; ++d) a += q[n * 64 + d] * kr[d];
                    int rel = (512 + qh * 16 + n) - key; rel = rel > 256 ? 256 : rel;
                    sc[n * 544 + key] = a * 0.125f + bias[rel + 63]; } }
            { const int key = 512 + (tid & 31), n = tid >> 5; float kr[64];
#pragma unroll
                for (int d8 = 0; d8 < 8; ++d8) unpack8(*(const u32x4*)(Z + (size_t)(rb + key - 512) * ZW + AK + h * 64 + d8 * 8), kr + d8 * 8);
                float a = 0.f;
#pragma unroll
                for (int d = 0; d < 64; ++d) a += q[n * 64 + d] * kr[d];
                const int rel = (512 + qh * 16 + n) - key;
                sc[n * 544 + key] = a * 0.125f + bias[rel + 63]; }
            __syncthreads();
            for (int n = wave * 2; n < wave * 2 + 2; ++n) { float mx = -1e30f;
                for (int kx = lane; kx < 544; kx += 64) mx = fmaxf(mx, sc[n * 544 + kx]);
#pragma unroll
                for (int o = 1; o < 64; o <<= 1) mx = fmaxf(mx, __shfl_xor(mx, o));
                float sm = 0.f;
                for (int kx = lane; kx < 544; kx += 64) { const float p = __expf(sc[n * 544 + kx] - mx); sc[n * 544 + kx] = p; sm += p; }
                sm = wave_sum(sm); const float inv = 1.f / sm;
                for (int kx = lane; kx < 544; kx += 64) sc[n * 544 + kx] *= inv; }
            __syncthreads();
            { const int d = tid & 63, kg = tid >> 6; float a[16];
#pragma unroll
              for (int n = 0; n < 16; ++n) a[n] = 0.f;
              float vv[68];
#pragma unroll
              for (int i = 0; i < 68; ++i) { const int key = kg * 68 + i; vv[i] = key < 512 ? cv[(size_t)key * 512 + d] : bf2f(Z[(size_t)(rb + key - 512) * ZW + AV + h * 64 + d]); }
#pragma unroll
              for (int i = 0; i < 68; i += 4)
#pragma unroll
                  for (int n = 0; n < 16; ++n) { const f32x4 p4 = *(const LAS f32x4*)(sc + n * 544 + kg * 68 + i); a[n] += p4[0] * vv[i] + p4[1] * vv[i + 1] + p4[2] * vv[i + 2] + p4[3] * vv[i + 3]; }
#pragma unroll
              for (int n = 0; n < 16; ++n) red[(kg * 16 + n) * 64 + d] = a[n]; }
            __syncthreads();
            for (int e = tid; e < 1024; e += 512) { const int n = e >> 6, d = e & 63; float a = 0.f;
#pragma unroll
                for (int kg = 0; kg < 8; ++kg) a += red[(kg * 16 + n) * 64 + d];
                Z[(size_t)(rq + n) * ZW + AQ + h * 64 + d] = f2bf(a); }
            __syncthreads();
        }
    }
}

__device__ __forceinline__ void p3_phase(const Params& P, int l, LAS unsigned char* lds) {
    const int tid = tid_opaque(), lane = tid & 63, wave = tid >> 6, fr = lane & 15, fq = lane >> 4;
    bf16_t* Z = (bf16_t*)(P.ws + WS_ZB);
    {
        const int qs = wave & 3, dh = wave >> 2;
        LAS bf16_t* SL = (LAS bf16_t*)lds;
        LAS bf16_t* KL = (LAS bf16_t*)(lds + 34816);
        LAS bf16_t* VL = (LAS bf16_t*)(lds + 52224);
        LAS float* XL = (LAS float*)(lds + 70656);
        u32x4 gs[4], gk[2], gv[2];
#define RT_LOAD(it_) do { const int h_ = (it_) & 3, c_ = ((it_) >> 2) & 255, b_ = (it_) >> 10; const size_t cb_ = (size_t)(b_ * SEQ + c_ * 64); \
        const bf16_t* St_ = (const bf16_t*)(P.ws + WS_XNB) + ((size_t)((b_ * 4 + h_) * 256 + (c_ > 0 ? c_ - 1 : 0))) * 16384; \
        _Pragma("unroll") for (int i_ = 0; i_ < 4; ++i_) { const int p_ = tid + 512 * i_; gs[i_] = *(const u32x4*)(St_ + (p_ >> 4) * 128 + (p_ & 15) * 8); } \
        _Pragma("unroll") for (int i_ = 0; i_ < 2; ++i_) { const int p_ = tid + 512 * i_, r_ = p_ >> 4, sg_ = p_ & 15; gk[i_] = *(const u32x4*)(Z + (cb_ + r_) * ZW + BK + h_ * 128 + sg_ * 8); gv[i_] = *(const u32x4*)(Z + (cb_ + r_) * ZW + BV + h_ * 128 + sg_ * 8); } } while (0)
#define RT_WRITE() do { _Pragma("unroll") for (int i_ = 0; i_ < 4; ++i_) { const int p_ = tid + 512 * i_; *(LAS u32x4*)(SL + (p_ >> 4) * 136 + (p_ & 15) * 8) = gs[i_]; } \
        _Pragma("unroll") for (int i_ = 0; i_ < 2; ++i_) { const int p_ = tid + 512 * i_, r_ = p_ >> 4, sg_ = p_ & 15; *(LAS u32x4*)(KL + r_ * 136 + sg_ * 8) = gk[i_]; *(LAS u32x4*)(VL + ((sg_ >> 3) * 64 + r_) * 72 + (sg_ & 7) * 8) = gv[i_]; } } while (0)
        int it = bid_opaque();
        if (it < 2048) RT_LOAD(it);
        for (; it < 2048; it += gridDim.x) {
            const int h = it & 3, c = (it >> 2) & 255, b = it >> 10;
            const int cb = b * SEQ + c * 64, qrow = cb + qs * 16 + fr; const float lg = gamma_l2(h);
            bf16x8 qf[4];
#pragma unroll
            for (int kk = 0; kk < 4; ++kk) qf[kk] = *(const bf16x8*)(Z + (size_t)qrow * ZW + BQ + h * 128 + 32 * kk + 8 * fq);
            RT_WRITE();
            __syncthreads();
            if (it + (int)gridDim.x < 2048) RT_LOAD(it + (int)gridDim.x);
            f32x4 acc[4];
#pragma unroll
            for (int dt = 0; dt < 4; ++dt) acc[dt] = (f32x4){0.f, 0.f, 0.f, 0.f};
            if (c > 0) {
#pragma unroll
                for (int dt = 0; dt < 4; ++dt)
#pragma unroll
                    for (int kk = 0; kk < 4; ++kk) acc[dt] = __builtin_amdgcn_mfma_f32_16x16x32_bf16(*(const LAS bf16x8*)(SL + (16 * (4 * dh + dt) + fr) * 136 + 32 * kk + 8 * fq), qf[kk], acc[dt], 0, 0, 0);
                const float dq = __builtin_amdgcn_exp2f(lg * (float)(qs * 16 + fr + 1));
#pragma unroll
                for (int dt = 0; dt < 4; ++dt) acc[dt] = acc[dt] * dq;
            }
            const int nu = (qs >> 1) + 1;
            for (int u = 0; u < nu; ++u) {
                unsigned pw[4];
#pragma unroll
                for (int t = 0; t < 2; ++t) { f32x4 sc_ = (f32x4){0.f, 0.f, 0.f, 0.f};
#pragma unroll
                    for (int kk = 0; kk < 4; ++kk) sc_ = __builtin_amdgcn_mfma_f32_16x16x32_bf16(*(const LAS bf16x8*)(KL + (32 * u + 16 * t + fr) * 136 + 32 * kk + 8 * fq), qf[kk], sc_, 0, 0, 0);
                    float pv[4];
#pragma unroll
                    for (int j = 0; j < 4; ++j) { const int n = qs * 16 + fr, m = 32 * u + 16 * t + 4 * fq + j; pv[j] = (m <= n) ? sc_[j] * __builtin_amdgcn_exp2f(lg * (float)(n - m)) : 0.f; }
                    pw[t * 2] = cvt_pk_bf16(pv[0], pv[1]); pw[t * 2 + 1] = cvt_pk_bf16(pv[2], pv[3]); }
                u32x4 w4; w4.x = pw[0]; w4.y = pw[1]; w4.z = pw[2]; w4.w = pw[3]; const bf16x8 pf = __builtin_bit_cast(bf16x8, w4);
#pragma unroll
                for (int dt = 0; dt < 4; ++dt) { const LAS bf16_t* vp = VL + (16 * (4 * dh + dt) + fr) * 72 + 32 * u + 4 * fq;
                    const u32x2 v0 = *(const LAS u32x2*)vp, v1 = *(const LAS u32x2*)(vp + 16); u32x4 w; w.x = v0.x; w.y = v0.y; w.z = v1.x; w.w = v1.y;
                    acc[dt] = __builtin_amdgcn_mfma_f32_16x16x32_bf16(__builtin_bit_cast(bf16x8, w), pf, acc[dt], 0, 0, 0); }
            }
            float ss = 0.f;
#pragma unroll
            for (int dt = 0; dt < 4; ++dt) ss += acc[dt][0] * acc[dt][0] + acc[dt][1] * acc[dt][1] + acc[dt][2] * acc[dt][2] + acc[dt][3] * acc[dt][3];
            ss += __shfl_xor(ss, 16); ss += __shfl_xor(ss, 32);
            if (fq == 0) XL[(qs * 2 + dh) * 16 + fr] = ss;
            __syncthreads();
            const float rs = rsqrtf((XL[(qs * 2) * 16 + fr] + XL[(qs * 2 + 1) * 16 + fr]) * (1.f / 128.f) + EPS);
#pragma unroll
            for (int dt = 0; dt < 4; ++dt) { const int dvc = 16 * (4 * dh + dt) + 4 * fq; const u32x2 gw = *(const u32x2*)(Z + (size_t)qrow * ZW + BG + h * 128 + dvc);
                const float g0 = bflo(gw.x), g1 = bfhi(gw.x), g2 = bflo(gw.y), g3 = bfhi(gw.y); u32x2 w;
                w.x = cvt_pk_bf16(acc[dt][0] * rs * g0 * sigmoidf_(g0), acc[dt][1] * rs * g1 * sigmoidf_(g1)); w.y = cvt_pk_bf16(acc[dt][2] * rs * g2 * sigmoidf_(g2), acc[dt][3] * rs * g3 * sigmoidf_(g3));
                *(u32x2*)(Z + (size_t)qrow * ZW + BQ + h * 128 + dvc) = w; }
        }
        __syncthreads();
    }
}

__device__ __forceinline__ void attn_item(const Params& P, int l, LAS unsigned char* lds, int it, int tid) {
    const int lane = tid & 63, wave = tid >> 6, fr = lane & 15, fq = lane >> 4;
    bf16_t* Z = (bf16_t*)(P.ws + WS_ZB);
    {

            const int ia = it - 1024, hp = ia & 3, c = (ia >> 2) & 255, b = ia >> 10, hsel = wave >> 2, h = hp * 2 + hsel, qs = wave & 3;
            const int sb = b * SEQ, qpos = c * 64 + qs * 16 + fr; const size_t qrow = (size_t)(sb + qpos);
            LAS bf16_t* KS = (LAS bf16_t*)lds;
            LAS bf16_t* VS = (LAS bf16_t*)(lds + 36864);
            LAS float* BL = (LAS float*)(lds + 73728);
            const bf16x8 q0 = *(const bf16x8*)(Z + qrow * ZW + AQ + h * 64 + 8 * fq), q1 = *(const bf16x8*)(Z + qrow * ZW + AQ + h * 64 + 32 + 8 * fq);
            f32x4 acc[4];
#pragma unroll
            for (int dt = 0; dt < 4; ++dt) acc[dt] = (f32x4){0.f, 0.f, 0.f, 0.f};
            float mrun = -1e30f, lrun = 0.f;
            const int jlo = c >= 8 ? 0 : 8 - c;
            u32x4 gk[2], gv[2];
#define AT_LOAD(j_) do { const size_t rb_ = (size_t)(sb + (c - 8 + (j_)) * 64); _Pragma("unroll") for (int i_ = 0; i_ < 2; ++i_) { const int p_ = tid + 512 * i_, hd_ = p_ >> 9, r_ = (p_ >> 3) & 63, sg_ = p_ & 7; \
        gk[i_] = *(const u32x4*)(Z + (rb_ + r_) * ZW + AK + (hp * 2 + hd_) * 64 + sg_ * 8); gv[i_] = *(const u32x4*)(Z + (rb_ + r_) * ZW + AV + (hp * 2 + hd_) * 64 + sg_ * 8); } } while (0)
#define AT_WRITE(st_) do { _Pragma("unroll") for (int i_ = 0; i_ < 2; ++i_) { const int p_ = tid + 512 * i_, hd_ = p_ >> 9, r_ = (p_ >> 3) & 63, sg_ = p_ & 7; \
        *(LAS u32x4*)(KS + ((st_) * 2 + hd_) * 4608 + r_ * 72 + sg_ * 8) = gk[i_]; *(LAS u32x4*)(VS + ((st_) * 2 + hd_) * 4608 + r_ * 72 + sg_ * 8) = gv[i_]; } } while (0)
            AT_LOAD(jlo);
            for (int e = tid; e < 640; e += 512) BL[e] = PIN(13)[(size_t)(l * 8 + hp * 2) * 320 + e] * 1.4426950408889634f;
            AT_WRITE(0);
            __syncthreads();
            for (int j = jlo; j < 9; ++j) {
                const int st = (j - jlo) & 1;
                if (j < 8) AT_LOAD(j + 1);
                const LAS bf16_t* ks = KS + (st * 2 + hsel) * 4608; const LAS bf16_t* vs = VS + (st * 2 + hsel) * 4608; const LAS float* bl = BL + hsel * 320;
#pragma unroll
                for (int u = 0; u < 2; ++u) {
                    const int kb = (c - 8 + j) * 64 + 32 * u;
                    float sv[8];
#pragma unroll
                    for (int t = 0; t < 2; ++t) { const LAS bf16_t* kp = ks + (32 * u + 16 * t + fr) * 72 + 8 * fq;
                        f32x4 sc_ = (f32x4){0.f, 0.f, 0.f, 0.f};
                        sc_ = __builtin_amdgcn_mfma_f32_16x16x32_bf16(*(const LAS bf16x8*)kp, q0, sc_, 0, 0, 0); sc_ = __builtin_amdgcn_mfma_f32_16x16x32_bf16(*(const LAS bf16x8*)(kp + 32), q1, sc_, 0, 0, 0);
                        if (j <= 3) {
                            const float bc = bl[319];
#pragma unroll
                            for (int jj = 0; jj < 4; ++jj) sv[t * 4 + jj] = sc_[jj] * 0.18033688011112042f + bc;
                        } else {
#pragma unroll
                            for (int jj = 0; jj < 4; ++jj) { int rel = qpos - (kb + 16 * t + 4 * fq + jj); rel = rel > 256 ? 256 : rel; sv[t * 4 + jj] = sc_[jj] * 0.18033688011112042f + bl[rel + 63]; }
                        } }
                    float mx = sv[0];
#pragma unroll
                    for (int e = 1; e < 8; ++e) mx = fmaxf(mx, sv[e]);
                    mx = fmaxf(mx, __shfl_xor(mx, 16)); mx = fmaxf(mx, __shfl_xor(mx, 32));
                    const float mnew = fmaxf(mrun, mx), alpha = __builtin_amdgcn_exp2f(mrun - mnew); mrun = mnew;
                    float ps = 0.f;
#pragma unroll
                    for (int e = 0; e < 8; ++e) { sv[e] = __builtin_amdgcn_exp2f(sv[e] - mnew); ps += sv[e]; }
                    lrun = lrun * alpha + ps;
                    u32x4 pw; pw.x = cvt_pk_bf16(sv[0], sv[1]); pw.y = cvt_pk_bf16(sv[2], sv[3]); pw.z = cvt_pk_bf16(sv[4], sv[5]); pw.w = cvt_pk_bf16(sv[6], sv[7]);
                    const bf16x8 pf = __builtin_bit_cast(bf16x8, pw);
#pragma unroll
                    for (int dt = 0; dt < 4; ++dt) { const LAS bf16_t* vp = vs + (16 * dt + fr) * 72 + 32 * u + 4 * fq;
                        const u32x2 v0 = *(const LAS u32x2*)vp, v1 = *(const LAS u32x2*)(vp + 16); u32x4 w; w.x = v0.x; w.y = v0.y; w.z = v1.x; w.w = v1.y;
                        acc[dt] = acc[dt] * alpha;
                        acc[dt] = __builtin_amdgcn_mfma_f32_16x16x32_bf16(__builtin_bit_cast(bf16x8, w), pf, acc[dt], 0, 0, 0); }
                }
                if (j < 8) AT_WRITE(st ^ 1);
                __syncthreads();
            }
            lrun += __shfl_xor(lrun, 16); lrun += __shfl_xor(lrun, 32);
            const float inv = 1.f / lrun;
#pragma unroll
            for (int dt = 0; dt < 4; ++dt) { u32x2 w; w.x = cvt_pk_bf16(acc[dt][0] * inv, acc[dt][1] * inv); w.y = cvt_pk_bf16(acc[dt][2] * inv, acc[dt][3] * inv);
                *(u32x2*)(Z + qrow * ZW + AQ + h * 64 + 16 * dt + 4 * fq) = w; }
    }
}

__device__ __forceinline__ void c2_phase(const Params& P, int l, LAS unsigned char* lds) {
    const int tid = tid_opaque(), tok = tid >> 3, sub = tid & 7;
    bf16_t* Z = (bf16_t*)(P.ws + WS_ZB); bf16_t* XW = (bf16_t*)(P.ws + WS_XNB);
    (void)lds;
    for (int it = bid_opaque(); it < 528 * 4; it += gridDim.x) {
        const int tile = it >> 2, hp = it & 3, r0 = tile * 64, row = r0 + tok; const bool prompt = tile < 512; const int sr = row - T_P;
        const bool sfirst = !prompt && (sr & 31) == 0; const float* sh = sfirst ? PIN(8) + ((size_t)l * 32 + (sr >> 5)) * 1792 : nullptr;
        const bool pzero = prompt && tok == 0 && (r0 & (SEQ - 1)) == 0;
        const bf16_t* prow = (tok > 0) ? Z + (size_t)(row - 1) * ZW + CR : (const bf16_t*)(P.ws + WS_CZB) + (size_t)(tile > 0 ? tile - 1 : 0) * 1536;
        u32x4 cu[2][3], pv_[2][3], wa[2][2];
#pragma unroll
        for (int q = 0; q < 2; ++q) { const int hc = (hp * 2 + q) * 64 + sub * 8;
#pragma unroll
            for (int part = 0; part < 3; ++part) { cu[q][part] = *(const u32x4*)(Z + (size_t)row * ZW + CR + part * 512 + hc); pv_[q][part] = *(const u32x4*)(prow + part * 512 + hc); }
            wa[q][0] = *(const u32x4*)(XW + (size_t)row * DM + hc); wa[q][1] = *(const u32x4*)(XW + (size_t)row * DM + 512 + hc); }
        asm volatile("s_waitcnt vmcnt(0)" ::: "memory");
        __syncthreads();
        const float* mu = PIN(14) + (size_t)l * 1792;
#pragma unroll
        for (int q = 0; q < 2; ++q) { const int h = hp * 2 + q, hc = h * 64 + sub * 8;
            float r[8], k[8], v[8], wr_[8], ar_[8], kk[8], pr[8], pk[8], pvv[8];
            unpack8(cu[q][0], r); unpack8(cu[q][1], k); unpack8(cu[q][2], v); unpack8(pv_[q][0], pr); unpack8(pv_[q][1], pk); unpack8(pv_[q][2], pvv); unpack8(wa[q][0], wr_); unpack8(wa[q][1], ar_);
#pragma unroll
            for (int e = 0; e < 8; ++e) { float a_ = pr[e], b_ = pk[e], c_ = pvv[e];
                if (sfirst) { a_ = sh[hc + e]; b_ = sh[512 + hc + e]; c_ = sh[1024 + hc + e]; } else if (pzero) { a_ = 0.f; b_ = 0.f; c_ = 0.f; }
                r[e] = r[e] + (a_ - r[e]) * mu[hc + e]; k[e] = k[e] + (b_ - k[e]) * mu[512 + hc + e]; v[e] = v[e] + (c_ - v[e]) * mu[1024 + hc + e]; }
            const float* w0 = PIN(15) + l * 512 + hc; const float* a0 = PIN(17) + l * 512 + hc; const float* kkw = PIN(20) + l * 512 + hc; const float* kaw = PIN(21) + l * 512 + hc; const float* rk = PIN(22) + l * 512 + hc;
            float ss = 0.f, bn = 0.f;
#pragma unroll
            for (int e = 0; e < 8; ++e) { kk[e] = k[e] * kkw[e]; ss += kk[e] * kk[e]; }
            const float rn = rsqrtf(fmaxf(sum8(ss), 1e-24f));
#pragma unroll
            for (int e = 0; e < 8; ++e) { const float a = sigmoidf_(a0[e] + ar_[e]); const float ew = 0.6065306597126334f * sigmoidf_(w0[e] + wr_[e]);
                kk[e] *= rn; k[e] = k[e] * (1.f + (a - 1.f) * kaw[e]); bn += r[e] * k[e] * rk[e]; wr_[e] = ew; ar_[e] = kk[e] * a; }
            bn = sum8(bn);
            *(u32x4*)(Z + (size_t)row * ZW + CR + hc) = pack8(r); *(u32x4*)(Z + (size_t)row * ZW + CK + hc) = pack8(k); *(u32x4*)(Z + (size_t)row * ZW + CV + hc) = pack8(v);
            *(u32x4*)(Z + (size_t)row * ZW + BV + hc) = pack8(kk); *(u32x4*)(XW + (size_t)row * DM + hc) = pack8(wr_); *(u32x4*)(XW + (size_t)row * DM + 512 + hc) = pack8(ar_);
            if (sub == 0) ((float*)(P.ws + WS_BONUS))[(size_t)row * 8 + h] = bn; }
        __syncthreads();
    }
}

__device__ __forceinline__ void scan_phase(const Params& P, int l, LAS unsigned char* lds) {
    const int tid = tid_opaque(), lane = tid & 63, wave = tid >> 6;
    bf16_t* Z = (bf16_t*)(P.ws + WS_ZB); const bf16_t* XW = (const bf16_t*)(P.ws + WS_XNB);
    LAS float* buf = (LAS float*)lds;
    LAS float* ybuf = (LAS float*)(lds + 86016);
    const int bid_ = bid_opaque(), nidle_ = (int)gridDim.x > 192 ? (int)gridDim.x - 192 : 0;
    for (int it = (bid_ < 192 || nidle_ == 0) ? bid_ : 192 + (bid_ - 192); it < 192 + 1024; it += (bid_ < 192 ? (nidle_ ? 100000 : (int)gridDim.x) : nidle_)) {
        int rowbase, nsteps, h, qt, part = 0; const float* S0 = nullptr; float* So; bf16_t* yout; size_t ypitch = ZW;
        if (it < 192) { const int itx = ((it & 7) * 2 + (it >> 3) / 12) * 12 + (it >> 3) % 12;
            const int chain = itx / 12, sub12 = itx % 12, b = chain >> 3; h = chain & 7; part = sub12 >> 2; qt = sub12 & 3; nsteps = SEQ / 2; rowbase = b * SEQ + (part ? SEQ / 2 : 0);
            So = (float*)(P.ws + (part == 0 ? WS_SMID : (part == 1 ? WS_SP1 : WS_PHI))) + (size_t)chain * 4096;
            if (part < 2) yout = Z + (size_t)rowbase * ZW + BK + h * 64 + qt * 16; else { yout = (bf16_t*)(P.ws + WS_YPHI) + (size_t)b * (SEQ / 2) * 512 + h * 64 + qt * 16; ypitch = 512; } }
        else { const int si = it - 192, s = si >> 5; h = (si >> 2) & 7; qt = si & 3; rowbase = T_P + s * 32; nsteps = 32; S0 = PIN(7) + ((size_t)((l * 32 + s) * 8 + h)) * 4096; So = P.out + O_RWS + ((size_t)((l * 32 + s) * 8 + h)) * 4096;
            yout = Z + (size_t)rowbase * ZW + BK + h * 64 + qt * 16; }
        const int i0 = qt * 16, nb = nsteps >> 5;
        const int lt = tid - 256, lstep = lt >> 3, lsub = lt & 7;
        const int rr = lane >> 4, jl = lane & 15, li = 4 * wave + rr;
        f32x2v Sa = {0.f, 0.f}, Sb = {0.f, 0.f};
        u32x4 g_ew = {0u,0u,0u,0u}, g_k = g_ew, g_kk = g_ew, g_ka = g_ew, g_r = g_ew, g_v = g_ew;
        if (wave < 4 && S0) { const f32x4 s4 = *(const f32x4*)(S0 + (size_t)(i0 + li) * 64 + 4 * jl); Sa = (f32x2v){s4[0], s4[1]}; Sb = (f32x2v){s4[2], s4[3]}; }
        if (part == 2) { const int d_ = i0 + li - 4 * jl; Sa = (f32x2v){d_ == 0 ? 1.f : 0.f, d_ == 1 ? 1.f : 0.f}; Sb = (f32x2v){d_ == 2 ? 1.f : 0.f, d_ == 3 ? 1.f : 0.f}; }
        for (int bb = -1; bb < nb; ++bb) {
            if (wave >= 4) {
#define SC_LOAD(bt) do { const size_t row_ = (size_t)(rowbase + (bt) * 32 + lstep); g_ew = *(const u32x4*)(XW + row_ * DM + h * 64 + lsub * 8); g_k = *(const u32x4*)(Z + row_ * ZW + CK + h * 64 + lsub * 8); \
        g_kk = *(const u32x4*)(Z + row_ * ZW + BV + h * 64 + lsub * 8); g_ka = *(const u32x4*)(XW + row_ * DM + 512 + h * 64 + lsub * 8); g_r = *(const u32x4*)(Z + row_ * ZW + CR + h * 64 + lsub * 8); \
        if (lsub < 2 && part != 2) g_v = *(const u32x4*)(Z + row_ * ZW + CV + h * 64 + i0 + lsub * 8); } while (0)
#define SC_WRITE(bt) do { LAS float* d = buf + ((bt) & 1) * 10752 + lstep * 336; float f[8]; unpack8(g_ew, f); \
        *(LAS f32x4*)(d + lsub * 8) = (f32x4){__expf(-f[0]), __expf(-f[1]), __expf(-f[2]), __expf(-f[3])}; *(LAS f32x4*)(d + lsub * 8 + 4) = (f32x4){__expf(-f[4]), __expf(-f[5]), __expf(-f[6]), __expf(-f[7])}; \
        unpack8(g_k, f); *(LAS f32x4*)(d + 64 + lsub * 8) = (f32x4){f[0], f[1], f[2], f[3]}; *(LAS f32x4*)(d + 64 + lsub * 8 + 4) = (f32x4){f[4], f[5], f[6], f[7]}; \
        unpack8(g_kk, f); *(LAS f32x4*)(d + 128 + lsub * 8) = (f32x4){f[0], f[1], f[2], f[3]}; *(LAS f32x4*)(d + 128 + lsub * 8 + 4) = (f32x4){f[4], f[5], f[6], f[7]}; \
        unpack8(g_ka, f); *(LAS f32x4*)(d + 192 + lsub * 8) = (f32x4){f[0], f[1], f[2], f[3]}; *(LAS f32x4*)(d + 192 + lsub * 8 + 4) = (f32x4){f[4], f[5], f[6], f[7]}; \
        unpack8(g_r, f); *(LAS f32x4*)(d + 256 + lsub * 8) = (f32x4){f[0], f[1], f[2], f[3]}; *(LAS f32x4*)(d + 256 + lsub * 8 + 4) = (f32x4){f[4], f[5], f[6], f[7]}; \
        if (lsub < 2) { unpack8(g_v, f); *(LAS f32x4*)(d + 320 + lsub * 8) = (f32x4){f[0], f[1], f[2], f[3]}; *(LAS f32x4*)(d + 320 + lsub * 8 + 4) = (f32x4){f[4], f[5], f[6], f[7]}; } } while (0)
                if (bb == -1) { SC_LOAD(0); SC_WRITE(0); if (nb > 1) SC_LOAD(1); }
                else { if (bb + 1 < nb) SC_WRITE(bb + 1); if (bb + 2 < nb) SC_LOAD(bb + 2); }
                if (bb >= 1 && lsub < 2) {
                    const LAS float* y = ybuf + ((bb - 1) & 1) * 512 + lstep * 16 + lsub * 8; float f[8];
#pragma unroll
                    for (int e = 0; e < 8; ++e) f[e] = y[e];
                    *(u32x4*)(yout + (size_t)((bb - 1) * 32 + lstep) * ypitch + lsub * 8) = pack8(f);
                }
            } else if (bb >= 0) {
                __builtin_amdgcn_s_setprio(3);
                const LAS float* bp = buf + (bb & 1) * 10752 + 4 * jl; const LAS float* vp_ = buf + (bb & 1) * 10752 + 320 + li; LAS float* yb = ybuf + (bb & 1) * 512;
                float ysel = 0.f, yprev = 0.f;
                f32x4 cw = *(const LAS f32x4*)(bp), ck_ = *(const LAS f32x4*)(bp + 64), ckk = *(const LAS f32x4*)(bp + 128), cka = *(const LAS f32x4*)(bp + 192), cr = *(const LAS f32x4*)(bp + 256); float cv = vp_[0];
                f32x2v m = Sa * (f32x2v){ckk[0], ckk[1]}; m = Sb * (f32x2v){ckk[2], ckk[3]} + m;
                float a = m.x + m.y;
#pragma unroll
                for (int st = 0; st < 32; ++st) {
                    const int sn = (st + 1 < 32) ? st + 1 : st;
                    const f32x4 nw = *(const LAS f32x4*)(bp + sn * 336), nk = *(const LAS f32x4*)(bp + sn * 336 + 64), nkk = *(const LAS f32x4*)(bp + sn * 336 + 128), nka = *(const LAS f32x4*)(bp + sn * 336 + 192), nr = *(const LAS f32x4*)(bp + sn * 336 + 256); const float nv = vp_[sn * 336];
                    float b = yprev;
                    a += dppf<0xB1>(a); b += dppf<0xB1>(b); a += dppf<0x4E>(a); b += dppf<0x4E>(b); a += dppf<0x141>(a); b += dppf<0x141>(b); a += dppf<0x140>(a); b += dppf<0x140>(b);
                    if (st > 0) { ysel = (jl == ((st - 1) & 3)) ? b : ysel; if (((st - 1) & 3) == 3 && jl < 4) yb[(st - 4 + jl) * 16 + li] = ysel; }
                    const float nsa = -a; const f32x2v vi2 = {cv, cv}, ns2 = {nsa, nsa};
                    const f32x2v ta = (f32x2v){cka[0], cka[1]} * ns2 + (f32x2v){ck_[0], ck_[1]} * vi2, tb = (f32x2v){cka[2], cka[3]} * ns2 + (f32x2v){ck_[2], ck_[3]} * vi2;
                    Sa = Sa * (f32x2v){cw[0], cw[1]} + ta; Sb = Sb * (f32x2v){cw[2], cw[3]} + tb;
                    f32x2v ym = Sa * (f32x2v){cr[0], cr[1]}; ym = Sb * (f32x2v){cr[2], cr[3]} + ym; yprev = ym.x + ym.y;
                    f32x2v mm = Sa * (f32x2v){nkk[0], nkk[1]}; mm = Sb * (f32x2v){nkk[2], nkk[3]} + mm; a = mm.x + mm.y;
                    cw = nw; ck_ = nk; ckk = nkk; cka = nka; cr = nr; cv = nv;
                }
                { float b = red16(yprev); ysel = (jl == 3) ? b : ysel; if (jl < 4) yb[(28 + jl) * 16 + li] = ysel; }
                __builtin_amdgcn_s_setprio(0);
            }
            __syncthreads();
        }
        if (wave >= 4 && lsub < 2) { const LAS float* y = ybuf + ((nb - 1) & 1) * 512 + lstep * 16 + lsub * 8; float f[8];
#pragma unroll
            for (int e = 0; e < 8; ++e) f[e] = y[e];
            *(u32x4*)(yout + (size_t)((nb - 1) * 32 + lstep) * ypitch + lsub * 8) = pack8(f); }
        if (wave < 4) *(f32x4*)(So + (size_t)(i0 + li) * 64 + 4 * jl) = (f32x4){Sa.x, Sa.y, Sb.x, Sb.y};
        __syncthreads();
    }
    {
        unsigned* ctr = (unsigned*)(P.ws + 14336) + l;
        LAS int* slot = (LAS int*)(lds + 131072 + 1024);
        int nxt = 0;
        if (tid == 0) nxt = (int)atomicAdd(ctr, 1u);
        for (;;) {
            __syncthreads();
            if (tid == 0) { slot[0] = nxt; nxt = (int)atomicAdd(ctr, 1u); }
            __syncthreads();
            const int idx = slot[0];
            if (idx >= 2048) break;
            attn_item(P, l, lds, 1024 + idx, tid);
        }
    }
}

__device__ __forceinline__ void e2_phase(const Params& P, int l) {
    const int tid = tid_opaque(), tok = tid >> 3, sub = tid & 7;
    bf16_t* Z = (bf16_t*)(P.ws + WS_ZB);
    {
        const float* SM = (const float*)(P.ws + WS_SMID); const float* S1 = (const float*)(P.ws + WS_SP1); const float* PH = (const float*)(P.ws + WS_PHI);
        for (int e = bid_opaque() * 512 + tid; e < 16 * 4096; e += gridDim.x * 512) { const int chain = e >> 12, i = (e >> 6) & 63, j = e & 63; float a = S1[e];
#pragma unroll 16
            for (int m = 0; m < 64; ++m) a += SM[chain * 4096 + i * 64 + m] * PH[chain * 4096 + m * 64 + j];
            P.out[O_RWP + (size_t)(l * 16 + chain) * 4096 + i * 64 + j] = a; }
    }
    const int wave = tid >> 6, lane = tid & 63, fr = lane & 15, fq = lane >> 4, tt = wave & 3, ih = wave >> 2;
    for (int t_ = bid_opaque(); t_ < 528; t_ += gridDim.x) {
        const int tile = (t_ >= 256 && t_ < 512) ? 256 + ((t_ - 256) ^ 128) : t_;
        if (tile < 512 && (tile & 255) >= 128) {
            const int b = tile >> 8, tl = ((tile & 255) - 128) * 64 + tt * 16 + fr;
            for (int h = 0; h < 8; ++h) {
                const float* SM = (const float*)(P.ws + WS_SMID) + (size_t)(b * 8 + h) * 4096;
                const bf16_t* yp = (const bf16_t*)(P.ws + WS_YPHI) + ((size_t)b * (SEQ / 2) + tl) * 512 + h * 64;
                const bf16x8 yb0 = *(const bf16x8*)(yp + 8 * fq), yb1 = *(const bf16x8*)(yp + 32 + 8 * fq);
                bf16_t* yrow = Z + (size_t)(b * SEQ + SEQ / 2 + tl) * ZW + BK + h * 64;
#pragma unroll
                for (int q = 0; q < 2; ++q) { const int i = (ih * 2 + q) * 16 + fr; f32x4 acc = (f32x4){0.f, 0.f, 0.f, 0.f};
#pragma unroll
                    for (int kk = 0; kk < 2; ++kk) { const f32x4 s0 = *(const f32x4*)(SM + i * 64 + 32 * kk + 8 * fq), s1 = *(const f32x4*)(SM + i * 64 + 32 * kk + 8 * fq + 4);
                        u32x4 w; w.x = cvt_pk_bf16(s0[0], s0[1]); w.y = cvt_pk_bf16(s0[2], s0[3]); w.z = cvt_pk_bf16(s1[0], s1[1]); w.w = cvt_pk_bf16(s1[2], s1[3]);
                        acc = __builtin_amdgcn_mfma_f32_16x16x32_bf16(__builtin_bit_cast(bf16x8, w), kk ? yb1 : yb0, acc, 0, 0, 0); }
                    bf16_t* dp = yrow + (ih * 2 + q) * 16 + 4 * fq; const u32x2 o = *(const u32x2*)dp; u32x2 w;
                    w.x = cvt_pk_bf16(bflo(o.x) + acc[0], bfhi(o.x) + acc[1]); w.y = cvt_pk_bf16(bflo(o.y) + acc[2], bfhi(o.y) + acc[3]); *(u32x2*)dp = w; }
            }
            __syncthreads();
        }
        const size_t row = (size_t)tile * 64 + tok;
#pragma unroll
        for (int hq = 0; hq < 2; ++hq) {
            u32x4 ry[4], rv[4], rg[4]; float bnv[4];
#pragma unroll
            for (int q = 0; q < 4; ++q) { const int h = hq * 4 + q, hc = h * 64 + sub * 8; ry[q] = *(const u32x4*)(Z + row * ZW + BK + hc); rv[q] = *(const u32x4*)(Z + row * ZW + CV + hc); rg[q] = *(const u32x4*)(Z + row * ZW + BG + hc);
                bnv[q] = ((const float*)(P.ws + WS_BONUS))[row * 8 + h]; }
#pragma unroll
            for (int q = 0; q < 4; ++q) { const int h = hq * 4 + q, hc = h * 64 + sub * 8; float y[8], v[8], g[8], o[8];
                unpack8(ry[q], y); unpack8(rv[q], v); unpack8(rg[q], g);
                float s_ = 0.f;
#pragma unroll
                for (int e = 0; e < 8; ++e) s_ += y[e];
                const float mean = sum8(s_) * (1.f / 64.f); float q2 = 0.f;
#pragma unroll
                for (int e = 0; e < 8; ++e) { const float d = y[e] - mean; q2 += d * d; }
                const float rs = rsqrtf(sum8(q2) * (1.f / 64.f) + 64e-5f);
                const float bn = bnv[q];
                const float* lw = PIN(23) + l * 512 + hc; const float* lb = PIN(24) + l * 512 + hc;
#pragma unroll
                for (int e = 0; e < 8; ++e) o[e] = ((y[e] - mean) * rs * lw[e] + lb[e] + bn * v[e]) * g[e];
                *(u32x4*)(Z + row * ZW + CR + hc) = pack8(o); }
        }
    }
}

#define XB_TMO      128
#define XB_XCNT(j)  (256  + 64 * (j))
#define XB_XSUB(j)  (1280 + 64 * (j))
#define XB_XGEN(j)  (2304 + 64 * (j))
#define XB_TOP      3328
#define XB_TOPGEN   3392
#define XCD_BAR_WORDS 3456
#define XB_SPIN_CAP (1u << 22)
__device__ __forceinline__ unsigned xb_ld(unsigned* p)              { return __hip_atomic_load(p, __ATOMIC_RELAXED, __HIP_MEMORY_SCOPE_AGENT); }
__device__ __forceinline__ unsigned xb_add(unsigned* p, unsigned v) { return __hip_atomic_fetch_add(p, v, __ATOMIC_RELAXED, __HIP_MEMORY_SCOPE_AGENT); }
__device__ __forceinline__ unsigned xb_xcc_id() { return (unsigned)__builtin_amdgcn_s_getreg((3 << 11) | 20) & 0xFu; }
#define XB_SPIN(cond, bar) do { unsigned _sp = 0; while (cond) { __builtin_amdgcn_s_sleep(1); \
    if ((++_sp & 255u) == 0u) { if (xb_ld(&(bar)[XB_TMO])) break; if (_sp > XB_SPIN_CAP) { atomicAdd(&(bar)[XB_TMO], 1u); break; } } } } while (0)
struct XcdBarrier { unsigned* bar; unsigned x; volatile LAS unsigned* st; };
__device__ __forceinline__ XcdBarrier xcd_barrier_post(unsigned* bar, volatile LAS unsigned* st) {
    XcdBarrier b; b.bar = bar; b.x = xb_xcc_id(); b.st = st;
    if (threadIdx.x == 0) (void)xb_add(&bar[XB_XCNT(b.x)], 1u);
    return b;
}
__device__ __forceinline__ void xcd_barrier_complete(unsigned* bar, unsigned x, unsigned& nloc, unsigned& nx) {
    const unsigned G = gridDim.x * gridDim.y * gridDim.z;
    unsigned sum, cnt, mine, sp = 0u;
    for (;;) {
        sum = 0u; cnt = 0u; mine = 0u;
#pragma unroll
        for (unsigned j = 0; j < 16; ++j) { const unsigned c = xb_ld(&bar[XB_XCNT(j)]); sum += c; cnt += (c > 0u) ? 1u : 0u; mine = (j == x) ? c : mine; }
        if (sum == G) break;
        __builtin_amdgcn_s_sleep(1);
        if ((++sp & 255u) == 0u) { if (xb_ld(&bar[XB_TMO])) break; if (sp > XB_SPIN_CAP) { atomicAdd(&bar[XB_TMO], 1u); break; } }
    }
    nloc = mine > 0u ? mine : 1u; nx = cnt > 0u ? cnt : 1u;
}
__device__ __forceinline__ void xcd_barrier(const XcdBarrier& b) {
    asm volatile("s_waitcnt vmcnt(0)" ::: "memory");
    __syncthreads();
    if (threadIdx.x == 0) {
        unsigned* bar = b.bar;
        __builtin_amdgcn_s_waitcnt(0);
        unsigned nloc = b.st[0], nx = b.st[1];
        if (nloc == 0u) { xcd_barrier_complete(bar, b.x, nloc, nx); b.st[0] = nloc; b.st[1] = nx; }
        const unsigned old = xb_add(&bar[XB_XSUB(b.x)], 1u);
        const unsigned gen = old / nloc;
        if (old + 1u == (gen + 1u) * nloc) {
            __builtin_amdgcn_fence(__ATOMIC_RELEASE, "agent");
            asm volatile("s_waitcnt vmcnt(0)" ::: "memory");
            const unsigned og = xb_add(&bar[XB_TOP], 1u);
            const unsigned tg = og / nx;
            if (og + 1u == (tg + 1u) * nx) xb_add(&bar[XB_TOPGEN], 1u);
            else XB_SPIN(xb_ld(&bar[XB_TOPGEN]) == tg, bar);
            __builtin_amdgcn_fence(__ATOMIC_ACQUIRE, "agent");
            xb_add(&bar[XB_XGEN(b.x)], 1u);
            asm volatile("s_waitcnt vmcnt(0)" ::: "memory");
        } else {
            XB_SPIN(xb_ld(&bar[XB_XGEN(b.x)]) == gen, bar);
            __builtin_amdgcn_fence(__ATOMIC_ACQUIRE, "agent");
            asm volatile("s_waitcnt vmcnt(0)" ::: "memory");
        }
    }
    __syncthreads();
}

__global__ void __launch_bounds__(512, 2) mega_fwd(Params P) {
    extern __shared__ __attribute__((aligned(16))) unsigned char lds_raw[];
    LAS unsigned char* lds = (LAS unsigned char*)lds_raw;
    unsigned char* ws = P.ws;
    bf16_t* Z = (bf16_t*)(ws + WS_ZB); bf16_t* XNB = (bf16_t*)(ws + WS_XNB); bf16_t* LOB = (bf16_t*)(ws + WS_LOB); bf16_t* WT = (bf16_t*)(ws + WS_W);
    volatile LAS unsigned* bst = (volatile LAS unsigned*)(lds + 131072 + 512);
    if (threadIdx.x < 2) bst[threadIdx.x] = 0u;
    __syncthreads();
    XcdBarrier xbar = xcd_barrier_post((unsigned*)ws, bst);
    for (int ph = P.ph_lo; ph < P.ph_hi; ++ph) {
        if (ph == 0) { convert_weights(P, 0, lds); row_norm_pass(P, 0, 0); }
        else {
            const int l = (ph - 1) / NPH_LAYER, k = (ph - 1) % NPH_LAYER;
            GemmDesc g; g.sched = -1; g.lda = g.ldb = 1024; g.K = 1024; g.nM = 132; g.nN = 4; g.epi = 0; g.perm = 1; g.d0 = nullptr; g.ldc0 = 1024; g.d1 = nullptr; g.x = nullptr; g.z = Z; g.A = nullptr; g.B = nullptr;
            switch (k) {
            case 0: g.sched = 0; g.A = (const char*)XNB; g.B = (const char*)(WT + W_Z); g.nN = 21; g.d0 = Z; g.ldc0 = ZW; break;
            case 1: e1_phase(P, l, lds); break;
            case 2: p2_phase(P, l, lds); break;
            case 3: p3_phase(P, l, lds); break;
            case 4: g.sched = 0; g.A = (const char*)LOB; g.lda = 256; g.B = (const char*)(WT + W_BD); g.ldb = 256; g.K = 256; g.nN = 6; g.epi = 1; g.d0 = XNB; break;
            case 5: c2_phase(P, l, lds); break;
            case 6: scan_phase(P, l, lds); break;
            case 7: e2_phase(P, l); row_norm_pass(P, l, 1); break;
            case 8: g.sched = 0; g.A = (const char*)XNB; g.B = (const char*)(WT + W_GL); g.nN = 12; g.epi = 2; g.d0 = Z; g.ldc0 = ZW; break;
            case 9: g.sched = 1; g.A = (const char*)Z; g.lda = ZW; g.B = (const char*)(WT + W_B); g.ldb = 512; g.K = 512; g.epi = 3; g.d0 = XNB; break;
            case 10: g.sched = 0; g.A = (const char*)XNB; g.B = (const char*)(WT + W_O); g.epi = 4; g.perm = 0; g.x = P.out; break;
            case 11: row_norm_pass(P, l, 2); break;
            case 12: g.sched = 0; g.A = (const char*)Z; g.B = (const char*)(WT + W_GU); g.nN = 22; g.epi = 5; g.d0 = (bf16_t*)(ws + WS_H); g.ldc0 = FF; break;
            case 13: g.sched = 0; g.A = (const char*)(ws + WS_H); g.lda = FF; g.B = (const char*)(WT + W_D); g.ldb = FF; g.K = FF; g.epi = 4; g.perm = 0; g.x = P.out; g.d1 = (bf16_t*)(ws + WS_XB); break;
            case 14: g.sched = 0; g.A = (const char*)(ws + WS_XB); g.B = (const char*)(WT + W_PG); g.d0 = Z; break;
            default: finish_pass(P, l); if (l == 0) convert_weights(P, 1, lds); break;
            }
            for (int rep = 0; rep < (k == 13 ? 2 : 1); ++rep) {
                if (rep == 1) { g.A = (const char*)LOB; g.lda = 256; g.B = (const char*)(WT + W_P); g.ldb = 256; g.K = 256; g.epi = 0; g.perm = 1; g.d0 = XNB; g.ldc0 = 1024; g.d1 = nullptr; g.x = nullptr; }
                if (g.sched >= 0) gemm_phase(lds, g);
            }
#ifdef DBG_REP_MASK
            if ((DBG_REP_MASK >> k) & 1) { cg::this_grid().sync(); if (g.sched >= 0) gemm_phase(lds, g); else if (k == 6) scan_phase(P, l, lds); else if (k == 2) p2_phase(P, l, lds); }
#endif
        }
        if (ph + 1 < P.ph_hi) { if (P.ph_hi < 0) cg::this_grid().sync(); else xcd_barrier(xbar); }
#ifdef DBG_EXTRA_SYNC
        if (ph + 1 < P.ph_hi) { cg::this_grid().sync(); cg::this_grid().sync(); }
#endif
    }
#ifdef DBG_DUMP_Z
    cg::this_grid().sync();
    for (size_t e = (size_t)blockIdx.x * 512 + threadIdx.x; e < (size_t)T_ALL * 512; e += (size_t)gridDim.x * 512) {
        const size_t r = e >> 9; const int c = (int)(e & 511);
        P.out[e] = bf2f(XNB[e]); (void)r; (void)c;
    }
#endif
}

extern "C" void kernel_launch(void* const* d_in, const int* in_sizes, int n_in, void* d_out, int out_size, void* d_ws, size_t ws_size, hipStream_t stream) {
    static int grid = 0;
    if (grid == 0) {
        if (n_in != 34 || out_size != 45603840 || ws_size < WS_END2) { fprintf(stderr, "kernel_launch: unexpected shapes n_in %d out %d ws %zu\n", n_in, out_size, ws_size); grid = -1; return; }
        int dev = 0, cus = 0, per_cu = 0;
        hipGetDevice(&dev); hipDeviceGetAttribute(&cus, hipDeviceAttributeMultiprocessorCount, dev);
        hipFuncSetAttribute((const void*)mega_fwd, hipFuncAttributeMaxDynamicSharedMemorySize, LDS_BYTES);
        hipOccupancyMaxActiveBlocksPerMultiprocessor(&per_cu, (const void*)mega_fwd, 512, LDS_BYTES);
        if (per_cu < 1) { fprintf(stderr, "kernel_launch: occupancy query says %d blocks per CU\n", per_cu); per_cu = 1; }
        (void)hipGetLastError();
        grid = cus * per_cu;
        fprintf(stderr, "kernel_launch: grid %d (cus %d x %d)\n", grid, cus, per_cu);
    }
    if (grid < 0) return;
#ifdef DBG_POISON
    (void)hipMemsetAsync(d_ws, 0xFF, WS_END, stream);
#endif
    (void)hipMemsetAsync(d_ws, 0, 16384, stream);
    Params p{};
    for (int i = 0; i < 34; ++i) p.in[i] = (const float*)d_in[i];
    p.out = (float*)d_out; p.ws = (unsigned char*)d_ws;
#if MK_PER_PHASE
    for (int ph = 0; ph < NPHASES; ++ph) { p.ph_lo = ph; p.ph_hi = ph + 1; hipLaunchKernelGGL(mega_fwd, dim3(grid), dim3(512), LDS_BYTES, stream, p); }
#else
#ifdef DBG_PH_HI
    p.ph_lo = 0; p.ph_hi = DBG_PH_HI;
#else
    p.ph_lo = 0; p.ph_hi = NPHASES;
#endif
    void* args[] = {&p};
    hipError_t e = hipLaunchCooperativeKernel((const void*)mega_fwd, dim3(grid), dim3(512), args, LDS_BYTES, stream);
    if (e != hipSuccess) fprintf(stderr, "cooperative launch failed: %s (grid %d)\n", hipGetErrorString(e), grid);
#endif
}
```

```cpp
#include <hip/hip_runtime.h>
#include <hip/hip_cooperative_groups.h>
#include <cstdio>
#include <cstdint>
namespace cg = cooperative_groups;


#ifndef MK_PER_PHASE
#define MK_PER_PHASE 0
#endif

#define LAS __attribute__((address_space(3)))
typedef unsigned short bf16_t;
typedef short bf16x8 __attribute__((ext_vector_type(8)));
typedef float f32x4 __attribute__((ext_vector_type(4)));
typedef unsigned u32x4 __attribute__((ext_vector_type(4)));
typedef unsigned u32x2 __attribute__((ext_vector_type(2)));

constexpr int T_ALL = 33792, T_P = 32768, SEQ = 16384, DM = 1024, ZW = 5376, FF = 2816;
constexpr int AQ = 0, AK = 512, AV = 1024, BQ = 1536, BK = 2048, BV = 2560, BG = 3072, CR = 3584, CK = 4096, CV = 4608, CLO = 5120;
constexpr float EPS = 1e-6f;
constexpr int NPH_LAYER = 16, NPHASES = 1 + 2 * NPH_LAYER;
constexpr size_t O_YP = 0, O_AKP = 34603008, O_AVP = 35651584, O_RETP = 36700160, O_RWP = 36962304, O_SHP = 37093376,
                 O_AKS = 37100544, O_AVS = 38149120, O_RETS = 39197696, O_RWS = 43392000, O_SHS = 45489152;
constexpr size_t MiB = 1u << 20;
constexpr size_t WS_W = 1 * MiB, WS_XNB = 43 * MiB, WS_LOB = 109 * MiB, WS_ZB = 126 * MiB, WS_BONUS = 473 * MiB, WS_CZB = 475 * MiB, WS_END = 477 * MiB;
constexpr size_t WS_YPHI = 478 * MiB, WS_SMID = 495 * MiB, WS_SP1 = 496 * MiB, WS_PHI = 497 * MiB, WS_END2 = 498 * MiB;
constexpr size_t WS_H = WS_ZB + 66 * MiB, WS_XB = WS_ZB + 248 * MiB;
constexpr size_t W_Z = 0, W_GL = 5505024, W_BD = 8650752, W_B = 9043968, W_O = 10616832, W_GU = 11665408, W_D = 17432576, W_P = 20316160, W_PG = 20578304;
constexpr int LDS_BYTES = 147456;

struct Params { const float* in[34]; float* out; unsigned char* ws; int ph_lo, ph_hi; };

__device__ __forceinline__ const float* ld_in(const Params& P, int i) { asm volatile("" : "+s"(i)); return P.in[i]; }
#define PIN(i) ld_in(P, i)
__device__ __forceinline__ int tid_opaque() { int t = threadIdx.x; asm volatile("" : "+v"(t)); return t; }
__device__ __forceinline__ int bid_opaque() { int b = blockIdx.x; asm volatile("" : "+s"(b)); return b; }
typedef __bf16 bf16x2v __attribute__((ext_vector_type(2)));
typedef float f32x2v __attribute__((ext_vector_type(2)));
__device__ __forceinline__ unsigned cvt_pk_bf16(float lo, float hi) { f32x2v v = {lo, hi}; bf16x2v b = __builtin_convertvector(v, bf16x2v); return __builtin_bit_cast(unsigned, b); }
__device__ __forceinline__ float bflo(unsigned w) { return __uint_as_float(w << 16); }
__device__ __forceinline__ float bfhi(unsigned w) { return __uint_as_float(w & 0xffff0000u); }
__device__ __forceinline__ float bf2f(bf16_t b) { return __uint_as_float((unsigned)b << 16); }
__device__ __forceinline__ bf16_t f2bf(float f) { return (bf16_t)(cvt_pk_bf16(f, f) & 0xffffu); }
__device__ __forceinline__ void unpack8(u32x4 w, float* f) { f[0] = bflo(w.x); f[1] = bfhi(w.x); f[2] = bflo(w.y); f[3] = bfhi(w.y); f[4] = bflo(w.z); f[5] = bfhi(w.z); f[6] = bflo(w.w); f[7] = bfhi(w.w); }
__device__ __forceinline__ u32x4 pack8(const float* f) { u32x4 w; w.x = cvt_pk_bf16(f[0], f[1]); w.y = cvt_pk_bf16(f[2], f[3]); w.z = cvt_pk_bf16(f[4], f[5]); w.w = cvt_pk_bf16(f[6], f[7]); return w; }
__device__ __forceinline__ float sigmoidf_(float x) { return __builtin_amdgcn_rcpf(1.f + __builtin_amdgcn_exp2f(-1.4426950408889634f * x)); }
__device__ __forceinline__ float wave_sum(float v) {
#pragma unroll
    for (int o = 1; o < 64; o <<= 1) v += __shfl_xor(v, o);
    return v;
}
__device__ __forceinline__ float sum8(float v) { v += __shfl_xor(v, 1); v += __shfl_xor(v, 2); v += __shfl_xor(v, 4); return v; }
template <int CTRL> __device__ __forceinline__ float dppf(float x) { return __builtin_bit_cast(float, __builtin_amdgcn_update_dpp(0, __builtin_bit_cast(int, x), CTRL, 0xf, 0xf, false)); }
__device__ __forceinline__ float red16(float x) { x += dppf<0xB1>(x); x += dppf<0x4E>(x); x += dppf<0x141>(x); x += dppf<0x140>(x); return x; }
__device__ __forceinline__ float gamma_l2(int h) { return __log2f(1.f - __builtin_amdgcn_exp2f(-5.f - (float)h)); }
#define LDSW() asm volatile("s_waitcnt lgkmcnt(0)" ::: "memory")

constexpr int BM = 256, BKT = 64, HALF = 128, HTB = HALF * BKT * 2;
__device__ __forceinline__ int lds_byte(int r, int c) { const int st = (r >> 4) * 2 + (c >> 5), rr = r & 15, cc = c & 31, ob = rr * 64 + cc * 2; return st * 1024 + (ob ^ (((ob >> 9) & 1) << 5)); }
__device__ __forceinline__ void stage_rc(int b, int& R, int& C) { const int st = b / 1024, sb = b % 1024, swz = sb ^ (((sb >> 9) & 1) << 5); R = (st >> 1) * 16 + swz / 64; C = (st & 1) * 32 + (swz % 64) / 2; }
__device__ __forceinline__ int perm32(int rho) { const int n = rho >> 4, i = rho & 15; return 8 * (i >> 2) + 4 * n + (i & 3); }

struct Unit { const char* a; const char* b; int pm, pn, aux; };
struct GemmDesc {
    const char* A; const char* B; int lda, ldb, K, nM, nN, sched, epi, perm;
    bf16_t* d0; int ldc0; bf16_t* d1; float* x; bf16_t* z;
    int skip;
};
__device__ __forceinline__ void tile_map(int L, int nM, int nN, int& pm, int& pn) {
    const int nwg = nM * nN; int wgid = L;
    { const int q = nwg / 8, r = nwg % 8, xcd = wgid % 8, off = wgid / 8; wgid = (xcd < r ? xcd * (q + 1) : r * (q + 1) + (xcd - r) * q) + off; }
    const int nig = 8 * nN, gid = wgid / nig, fm = gid * 8, gsz = (nM - fm) < 8 ? (nM - fm) : 8;
    pm = fm + ((wgid % nig) % gsz); pn = (wgid % nig) / gsz;
}
__device__ __forceinline__ int gl_off(int b) { return b == 0 ? 512 : (b == 1 ? 2048 : 4096); }
__device__ __forceinline__ int br_off(int b) { return b == 0 ? AQ : (b == 1 ? BQ : CR); }
__device__ __forceinline__ bool unit_next(const GemmDesc& g, int i, int G, int c, Unit& u) {
    const int nwg = g.nM * g.nN;
    if (g.sched == 0) {
        if (c < g.skip) return false;
        const long L = (long)i * (G - g.skip) + (c - g.skip); if (L >= nwg) return false;
        tile_map((int)L, g.nM, g.nN, u.pm, u.pn); u.aux = 0;
        u.a = g.A + (size_t)u.pm * 256 * g.lda * 2; u.b = g.B + (size_t)u.pn * 256 * g.ldb * 2; return true;
    } else {
        const long L = (long)(i / 3) * G + c; if (L >= nwg) return false;
        const int b = i % 3; tile_map((int)L, g.nM, g.nN, u.pm, u.pn); u.aux = b;
        u.a = g.A + (size_t)u.pm * 256 * g.lda * 2 + br_off(b) * 2; u.b = g.B + (size_t)b * 1024 * 512 * 2 + (size_t)u.pn * 256 * g.ldb * 2; return true;
    }
}
__device__ __forceinline__ void gemm_epilogue(const GemmDesc& g, const f32x4 (&acc)[2][2][4][2], const Unit& u, int wr, int wc, int fr, int fq) {
    const int row0 = u.pm * BM + wr * 64 + fr;
    if (g.epi == 4) {
        const int col0 = u.pn * BM + wc * 32 + 4 * fq;
#pragma unroll
        for (int ai = 0; ai < 2; ++ai)
#pragma unroll
            for (int m = 0; m < 4; ++m) { const size_t ro = (size_t)(row0 + ai * HALF + m * 16) * DM + col0;
#pragma unroll
                for (int bj = 0; bj < 2; ++bj)
#pragma unroll
                    for (int n = 0; n < 2; ++n) { f32x4* p = (f32x4*)(g.x + ro + bj * HALF + n * 16); const f32x4 v = *p + acc[ai][bj][m][n]; *p = v;
                        if (g.d1) { u32x2 w; w.x = cvt_pk_bf16(v[0], v[1]); w.y = cvt_pk_bf16(v[2], v[3]); *(u32x2*)(g.d1 + ro + bj * HALF + n * 16) = w; } } }
        return;
    }
    const int cl = wc * 32 + 8 * fq;
    if (g.epi == 5) {
#pragma unroll
        for (int ai = 0; ai < 2; ++ai)
#pragma unroll
            for (int m = 0; m < 4; ++m) { const size_t ro = (size_t)(row0 + ai * HALF + m * 16) * g.ldc0 + u.pn * 128 + cl; float h[8];
#pragma unroll
                for (int n = 0; n < 2; ++n)
#pragma unroll
                    for (int e = 0; e < 4; ++e) { const float gt = acc[ai][0][m][n][e], up = acc[ai][1][m][n][e]; h[n * 4 + e] = gt * sigmoidf_(gt) * up; }
                *(u32x4*)(g.d0 + ro) = pack8(h); }
        return;
    }
    bf16_t* base = g.d0; int ldc = g.ldc0, colt = u.pn * BM; bool sg = false;
    if (g.epi == 1) { if (u.pn >= 4) { base = g.z; ldc = ZW; colt = BG + (u.pn - 4) * BM; } }
    else if (g.epi == 2) { colt = gl_off(u.pn >> 2) + (u.pn & 3) * BM; sg = true; }
    const bool gated = (g.epi == 3); const int gcol = gated ? gl_off(u.aux) : 0;
#pragma unroll
    for (int ai = 0; ai < 2; ++ai)
#pragma unroll
        for (int m = 0; m < 4; ++m) { const int row = row0 + ai * HALF + m * 16;
#pragma unroll
            for (int bj = 0; bj < 2; ++bj) { float v[8];
#pragma unroll
                for (int n = 0; n < 2; ++n)
#pragma unroll
                    for (int e = 0; e < 4; ++e) v[n * 4 + e] = acc[ai][bj][m][n][e];
                bf16_t* dp = base + (size_t)row * ldc + colt + bj * HALF + cl;
                if (sg) {
#pragma unroll
                    for (int e = 0; e < 8; ++e) v[e] = sigmoidf_(v[e]);
                }
                if (gated) { float gt[8]; unpack8(*(const u32x4*)(g.z + (size_t)row * ZW + gcol + u.pn * BM + bj * HALF + cl), gt);
#pragma unroll
                    for (int e = 0; e < 8; ++e) v[e] *= gt[e];
                    if (u.aux > 0) { float pv[8]; unpack8(*(const u32x4*)dp, pv);
#pragma unroll
                        for (int e = 0; e < 8; ++e) v[e] += pv[e]; } }
                *(u32x4*)dp = pack8(v); } }
}

__device__ __forceinline__ void gemm_phase(LAS unsigned char* lds, const GemmDesc& g) {
    const int tid = tid_opaque(), wid = __builtin_amdgcn_readfirstlane(tid >> 6), lane = tid & 63, wr = wid >> 2, wc = wid & 3, fr = lane & 15, fq = lane >> 4;
    const int G = gridDim.x, cb = bid_opaque();
    const int K = g.K, nt = K / BKT;
    unsigned voffA[2], voffB[2];
#pragma unroll
    for (int i = 0; i < 2; ++i) { int R, C; stage_rc(tid * 16 + i * 8192, R, C); const int Rb = g.perm ? ((R & ~31) + perm32(R & 31)) : R;
        voffA[i] = (unsigned)(R * g.lda + C) * 2u; voffB[i] = (unsigned)(Rb * g.ldb + C) * 2u; }
    const size_t kstep = (size_t)(BKT * 2);
    const size_t hstepA = (size_t)HALF * g.lda * 2, hstepB = (size_t)HALF * g.ldb * 2;
    const unsigned ldsw = (unsigned)wid * 1024u;
    const int aoff = lds_byte(wr * 64 + fr, fq * 8), boff = lds_byte(wc * 32 + fr, fq * 8);
#define PG8_SA(b, h) (((b) * 2 + (h)) * HTB)
#define PG8_SB(b, h) ((4 + (b) * 2 + (h)) * HTB)
#define PG8_STAGE(bufoff, gbase, voff) do { _Pragma("unroll") for (int _i = 0; _i < 2; ++_i) \
        __builtin_amdgcn_global_load_lds((const unsigned*)((const char*)(gbase) + (voff)[_i]), (LAS unsigned*)(lds + (bufoff) + ldsw + _i * 8192), 16, 0, 0); } while (0)
#define PG8_LDA(dst, b, h) do { _Pragma("unroll") for (int m = 0; m < 4; ++m) _Pragma("unroll") for (int k = 0; k < 2; ++k) dst[m][k] = *(const LAS bf16x8*)(lds + PG8_SA(b, h) + aoff + m * 2048 + k * 1024); } while (0)
#define PG8_LDB(dst, b, h) do { _Pragma("unroll") for (int n = 0; n < 2; ++n) _Pragma("unroll") for (int k = 0; k < 2; ++k) dst[n][k] = *(const LAS bf16x8*)(lds + PG8_SB(b, h) + boff + n * 2048 + k * 1024); } while (0)
#define PG8_MMA(ai, bj, At, Bt) do { __builtin_amdgcn_s_setprio(1); _Pragma("unroll") for (int m = 0; m < 4; ++m) _Pragma("unroll") for (int n = 0; n < 2; ++n) _Pragma("unroll") for (int k = 0; k < 2; ++k) \
        acc[ai][bj][m][n] = __builtin_amdgcn_mfma_f32_16x16x32_bf16(Bt[n][k], At[m][k], acc[ai][bj][m][n], 0, 0, 0); __builtin_amdgcn_s_setprio(0); } while (0)
#define PG8_WAIT_V(n) asm volatile("s_waitcnt vmcnt(" #n ")" ::: "memory")
#define PG8_WAIT_L(n) asm volatile("s_waitcnt lgkmcnt(" #n ")" ::: "memory")
#define PG8_BAR __builtin_amdgcn_s_barrier()
#define PG8_SCHED __builtin_amdgcn_sched_barrier(0)
    Unit cur, nxt; int ui = 0;
    if (!unit_next(g, 0, G, cb, cur)) return;
    f32x4 acc[2][2][4][2];
#pragma unroll
    for (int a = 0; a < 2; ++a)
#pragma unroll
        for (int b = 0; b < 2; ++b)
#pragma unroll
            for (int m = 0; m < 4; ++m)
#pragma unroll
                for (int n = 0; n < 2; ++n) acc[a][b][m][n] = (f32x4){0.f, 0.f, 0.f, 0.f};
    bf16x8 At[4][2], B0[2][2], B1[2][2];
    const char* cA = cur.a; const char* cB = cur.b;
    PG8_STAGE(PG8_SB(0, 0), cB, voffB); PG8_STAGE(PG8_SB(0, 1), cB + hstepB, voffB); PG8_STAGE(PG8_SA(0, 0), cA, voffA); PG8_STAGE(PG8_SA(0, 1), cA + hstepA, voffA);
    if (wr == 1) PG8_BAR;
    PG8_WAIT_V(2); PG8_BAR;
    PG8_STAGE(PG8_SB(1, 0), cB + kstep, voffB); PG8_STAGE(PG8_SA(1, 0), cA + kstep, voffA); PG8_STAGE(PG8_SB(1, 1), cB + hstepB + kstep, voffB);
    PG8_WAIT_V(6); PG8_BAR;
    for (;;) {
        const bool has_next = unit_next(g, ui + 1, G, cb, nxt);
        const char* nA = has_next ? nxt.a : cA; const char* nB = has_next ? nxt.b : cB;
        for (int t = 0; t < nt; t += 2) {
            const bool last = (t == nt - 2);
            const char* a1 = cA + (size_t)(t + 1) * kstep;
            const char* a2 = last ? nA : cA + (size_t)(t + 2) * kstep; const char* b2 = last ? nB : cB + (size_t)(t + 2) * kstep;
            const char* a3 = a2 + kstep; const char* b3 = b2 + kstep;
            PG8_LDB(B0, 0, 0); PG8_LDB(B1, 0, 1); PG8_SCHED; PG8_LDA(At, 0, 0); PG8_STAGE(PG8_SA(1, 1), a1 + hstepA, voffA);
            PG8_WAIT_V(8); PG8_WAIT_L(0); PG8_BAR; PG8_MMA(0, 0, At, B0); PG8_MMA(0, 1, At, B1); PG8_BAR; PG8_SCHED;
            PG8_LDA(At, 0, 1); PG8_STAGE(PG8_SB(0, 0), b2, voffB); PG8_STAGE(PG8_SB(0, 1), b2 + hstepB, voffB); PG8_STAGE(PG8_SA(0, 0), a2, voffA);
            PG8_WAIT_V(8); PG8_WAIT_L(0); PG8_BAR; PG8_MMA(1, 0, At, B0); PG8_MMA(1, 1, At, B1); PG8_BAR; PG8_SCHED;
            PG8_LDB(B0, 1, 0); PG8_LDB(B1, 1, 1); PG8_SCHED; PG8_LDA(At, 1, 0); PG8_STAGE(PG8_SA(0, 1), a2 + hstepA, voffA);
            PG8_WAIT_V(8); PG8_WAIT_L(0); PG8_BAR; PG8_MMA(0, 0, At, B0); PG8_MMA(0, 1, At, B1); PG8_BAR; PG8_SCHED;
            PG8_LDA(At, 1, 1); PG8_STAGE(PG8_SB(1, 0), b3, voffB); PG8_STAGE(PG8_SB(1, 1), b3 + hstepB, voffB); PG8_STAGE(PG8_SA(1, 0), a3, voffA);
            PG8_WAIT_V(8); PG8_WAIT_L(0); PG8_BAR; PG8_MMA(1, 0, At, B0); PG8_MMA(1, 1, At, B1); PG8_BAR; PG8_SCHED;
        }
        if (wr == 0) PG8_BAR;
        gemm_epilogue(g, acc, cur, wr, wc, fr, fq);
        if (!has_next) break;
#pragma unroll
        for (int a = 0; a < 2; ++a)
#pragma unroll
            for (int b = 0; b < 2; ++b)
#pragma unroll
                for (int m = 0; m < 4; ++m)
#pragma unroll
                    for (int n = 0; n < 2; ++n) acc[a][b][m][n] = (f32x4){0.f, 0.f, 0.f, 0.f};
        cur = nxt; cA = nA; cB = nB; ++ui;
        if (wr == 1) PG8_BAR;
    }
    PG8_WAIT_V(0);
    PG8_BAR;
}

struct MatDesc { const float* W; int ldw, col0, K, N; bf16_t* T; int ldt, koff, rowmode, rowoff; };
__device__ __forceinline__ MatDesc get_mat(const Params& P, int l, int m) {
    bf16_t* wb = (bf16_t*)(P.ws + WS_W); MatDesc d; d.col0 = 0; d.koff = 0; d.rowmode = 0; d.rowoff = 0;
    switch (m) {
    case 0: d.W = PIN(10) + (size_t)l * 1024 * 8448; d.ldw = 8448; d.K = 1024; d.N = 5376; d.T = wb + W_Z; d.ldt = 1024; break;
    case 1: d.W = PIN(10) + (size_t)l * 1024 * 8448; d.ldw = 8448; d.col0 = 5376; d.K = 1024; d.N = 3072; d.T = wb + W_GL; d.ldt = 1024; break;
    case 2: d.W = PIN(16) + (size_t)l * 64 * 512; d.ldw = 512; d.K = 64; d.N = 512; d.T = wb + W_BD; d.ldt = 256; break;
    case 3: d.W = PIN(18) + (size_t)l * 64 * 512; d.ldw = 512; d.K = 64; d.N = 512; d.T = wb + W_BD; d.ldt = 256; d.koff = 64; d.rowoff = 512; break;
    case 4: d.W = PIN(19) + (size_t)l * 128 * 512; d.ldw = 512; d.K = 128; d.N = 512; d.T = wb + W_BD; d.ldt = 256; d.koff = 128; d.rowoff = 1024; break;
    case 5: case 6: case 7: d.W = PIN(25) + (size_t)(l * 3 + (m - 5)) * 512 * 1024; d.ldw = 1024; d.K = 512; d.N = 1024; d.T = wb + W_B + (size_t)(m - 5) * 1024 * 512; d.ldt = 512; break;
    case 8: d.W = PIN(26) + (size_t)l * 1024 * 1024; d.ldw = 1024; d.K = 1024; d.N = 1024; d.T = wb + W_O; d.ldt = 1024; break;
    case 9: d.W = PIN(28) + (size_t)l * 1024 * FF; d.ldw = FF; d.K = 1024; d.N = FF; d.T = wb + W_GU; d.ldt = 1024; d.rowmode = 1; break;
    case 10: d.W = PIN(29) + (size_t)l * 1024 * FF; d.ldw = FF; d.K = 1024; d.N = FF; d.T = wb + W_GU; d.ldt = 1024; d.rowmode = 1; d.rowoff = 128; break;
    case 11: d.W = PIN(30) + (size_t)l * FF * 1024; d.ldw = 1024; d.K = FF; d.N = 1024; d.T = wb + W_D; d.ldt = FF; break;
    case 12: d.W = PIN(31) + (size_t)l * 256 * 1024; d.ldw = 1024; d.K = 256; d.N = 1024; d.T = wb + W_P; d.ldt = 256; break;
    default: d.W = PIN(33) + (size_t)l * 1024 * 1024; d.ldw = 1024; d.K = 1024; d.N = 1024; d.T = wb + W_PG; d.ldt = 1024; break;
    }
    return d;
}
__device__ __forceinline__ void convert_weights(const Params& P, int l, LAS unsigned char* lds) {
    const int tid = tid_opaque(), lane = tid & 63, wave = tid >> 6;
    LAS float* scr = (LAS float*)(lds + wave * 8704);
    const int gw = bid_opaque() * 8 + wave, NGW = gridDim.x * 8;
    for (int m = 0; m < 14; ++m) {
        const MatDesc d = get_mat(P, l, m);
        const int nblk = d.N / 32, nit = (d.K / 64) * nblk;
        for (int it = gw; it < nit; it += NGW) {
            const int kb = it / nblk, nb = it % nblk, k0 = 64 * kb, n0 = 32 * nb;
#pragma unroll 8
            for (int i = 0; i < 32; ++i) { const int kk = 2 * i + (lane >> 5); scr[kk * 33 + (lane & 31)] = d.W[(size_t)(k0 + kk) * d.ldw + d.col0 + n0 + (lane & 31)]; }
            LDSW();
            const int c = lane & 7;
#pragma unroll
            for (int j = 0; j < 4; ++j) { const int n = (lane >> 3) + 8 * j; const LAS float* s = scr + (8 * c) * 33 + n;
                u32x4 o; o.x = cvt_pk_bf16(s[0 * 33], s[1 * 33]); o.y = cvt_pk_bf16(s[2 * 33], s[3 * 33]); o.z = cvt_pk_bf16(s[4 * 33], s[5 * 33]); o.w = cvt_pk_bf16(s[6 * 33], s[7 * 33]);
                const int ng = n0 + n; const int drow = d.rowoff + (d.rowmode ? (256 * (ng >> 7) + (ng & 127)) : ng);
                *(u32x4*)(d.T + (size_t)drow * d.ldt + d.koff + k0 + 8 * c) = o; }
            LDSW();
        }
    }
    bf16_t* bd = (bf16_t*)(P.ws + WS_W) + W_BD;
    for (int e = bid_opaque() * 512 + tid; e < 1536 * 32; e += gridDim.x * 512) {
        const int row = e >> 5, k8 = (e & 31) * 8; const int blk = row >> 9;
        const bool diag = (blk == 0) ? (k8 < 64) : (blk == 1 ? (k8 >= 64 && k8 < 128) : (k8 >= 128));
        if (!diag) *(u32x4*)(bd + (size_t)row * 256 + k8) = (u32x4){0u, 0u, 0u, 0u};
    }
}

__device__ __forceinline__ void row_norm_pass(const Params& P, int l, int mode) {
    const int tid_ = tid_opaque(); const int lane = tid_ & 63, wave = tid_ >> 6;
    const int gw = bid_opaque() * 8 + wave, NGW = gridDim.x * 8;
    const float* gain = (mode == 2 ? PIN(27) : PIN(9)) + (size_t)l * DM;
    bf16_t* dst = (bf16_t*)(P.ws + (mode == 2 ? WS_ZB : WS_XNB));
    f32x4 gv[4];
#pragma unroll
    for (int j = 0; j < 4; ++j) gv[j] = *((const f32x4*)gain + lane + 64 * j);
    for (int r = gw; r < T_ALL; r += NGW) {
        const float* src = (mode == 0) ? (r < T_P ? PIN(0) + (size_t)r * DM : PIN(1) + (size_t)(r - T_P) * DM) : P.out + (size_t)r * DM;
        f32x4 v[4]; float s = 0.f;
#pragma unroll
        for (int j = 0; j < 4; ++j) { v[j] = *((const f32x4*)src + lane + 64 * j); s += v[j][0] * v[j][0] + v[j][1] * v[j][1] + v[j][2] * v[j][2] + v[j][3] * v[j][3]; }
        const float rs = rsqrtf(wave_sum(s) * (1.f / DM) + EPS);
#pragma unroll
        for (int j = 0; j < 4; ++j) {
            if (mode == 0) *((f32x4*)(P.out + (size_t)r * DM) + lane + 64 * j) = v[j];
            const f32x4 o = v[j] * rs * gv[j]; u32x2 w; w.x = cvt_pk_bf16(o[0], o[1]); w.y = cvt_pk_bf16(o[2], o[3]);
            *((u32x2*)(dst + (size_t)r * DM) + lane + 64 * j) = w; }
        if (mode == 2) {
            const float* pr = (r < T_P) ? PIN(2) + ((size_t)l * T_P + r) * 256 : PIN(3) + ((size_t)l * 1024 + (r - T_P)) * 256;
            const f32x4 pv = *((const f32x4*)pr + lane); u32x2 w; w.x = cvt_pk_bf16(pv[0], pv[1]); w.y = cvt_pk_bf16(pv[2], pv[3]);
            *((u32x2*)((bf16_t*)(P.ws + WS_LOB) + (size_t)r * 256) + lane) = w;
        }
    }
}
__device__ __forceinline__ void finish_pass(const Params& P, int l) {
    const int tid_ = tid_opaque(); const int lane = tid_ & 63, wave = tid_ >> 6;
    const int gw = bid_opaque() * 8 + wave, NGW = gridDim.x * 8;
    const float* gp = PIN(32) + (size_t)l * DM; const float* gn = PIN(9) + (size_t)(l < 1 ? l + 1 : l) * DM;
    bf16_t* GR = (bf16_t*)(P.ws + WS_ZB); bf16_t* EB = (bf16_t*)(P.ws + WS_XNB);
    for (int r = gw; r < T_ALL; r += NGW) {
        f32x4 x[4], gr[4], e[4]; float sx = 0.f, se = 0.f;
#pragma unroll
        for (int j = 0; j < 4; ++j) { x[j] = *((const f32x4*)(P.out + (size_t)r * DM) + lane + 64 * j);
            const u32x2 a = *((const u32x2*)(GR + (size_t)r * DM) + lane + 64 * j), b = *((const u32x2*)(EB + (size_t)r * DM) + lane + 64 * j);
            gr[j] = (f32x4){bflo(a.x), bfhi(a.x), bflo(a.y), bfhi(a.y)}; e[j] = (f32x4){bflo(b.x), bfhi(b.x), bflo(b.y), bfhi(b.y)};
#pragma unroll
            for (int k = 0; k < 4; ++k) { sx += x[j][k] * x[j][k]; se += e[j][k] * e[j][k]; } }
        const float rx = rsqrtf(wave_sum(sx) * (1.f / DM) + EPS), re = rsqrtf(wave_sum(se) * (1.f / DM) + EPS);
        float s2 = 0.f;
#pragma unroll
        for (int j = 0; j < 4; ++j) { const f32x4 g4 = *((const f32x4*)gp + lane + 64 * j);
#pragma unroll
            for (int k = 0; k < 4; ++k) { const float xn = x[j][k] + sigmoidf_(gr[j][k] * rx) * (e[j][k] * re * g4[k]); x[j][k] = xn; s2 += xn * xn; }
            *((f32x4*)(P.out + (size_t)r * DM) + lane + 64 * j) = x[j]; }
        if (l < 1) {
            const float r2 = rsqrtf(wave_sum(s2) * (1.f / DM) + EPS);
#pragma unroll
            for (int j = 0; j < 4; ++j) { const f32x4 g4 = *((const f32x4*)gn + lane + 64 * j); const f32x4 o = x[j] * r2 * g4; u32x2 w; w.x = cvt_pk_bf16(o[0], o[1]); w.y = cvt_pk_bf16(o[2], o[3]);
                *((u32x2*)(EB + (size_t)r * DM) + lane + 64 * j) = w; }
        }
    }
}

__device__ __forceinline__ void e1_phase(const Params& P, int l, LAS unsigned char* lds) {
    const int tid = tid_opaque(), tok = tid >> 3, sub = tid & 7, wave = tid >> 6, lane = tid & 63, fr = lane & 15, fq = lane >> 4;
    bf16_t* Z = (bf16_t*)(P.ws + WS_ZB);
    LAS bf16_t* L0 = (LAS bf16_t*)lds;
    LAS bf16_t* L1 = (LAS bf16_t*)(lds + 18432);
    for (int it = bid_opaque(); it < 528 * 7; it += gridDim.x) {
        const int tile = it / 7, job = it % 7, r0 = tile * 64, row = r0 + tok;
        const bool prompt = tile < 512; const int sr = row - T_P;
        bf16_t* zr = Z + (size_t)row * ZW;
        if (job < 2) {
            u32x4 rq[4], rk[4], rv[4];
#pragma unroll
            for (int q = 0; q < 4; ++q) { const int hc = (job * 4 + q) * 64 + sub * 8; rq[q] = *(const u32x4*)(zr + AQ + hc); rk[q] = *(const u32x4*)(zr + AK + hc); rv[q] = *(const u32x4*)(zr + AV + hc); }
            const float* gq = PIN(11) + l * 64 + sub * 8; const float* gk = PIN(12) + l * 64 + sub * 8;
#pragma unroll
            for (int q = 0; q < 4; ++q) { const int h = job * 4 + q; float f[8], o[8];
                unpack8(rq[q], f);
                float ss = 0.f;
#pragma unroll
                for (int e = 0; e < 8; ++e) ss += f[e] * f[e];
                float rs = rsqrtf(sum8(ss) * (1.f / 64.f) + EPS);
#pragma unroll
                for (int e = 0; e < 8; ++e) o[e] = f[e] * rs * gq[e];
                *(u32x4*)(zr + AQ + h * 64 + sub * 8) = pack8(o);
                unpack8(rk[q], f);
                ss = 0.f;
#pragma unroll
                for (int e = 0; e < 8; ++e) ss += f[e] * f[e];
                rs = rsqrtf(sum8(ss) * (1.f / 64.f) + EPS);
#pragma unroll
                for (int e = 0; e < 8; ++e) o[e] = f[e] * rs * gk[e];
                *(u32x4*)(zr + AK + h * 64 + sub * 8) = pack8(o);
                float vv[8]; const u32x4 vraw = rv[q]; unpack8(vraw, vv);
                float* ok = nullptr; float* ov = nullptr;
                if (prompt) { const int b = row >> 14, t = row & (SEQ - 1); if (t >= SEQ - 512) { const size_t o_ = (((size_t)(l * 2 + b) * 512 + (t - (SEQ - 512))) * 512 + h * 64 + sub * 8); ok = P.out + O_AKP + o_; ov = P.out + O_AVP + o_; } }
                else { const size_t o_ = ((size_t)(l * 1024 + sr) * 512 + h * 64 + sub * 8); ok = P.out + O_AKS + o_; ov = P.out + O_AVS + o_; }
                if (ok) { *(f32x4*)ok = (f32x4){o[0], o[1], o[2], o[3]}; *(f32x4*)(ok + 4) = (f32x4){o[4], o[5], o[6], o[7]};
                          *(f32x4*)ov = (f32x4){vv[0], vv[1], vv[2], vv[3]}; *(f32x4*)(ov + 4) = (f32x4){vv[4], vv[5], vv[6], vv[7]}; }
                if (prompt) {
#pragma unroll
                    for (int e = 0; e < 8; ++e) L0[q * 4608 + (sub * 8 + e) * 72 + tok] = ((const unsigned short*)&vraw)[e];
                } }
            if (prompt) {
                __syncthreads();
#pragma unroll
                for (int q = 0; q < 4; ++q) { const u32x4 w = *(const LAS u32x4*)(L0 + q * 4608 + tok * 72 + sub * 8);
                    *(u32x4*)(Z + (size_t)(r0 + tok) * ZW + AV + (job * 4 + q) * 64 + sub * 8) = w; }
                __syncthreads();
            }
        } else if (job < 6) {
            const int h = job - 2; const int pos = prompt ? (row & (SEQ - 1)) : (2048 + (sr & 31));
            float cs[8], sn[8];
#pragma unroll
            for (int e = 0; e < 8; ++e) { const float inv = __builtin_amdgcn_exp2f(-(float)(sub * 8 + e) * (13.287712379549449f / 64.f)); const float ang = (float)pos * inv;
                const float n = rintf(ang * 0.15915494309189535f); float rr = fmaf(-n, 6.2831855f, ang); rr = fmaf(-n, -1.7484555e-7f, rr); cs[e] = __cosf(rr); sn[e] = __sinf(rr); }
            float x1[8], x2[8], o1[8], o2[8];
            unpack8(*(const u32x4*)(zr + BQ + h * 128 + sub * 8), x1); unpack8(*(const u32x4*)(zr + BQ + h * 128 + 64 + sub * 8), x2);
#pragma unroll
            for (int e = 0; e < 8; ++e) { o1[e] = x1[e] * cs[e] - x2[e] * sn[e]; o2[e] = x1[e] * sn[e] + x2[e] * cs[e]; }
            *(u32x4*)(zr + BQ + h * 128 + sub * 8) = pack8(o1); *(u32x4*)(zr + BQ + h * 128 + 64 + sub * 8) = pack8(o2);
            unpack8(*(const u32x4*)(zr + BK + h * 128 + sub * 8), x1); unpack8(*(const u32x4*)(zr + BK + h * 128 + 64 + sub * 8), x2);
#pragma unroll
            for (int e = 0; e < 8; ++e) { o1[e] = (x1[e] * cs[e] - x2[e] * sn[e]) * 0.08838834764831845f; o2[e] = (x1[e] * sn[e] + x2[e] * cs[e]) * 0.08838834764831845f; }
            *(u32x4*)(zr + BK + h * 128 + sub * 8) = pack8(o1); *(u32x4*)(zr + BK + h * 128 + 64 + sub * 8) = pack8(o2);
            if (prompt) {
                const float dk = __builtin_amdgcn_exp2f(gamma_l2(h) * (float)(63 - tok));
                const u32x4 va = *(const u32x4*)(zr + BV + h * 128 + sub * 8), vb = *(const u32x4*)(zr + BV + h * 128 + 64 + sub * 8);
#pragma unroll
                for (int e = 0; e < 8; ++e) { L0[(sub * 8 + e) * 72 + tok] = f2bf(o1[e] * dk); L0[(64 + sub * 8 + e) * 72 + tok] = f2bf(o2[e] * dk);
                    L1[(sub * 8 + e) * 72 + tok] = ((const unsigned short*)&va)[e]; L1[(64 + sub * 8 + e) * 72 + tok] = ((const unsigned short*)&vb)[e]; }
                __syncthreads();
                const int b = row >> 14, c = (r0 & (SEQ - 1)) >> 6;
                bf16_t* St = (bf16_t*)(P.ws + WS_XNB) + ((size_t)((b * 4 + h) * 256 + c)) * 16384;
                const bf16x8 vb0 = *(const LAS bf16x8*)(L1 + (16 * wave + fr) * 72 + 8 * fq), vb1 = *(const LAS bf16x8*)(L1 + (16 * wave + fr) * 72 + 32 + 8 * fq);
#pragma unroll
                for (int dkt = 0; dkt < 8; ++dkt) {
                    const bf16x8 ka0 = *(const LAS bf16x8*)(L0 + (16 * dkt + fr) * 72 + 8 * fq), ka1 = *(const LAS bf16x8*)(L0 + (16 * dkt + fr) * 72 + 32 + 8 * fq);
                    f32x4 a = (f32x4){0.f, 0.f, 0.f, 0.f};
                    a = __builtin_amdgcn_mfma_f32_16x16x32_bf16(ka0, vb0, a, 0, 0, 0); a = __builtin_amdgcn_mfma_f32_16x16x32_bf16(ka1, vb1, a, 0, 0, 0);
                    u32x2 w; w.x = cvt_pk_bf16(a[0], a[1]); w.y = cvt_pk_bf16(a[2], a[3]);
                    *(u32x2*)(St + (size_t)(16 * wave + fr) * 128 + 16 * dkt + 4 * fq) = w;
                }
#pragma unroll
                for (int q = 0; q < 2; ++q) { const int idx = tid + q * 512, i = idx >> 4, hh = (idx >> 3) & 1, pc = idx & 7;
                    const u32x4 w = *(const LAS u32x4*)(L1 + (64 * hh + i) * 72 + pc * 8);
                    *(u32x4*)(Z + (size_t)(r0 + i) * ZW + BV + h * 128 + hh * 64 + pc * 8) = w; }
                __syncthreads();
            }
        } else {
            bool first; const float* sh = nullptr;
            if (prompt) first = (row & (SEQ - 1)) == 0; else { first = (sr & 31) == 0; sh = PIN(8) + ((size_t)l * 32 + (sr >> 5)) * 1792; }
            const float* mu = PIN(14) + (size_t)l * 1792;
            bf16_t* LO = (bf16_t*)(P.ws + WS_LOB) + (size_t)row * 256;
#pragma unroll
            for (int ch = 0; ch < 4; ++ch) { const int lc = sub * 32 + ch * 8, cp = 1536 + lc; float cur[8], prv[8], o[8];
                unpack8(*(const u32x4*)(zr + CLO + lc), cur);
                if (!first) unpack8(*(const u32x4*)(zr - ZW + CLO + lc), prv);
                else {
#pragma unroll
                    for (int e = 0; e < 8; ++e) prv[e] = sh ? sh[cp + e] : 0.f; }
#pragma unroll
                for (int e = 0; e < 8; ++e) { const float c_ = cur[e] + (prv[e] - cur[e]) * mu[cp + e];
                    o[e] = (lc < 64) ? (1.f - 2.f * __builtin_amdgcn_rcpf(__expf(2.f * c_) + 1.f)) : (lc < 128 ? c_ : sigmoidf_(c_)); }
                *(u32x4*)(LO + lc) = pack8(o); }
            bool lastt; float* so;
            if (prompt) { lastt = (row & (SEQ - 1)) == SEQ - 1; so = P.out + O_SHP + (size_t)(l * 2 + (row >> 14)) * 1792; }
            else { lastt = (sr & 31) == 31; so = P.out + O_SHS + (size_t)(l * 32 + (sr >> 5)) * 1792; }
            if (lastt) { for (int q = 0; q < 28; ++q) { const int c0 = (sub * 28 + q) * 8; float f[8]; unpack8(*(const u32x4*)(zr + CR + c0), f);
                    *(f32x4*)(so + c0) = (f32x4){f[0], f[1], f[2], f[3]}; *(f32x4*)(so + c0 + 4) = (f32x4){f[4], f[5], f[6], f[7]}; } }
            if (tid < 192) *(u32x4*)((bf16_t*)(P.ws + WS_CZB) + (size_t)tile * 1536 + tid * 8) = *(const u32x4*)(Z + (size_t)(r0 + 63) * ZW + CR + tid * 8);
        }
    }
}

__device__ __forceinline__ void p2_phase(const Params& P, int l, LAS unsigned char* lds) {
    bf16_t* Z = (bf16_t*)(P.ws + WS_ZB);
    for (int it = bid_opaque(); it < 64 + 128 + 512; it += gridDim.x) {
        const int tid = tid_opaque(), lane = tid & 63, wave = tid >> 6;
#ifdef DBG_P2_SKIP_SAMPLE
        if (it >= 64) continue;
#endif
        if (it < 64) {
            const int e4 = it * 512 + tid, chain = e4 >> 12, idx = (e4 & 4095) * 4, h = chain & 3, b = chain >> 2;
            const float g64 = __builtin_amdgcn_exp2f(gamma_l2(h) * 64.f);
            bf16_t* St = (bf16_t*)(P.ws + WS_XNB) + (size_t)chain * 256 * 16384 + idx;
            float s0 = 0.f, s1 = 0.f, s2 = 0.f, s3 = 0.f;
#pragma unroll 16
            for (int c = 0; c < 256; ++c) { const u32x2 d = *(const u32x2*)(St + (size_t)c * 16384);
                s0 = s0 * g64 + bflo(d.x); s1 = s1 * g64 + bfhi(d.x); s2 = s2 * g64 + bflo(d.y); s3 = s3 * g64 + bfhi(d.y);
                u32x2 w; w.x = cvt_pk_bf16(s0, s1); w.y = cvt_pk_bf16(s2, s3); *(u32x2*)(St + (size_t)c * 16384) = w; }
            const int dv = idx >> 7, dk = idx & 127; float* o = P.out + O_RETP + ((size_t)((l * 2 + b) * 4 + h)) * 16384 + dv;
            o[(size_t)dk * 128] = s0; o[(size_t)(dk + 1) * 128] = s1; o[(size_t)(dk + 2) * 128] = s2; o[(size_t)(dk + 3) * 128] = s3;
        } else if (it < 192) {
            const int si = it - 64, s = si >> 2, h = si & 3, rb = T_P + s * 32;
            LAS float* q = (LAS float*)lds; LAS float* k = q + 4096; LAS float* v = k + 4096; LAS float* A = v + 4096; LAS float* ob = A + 1024;
            const float lg = gamma_l2(h);
            { const int n = tid >> 4, sg = tid & 15; const bf16_t* zr = Z + (size_t)(rb + n) * ZW + h * 128 + sg * 8; float f[8];
              const u32x4 wq = *(const u32x4*)(zr + BQ), wk = *(const u32x4*)(zr + BK), wv = *(const u32x4*)(zr + BV);
              unpack8(wq, f); *(LAS f32x4*)(q + n * 128 + sg * 8) = (f32x4){f[0], f[1], f[2], f[3]}; *(LAS f32x4*)(q + n * 128 + sg * 8 + 4) = (f32x4){f[4], f[5], f[6], f[7]};
              unpack8(wk, f); *(LAS f32x4*)(k + n * 128 + sg * 8) = (f32x4){f[0], f[1], f[2], f[3]}; *(LAS f32x4*)(k + n * 128 + sg * 8 + 4) = (f32x4){f[4], f[5], f[6], f[7]};
              unpack8(wv, f); *(LAS f32x4*)(v + n * 128 + sg * 8) = (f32x4){f[0], f[1], f[2], f[3]}; *(LAS f32x4*)(v + n * 128 + sg * 8 + 4) = (f32x4){f[4], f[5], f[6], f[7]}; }
            __syncthreads();
            for (int e = tid; e < 1024; e += 512) { const int n = e >> 5, m = e & 31; float a = 0.f;
                if (m <= n) {
#pragma unroll 8
                    for (int d = 0; d < 128; d += 4) { const f32x4 q4 = *(const LAS f32x4*)(q + n * 128 + d), k4 = *(const LAS f32x4*)(k + m * 128 + d); a += q4[0] * k4[0] + q4[1] * k4[1] + q4[2] * k4[2] + q4[3] * k4[3]; }
                    a *= __builtin_amdgcn_exp2f(lg * (float)(n - m)); }
                A[e] = a; }
            __syncthreads();
            const float* S0 = PIN(6) + ((size_t)((l * 32 + s) * 4 + h)) * 16384;
            { const int e = tid & 127, ng = tid >> 7; float acc[8];
#pragma unroll
              for (int i = 0; i < 8; ++i) acc[i] = 0.f;
#pragma unroll 4
              for (int d = 0; d < 128; d += 4) { const float s0 = S0[(size_t)d * 128 + e], s1 = S0[(size_t)(d + 1) * 128 + e], s2 = S0[(size_t)(d + 2) * 128 + e], s3 = S0[(size_t)(d + 3) * 128 + e];
#pragma unroll
                  for (int i = 0; i < 8; ++i) { const f32x4 q4 = *(const LAS f32x4*)(q + (ng * 8 + i) * 128 + d); acc[i] += q4[0] * s0 + q4[1] * s1 + q4[2] * s2 + q4[3] * s3; } }
#pragma unroll
              for (int i = 0; i < 8; ++i) { const int n = ng * 8 + i; float a = acc[i] * __builtin_amdgcn_exp2f(lg * (float)(n + 1));
                  for (int m = 0; m <= n; ++m) a += A[n * 32 + m] * v[m * 128 + e];
                  ob[n * 128 + e] = a; }
              const int dg = tid >> 7; float* so = P.out + O_RETS + ((size_t)((l * 32 + s) * 4 + h)) * 16384; const float g32 = __builtin_amdgcn_exp2f(lg * 32.f);
              float vd[32];
#pragma unroll
              for (int m = 0; m < 32; ++m) vd[m] = v[m * 128 + e] * __builtin_amdgcn_exp2f(lg * (float)(31 - m));
#pragma unroll 2
              for (int d = dg * 32; d < dg * 32 + 32; d += 4) { float a0 = g32 * S0[(size_t)d * 128 + e], a1 = g32 * S0[(size_t)(d + 1) * 128 + e], a2 = g32 * S0[(size_t)(d + 2) * 128 + e], a3 = g32 * S0[(size_t)(d + 3) * 128 + e];
#pragma unroll
                  for (int m = 0; m < 32; ++m) { const f32x4 k4 = *(const LAS f32x4*)(k + m * 128 + d); a0 += k4[0] * vd[m]; a1 += k4[1] * vd[m]; a2 += k4[2] * vd[m]; a3 += k4[3] * vd[m]; }
                  so[(size_t)d * 128 + e] = a0; so[(size_t)(d + 1) * 128 + e] = a1; so[(size_t)(d + 2) * 128 + e] = a2; so[(size_t)(d + 3) * 128 + e] = a3; }
            }
            __syncthreads();
            { const int e = tid & 127, ng = tid >> 7;
              for (int i = 0; i < 8; ++i) { const int n = ng * 8 + i; float ss = 0.f;
#pragma unroll 8
                  for (int d = 0; d < 128; d += 4) { const f32x4 o4 = *(const LAS f32x4*)(ob + n * 128 + d); ss += o4[0] * o4[0] + o4[1] * o4[1] + o4[2] * o4[2] + o4[3] * o4[3]; }
                  const float rs = rsqrtf(ss * (1.f / 128.f) + EPS); bf16_t* zr = Z + (size_t)(rb + n) * ZW + h * 128 + e; const float gt = bf2f(zr[BG]);
                  zr[BQ] = f2bf(ob[n * 128 + e] * rs * gt * sigmoidf_(gt)); } }
            __syncthreads();
        } else {
            const int si = it - 192, s = si >> 4, h = (si >> 1) & 7, qh = si & 1, rb = T_P + s * 32, rq = rb + qh * 16;
            LAS float* q = (LAS float*)lds; LAS float* sc = q + 1024; LAS float* red = sc + 16 * 544;
            const float* ck = PIN(4) + ((size_t)(l * 32 + s) * 512) * 512 + h * 64; const float* cv = PIN(5) + ((size_t)(l * 32 + s) * 512) * 512 + h * 64;
            const float* bias = PIN(13) + (size_t)(l * 8 + h) * 320;
            for (int e = tid; e < 1024; e += 512) q[e] = bf2f(Z[(size_t)(rq + (e >> 6)) * ZW + AQ + h * 64 + (e & 63)]);
            __syncthreads();
            { const int key = tid; float kr[64];
#pragma unroll
                for (int d4 = 0; d4 < 16; ++d4) { const f32x4 t = *(const f32x4*)(ck + (size_t)key * 512 + d4 * 4); kr[d4 * 4] = t[0]; kr[d4 * 4 + 1] = t[1]; kr[d4 * 4 + 2] = t[2]; kr[d4 * 4 + 3] = t[3]; }
                for (int n = 0; n < 16; ++n) { float a = 0.f;
#pragma unroll
                    for (int d = 0; d < 64; ++d) a += q[n * 64 + d] * kr[d];
                    int rel = (512 + qh * 16 + n) - key; rel = rel > 256 ? 256 : rel;
                    sc[n * 544 + key] = a * 0.125f + bias[rel + 63]; } }
            { const int key = 512 + (tid & 31), n = tid >> 5; float kr[64];
#pragma unroll
                for (int d8 = 0; d8 < 8; ++d8) unpack8(*(const u32x4*)(Z + (size_t)(rb + key - 512) * ZW + AK + h * 64 + d8 * 8), kr + d8 * 8);
                float a = 0.f;
#pragma unroll
                for (int d = 0; d < 64; ++d) a += q[n * 64 + d] * kr[d];
                const int rel = (512 + qh * 16 + n) - key;
                sc[n * 544 + key] = a * 0.125f + bias[rel + 63]; }
            __syncthreads();
            for (int n = wave * 2; n < wave * 2 + 2; ++n) { float mx = -1e30f;
                for (int kx = lane; kx < 544; kx += 64) mx = fmaxf(mx, sc[n * 544 + kx]);
#pragma unroll
                for (int o = 1; o < 64; o <<= 1) mx = fmaxf(mx, __shfl_xor(mx, o));
                float sm = 0.f;
                for (int kx = lane; kx < 544; kx += 64) { const float p = __expf(sc[n * 544 + kx] - mx); sc[n * 544 + kx] = p; sm += p; }
                sm = wave_sum(sm); const float inv = 1.f / sm;
                for (int kx = lane; kx < 544; kx += 64) sc[n * 544 + kx] *= inv; }
            __syncthreads();
            { const int d = tid & 63, kg = tid >> 6; float a[16];
#pragma unroll
              for (int n = 0; n < 16; ++n) a[n] = 0.f;
              float vv[68];
#pragma unroll
              for (int i = 0; i < 68; ++i) { const int key = kg * 68 + i; vv[i] = key < 512 ? cv[(size_t)key * 512 + d] : bf2f(Z[(size_t)(rb + key - 512) * ZW + AV + h * 64 + d]); }
#pragma unroll
              for (int i = 0; i < 68; i += 4)
#pragma unroll
                  for (int n = 0; n < 16; ++n) { const f32x4 p4 = *(const LAS f32x4*)(sc + n * 544 + kg * 68 + i); a[n] += p4[0] * vv[i] + p4[1] * vv[i + 1] + p4[2] * vv[i + 2] + p4[3] * vv[i + 3]; }
#pragma unroll
              for (int n = 0; n < 16; ++n) red[(kg * 16 + n) * 64 + d] = a[n]; }
            __syncthreads();
            for (int e = tid; e < 1024; e += 512) { const int n = e >> 6, d = e & 63; float a = 0.f;
#pragma unroll
                for (int kg = 0; kg < 8; ++kg) a += red[(kg * 16 + n) * 64 + d];
                Z[(size_t)(rq + n) * ZW + AQ + h * 64 + d] = f2bf(a); }
            __syncthreads();
        }
    }
}

__device__ __forceinline__ void p3_phase(const Params& P, int l, LAS unsigned char* lds) {
    const int tid = tid_opaque(), lane = tid & 63, wave = tid >> 6, fr = lane & 15, fq = lane >> 4;
    bf16_t* Z = (bf16_t*)(P.ws + WS_ZB);
    {
        const int qs = wave & 3, dh = wave >> 2;
        LAS bf16_t* SL = (LAS bf16_t*)lds;
        LAS bf16_t* KL = (LAS bf16_t*)(lds + 34816);
        LAS bf16_t* VL = (LAS bf16_t*)(lds + 52224);
        LAS float* XL = (LAS float*)(lds + 70656);
        u32x4 gs[4], gk[2], gv[2];
#define RT_LOAD(it_) do { const int h_ = (it_) & 3, c_ = ((it_) >> 2) & 255, b_ = (it_) >> 10; const size_t cb_ = (size_t)(b_ * SEQ + c_ * 64); \
        const bf16_t* St_ = (const bf16_t*)(P.ws + WS_XNB) + ((size_t)((b_ * 4 + h_) * 256 + (c_ > 0 ? c_ - 1 : 0))) * 16384; \
        _Pragma("unroll") for (int i_ = 0; i_ < 4; ++i_) { const int p_ = tid + 512 * i_; gs[i_] = *(const u32x4*)(St_ + (p_ >> 4) * 128 + (p_ & 15) * 8); } \
        _Pragma("unroll") for (int i_ = 0; i_ < 2; ++i_) { const int p_ = tid + 512 * i_, r_ = p_ >> 4, sg_ = p_ & 15; gk[i_] = *(const u32x4*)(Z + (cb_ + r_) * ZW + BK + h_ * 128 + sg_ * 8); gv[i_] = *(const u32x4*)(Z + (cb_ + r_) * ZW + BV + h_ * 128 + sg_ * 8); } } while (0)
#define RT_WRITE() do { _Pragma("unroll") for (int i_ = 0; i_ < 4; ++i_) { const int p_ = tid + 512 * i_; *(LAS u32x4*)(SL + (p_ >> 4) * 136 + (p_ & 15) * 8) = gs[i_]; } \
        _Pragma("unroll") for (int i_ = 0; i_ < 2; ++i_) { const int p_ = tid + 512 * i_, r_ = p_ >> 4, sg_ = p_ & 15; *(LAS u32x4*)(KL + r_ * 136 + sg_ * 8) = gk[i_]; *(LAS u32x4*)(VL + ((sg_ >> 3) * 64 + r_) * 72 + (sg_ & 7) * 8) = gv[i_]; } } while (0)
        int it = bid_opaque();
        if (it < 2048) RT_LOAD(it);
        for (; it < 2048; it += gridDim.x) {
            const int h = it & 3, c = (it >> 2) & 255, b = it >> 10;
            const int cb = b * SEQ + c * 64, qrow = cb + qs * 16 + fr; const float lg = gamma_l2(h);
            bf16x8 qf[4];
#pragma unroll
            for (int kk = 0; kk < 4; ++kk) qf[kk] = *(const bf16x8*)(Z + (size_t)qrow * ZW + BQ + h * 128 + 32 * kk + 8 * fq);
            RT_WRITE();
            __syncthreads();
            if (it + (int)gridDim.x < 2048) RT_LOAD(it + (int)gridDim.x);
            f32x4 acc[4];
#pragma unroll
            for (int dt = 0; dt < 4; ++dt) acc[dt] = (f32x4){0.f, 0.f, 0.f, 0.f};
            if (c > 0) {
#pragma unroll
                for (int dt = 0; dt < 4; ++dt)
#pragma unroll
                    for (int kk = 0; kk < 4; ++kk) acc[dt] = __builtin_amdgcn_mfma_f32_16x16x32_bf16(*(const LAS bf16x8*)(SL + (16 * (4 * dh + dt) + fr) * 136 + 32 * kk + 8 * fq), qf[kk], acc[dt], 0, 0, 0);
                const float dq = __builtin_amdgcn_exp2f(lg * (float)(qs * 16 + fr + 1));
#pragma unroll
                for (int dt = 0; dt < 4; ++dt) acc[dt] = acc[dt] * dq;
            }
            const int nu = (qs >> 1) + 1;
            for (int u = 0; u < nu; ++u) {
                unsigned pw[4];
#pragma unroll
                for (int t = 0; t < 2; ++t) { f32x4 sc_ = (f32x4){0.f, 0.f, 0.f, 0.f};
#pragma unroll
                    for (int kk = 0; kk < 4; ++kk) sc_ = __builtin_amdgcn_mfma_f32_16x16x32_bf16(*(const LAS bf16x8*)(KL + (32 * u + 16 * t + fr) * 136 + 32 * kk + 8 * fq), qf[kk], sc_, 0, 0, 0);
                    float pv[4];
#pragma unroll
                    for (int j = 0; j < 4; ++j) { const int n = qs * 16 + fr, m = 32 * u + 16 * t + 4 * fq + j; pv[j] = (m <= n) ? sc_[j] * __builtin_amdgcn_exp2f(lg * (float)(n - m)) : 0.f; }
                    pw[t * 2] = cvt_pk_bf16(pv[0], pv[1]); pw[t * 2 + 1] = cvt_pk_bf16(pv[2], pv[3]); }
                u32x4 w4; w4.x = pw[0]; w4.y = pw[1]; w4.z = pw[2]; w4.w = pw[3]; const bf16x8 pf = __builtin_bit_cast(bf16x8, w4);
#pragma unroll
                for (int dt = 0; dt < 4; ++dt) { const LAS bf16_t* vp = VL + (16 * (4 * dh + dt) + fr) * 72 + 32 * u + 4 * fq;
                    const u32x2 v0 = *(const LAS u32x2*)vp, v1 = *(const LAS u32x2*)(vp + 16); u32x4 w; w.x = v0.x; w.y = v0.y; w.z = v1.x; w.w = v1.y;
                    acc[dt] = __builtin_amdgcn_mfma_f32_16x16x32_bf16(__builtin_bit_cast(bf16x8, w), pf, acc[dt], 0, 0, 0); }
            }
            float ss = 0.f;
#pragma unroll
            for (int dt = 0; dt < 4; ++dt) ss += acc[dt][0] * acc[dt][0] + acc[dt][1] * acc[dt][1] + acc[dt][2] * acc[dt][2] + acc[dt][3] * acc[dt][3];
            ss += __shfl_xor(ss, 16); ss += __shfl_xor(ss, 32);
            if (fq == 0) XL[(qs * 2 + dh) * 16 + fr] = ss;
            __syncthreads();
            const float rs = rsqrtf((XL[(qs * 2) * 16 + fr] + XL[(qs * 2 + 1) * 16 + fr]) * (1.f / 128.f) + EPS);
#pragma unroll
            for (int dt = 0; dt < 4; ++dt) { const int dvc = 16 * (4 * dh + dt) + 4 * fq; const u32x2 gw = *(const u32x2*)(Z + (size_t)qrow * ZW + BG + h * 128 + dvc);
                const float g0 = bflo(gw.x), g1 = bfhi(gw.x), g2 = bflo(gw.y), g3 = bfhi(gw.y); u32x2 w;
                w.x = cvt_pk_bf16(acc[dt][0] * rs * g0 * sigmoidf_(g0), acc[dt][1] * rs * g1 * sigmoidf_(g1)); w.y = cvt_pk_bf16(acc[dt][2] * rs * g2 * sigmoidf_(g2), acc[dt][3] * rs * g3 * sigmoidf_(g3));
                *(u32x2*)(Z + (size_t)qrow * ZW + BQ + h * 128 + dvc) = w; }
        }
        __syncthreads();
    }
}

__device__ __forceinline__ void attn_item(const Params& P, int l, LAS unsigned char* lds, int it, int tid) {
    const int lane = tid & 63, wave = tid >> 6, fr = lane & 15, fq = lane >> 4;
    bf16_t* Z = (bf16_t*)(P.ws + WS_ZB);
    {

            const int ia = it - 1024, hp = ia & 3, c = (ia >> 2) & 255, b = ia >> 10, hsel = wave >> 2, h = hp * 2 + hsel, qs = wave & 3;
            const int sb = b * SEQ, qpos = c * 64 + qs * 16 + fr; const size_t qrow = (size_t)(sb + qpos);
            LAS bf16_t* KS = (LAS bf16_t*)lds;
            LAS bf16_t* VS = (LAS bf16_t*)(lds + 36864);
            LAS float* BL = (LAS float*)(lds + 73728);
            const bf16x8 q0 = *(const bf16x8*)(Z + qrow * ZW + AQ + h * 64 + 8 * fq), q1 = *(const bf16x8*)(Z + qrow * ZW + AQ + h * 64 + 32 + 8 * fq);
            f32x4 acc[4];
#pragma unroll
            for (int dt = 0; dt < 4; ++dt) acc[dt] = (f32x4){0.f, 0.f, 0.f, 0.f};
            float mrun = -1e30f, lrun = 0.f;
            const int jlo = c >= 8 ? 0 : 8 - c;
            u32x4 gk[2], gv[2];
#define AT_LOAD(j_) do { const size_t rb_ = (size_t)(sb + (c - 8 + (j_)) * 64); _Pragma("unroll") for (int i_ = 0; i_ < 2; ++i_) { const int p_ = tid + 512 * i_, hd_ = p_ >> 9, r_ = (p_ >> 3) & 63, sg_ = p_ & 7; \
        gk[i_] = *(const u32x4*)(Z + (rb_ + r_) * ZW + AK + (hp * 2 + hd_) * 64 + sg_ * 8); gv[i_] = *(const u32x4*)(Z + (rb_ + r_) * ZW + AV + (hp * 2 + hd_) * 64 + sg_ * 8); } } while (0)
#define AT_WRITE(st_) do { _Pragma("unroll") for (int i_ = 0; i_ < 2; ++i_) { const int p_ = tid + 512 * i_, hd_ = p_ >> 9, r_ = (p_ >> 3) & 63, sg_ = p_ & 7; \
        *(LAS u32x4*)(KS + ((st_) * 2 + hd_) * 4608 + r_ * 72 + sg_ * 8) = gk[i_]; *(LAS u32x4*)(VS + ((st_) * 2 + hd_) * 4608 + r_ * 72 + sg_ * 8) = gv[i_]; } } while (0)
            AT_LOAD(jlo);
            for (int e = tid; e < 640; e += 512) BL[e] = PIN(13)[(size_t)(l * 8 + hp * 2) * 320 + e] * 1.4426950408889634f;
            AT_WRITE(0);
            __syncthreads();
            for (int j = jlo; j < 9; ++j) {
                const int st = (j - jlo) & 1;
                if (j < 8) AT_LOAD(j + 1);
                const LAS bf16_t* ks = KS + (st * 2 + hsel) * 4608; const LAS bf16_t* vs = VS + (st * 2 + hsel) * 4608; const LAS float* bl = BL + hsel * 320;
#pragma unroll
                for (int u = 0; u < 2; ++u) {
                    const int kb = (c - 8 + j) * 64 + 32 * u;
                    float sv[8];
#pragma unroll
                    for (int t = 0; t < 2; ++t) { const LAS bf16_t* kp = ks + (32 * u + 16 * t + fr) * 72 + 8 * fq;
                        f32x4 sc_ = (f32x4){0.f, 0.f, 0.f, 0.f};
                        sc_ = __builtin_amdgcn_mfma_f32_16x16x32_bf16(*(const LAS bf16x8*)kp, q0, sc_, 0, 0, 0); sc_ = __builtin_amdgcn_mfma_f32_16x16x32_bf16(*(const LAS bf16x8*)(kp + 32), q1, sc_, 0, 0, 0);
                        if (j <= 3) {
                            const float bc = bl[319];
#pragma unroll
                            for (int jj = 0; jj < 4; ++jj) sv[t * 4 + jj] = sc_[jj] * 0.18033688011112042f + bc;
                        } else {
#pragma unroll
                            for (int jj = 0; jj < 4; ++jj) { int rel = qpos - (kb + 16 * t + 4 * fq + jj); rel = rel > 256 ? 256 : rel; sv[t * 4 + jj] = sc_[jj] * 0.18033688011112042f + bl[rel + 63]; }
                        } }
                    float mx = sv[0];
#pragma unroll
                    for (int e = 1; e < 8; ++e) mx = fmaxf(mx, sv[e]);
                    mx = fmaxf(mx, __shfl_xor(mx, 16)); mx = fmaxf(mx, __shfl_xor(mx, 32));
                    const float mnew = fmaxf(mrun, mx), alpha = __builtin_amdgcn_exp2f(mrun - mnew); mrun = mnew;
                    float ps = 0.f;
#pragma unroll
                    for (int e = 0; e < 8; ++e) { sv[e] = __builtin_amdgcn_exp2f(sv[e] - mnew); ps += sv[e]; }
                    lrun = lrun * alpha + ps;
                    u32x4 pw; pw.x = cvt_pk_bf16(sv[0], sv[1]); pw.y = cvt_pk_bf16(sv[2], sv[3]); pw.z = cvt_pk_bf16(sv[4], sv[5]); pw.w = cvt_pk_bf16(sv[6], sv[7]);
                    const bf16x8 pf = __builtin_bit_cast(bf16x8, pw);
#pragma unroll
                    for (int dt = 0; dt < 4; ++dt) { const LAS bf16_t* vp = vs + (16 * dt + fr) * 72 + 32 * u + 4 * fq;
                        const u32x2 v0 = *(const LAS u32x2*)vp, v1 = *(const LAS u32x2*)(vp + 16); u32x4 w; w.x = v0.x; w.y = v0.y; w.z = v1.x; w.w = v1.y;
                        acc[dt] = acc[dt] * alpha;
                        acc[dt] = __builtin_amdgcn_mfma_f32_16x16x32_bf16(__builtin_bit_cast(bf16x8, w), pf, acc[dt], 0, 0, 0); }
                }
                if (j < 8) AT_WRITE(st ^ 1);
                __syncthreads();
            }
            lrun += __shfl_xor(lrun, 16); lrun += __shfl_xor(lrun, 32);
            const float inv = 1.f / lrun;
#pragma unroll
            for (int dt = 0; dt < 4; ++dt) { u32x2 w; w.x = cvt_pk_bf16(acc[dt][0] * inv, acc[dt][1] * inv); w.y = cvt_pk_bf16(acc[dt][2] * inv, acc[dt][3] * inv);
                *(u32x2*)(Z + qrow * ZW + AQ + h * 64 + 16 * dt + 4 * fq) = w; }
    }
}

__device__ __forceinline__ void c2_phase(const Params& P, int l, LAS unsigned char* lds) {
    const int tid = tid_opaque(), tok = tid >> 3, sub = tid & 7;
    bf16_t* Z = (bf16_t*)(P.ws + WS_ZB); bf16_t* XW = (bf16_t*)(P.ws + WS_XNB);
    (void)lds;
    for (int it = bid_opaque(); it < 528 * 4; it += gridDim.x) {
        const int tile = it >> 2, hp = it & 3, r0 = tile * 64, row = r0 + tok; const bool prompt = tile < 512; const int sr = row - T_P;
        const bool sfirst = !prompt && (sr & 31) == 0; const float* sh = sfirst ? PIN(8) + ((size_t)l * 32 + (sr >> 5)) * 1792 : nullptr;
        const bool pzero = prompt && tok == 0 && (r0 & (SEQ - 1)) == 0;
        const bf16_t* prow = (tok > 0) ? Z + (size_t)(row - 1) * ZW + CR : (const bf16_t*)(P.ws + WS_CZB) + (size_t)(tile > 0 ? tile - 1 : 0) * 1536;
        u32x4 cu[2][3], pv_[2][3], wa[2][2];
#pragma unroll
        for (int q = 0; q < 2; ++q) { const int hc = (hp * 2 + q) * 64 + sub * 8;
#pragma unroll
            for (int part = 0; part < 3; ++part) { cu[q][part] = *(const u32x4*)(Z + (size_t)row * ZW + CR + part * 512 + hc); pv_[q][part] = *(const u32x4*)(prow + part * 512 + hc); }
            wa[q][0] = *(const u32x4*)(XW + (size_t)row * DM + hc); wa[q][1] = *(const u32x4*)(XW + (size_t)row * DM + 512 + hc); }
        asm volatile("s_waitcnt vmcnt(0)" ::: "memory");
        __syncthreads();
        const float* mu = PIN(14) + (size_t)l * 1792;
#pragma unroll
        for (int q = 0; q < 2; ++q) { const int h = hp * 2 + q, hc = h * 64 + sub * 8;
            float r[8], k[8], v[8], wr_[8], ar_[8], kk[8], pr[8], pk[8], pvv[8];
            unpack8(cu[q][0], r); unpack8(cu[q][1], k); unpack8(cu[q][2], v); unpack8(pv_[q][0], pr); unpack8(pv_[q][1], pk); unpack8(pv_[q][2], pvv); unpack8(wa[q][0], wr_); unpack8(wa[q][1], ar_);
#pragma unroll
            for (int e = 0; e < 8; ++e) { float a_ = pr[e], b_ = pk[e], c_ = pvv[e];
                if (sfirst) { a_ = sh[hc + e]; b_ = sh[512 + hc + e]; c_ = sh[1024 + hc + e]; } else if (pzero) { a_ = 0.f; b_ = 0.f; c_ = 0.f; }
                r[e] = r[e] + (a_ - r[e]) * mu[hc + e]; k[e] = k[e] + (b_ - k[e]) * mu[512 + hc + e]; v[e] = v[e] + (c_ - v[e]) * mu[1024 + hc + e]; }
            const float* w0 = PIN(15) + l * 512 + hc; const float* a0 = PIN(17) + l * 512 + hc; const float* kkw = PIN(20) + l * 512 + hc; const float* kaw = PIN(21) + l * 512 + hc; const float* rk = PIN(22) + l * 512 + hc;
            float ss = 0.f, bn = 0.f;
#pragma unroll
            for (int e = 0; e < 8; ++e) { kk[e] = k[e] * kkw[e]; ss += kk[e] * kk[e]; }
            const float rn = rsqrtf(fmaxf(sum8(ss), 1e-24f));
#pragma unroll
            for (int e = 0; e < 8; ++e) { const float a = sigmoidf_(a0[e] + ar_[e]); const float ew = 0.6065306597126334f * sigmoidf_(w0[e] + wr_[e]);
                kk[e] *= rn; k[e] = k[e] * (1.f + (a - 1.f) * kaw[e]); bn += r[e] * k[e] * rk[e]; wr_[e] = ew; ar_[e] = kk[e] * a; }
            bn = sum8(bn);
            *(u32x4*)(Z + (size_t)row * ZW + CR + hc) = pack8(r); *(u32x4*)(Z + (size_t)row * ZW + CK + hc) = pack8(k); *(u32x4*)(Z + (size_t)row * ZW + CV + hc) = pack8(v);
            *(u32x4*)(Z + (size_t)row * ZW + BV + hc) = pack8(kk); *(u32x4*)(XW + (size_t)row * DM + hc) = pack8(wr_); *(u32x4*)(XW + (size_t)row * DM + 512 + hc) = pack8(ar_);
            if (sub == 0) ((float*)(P.ws + WS_BONUS))[(size_t)row * 8 + h] = bn; }
        __syncthreads();
    }
}

__device__ __forceinline__ void scan_phase(const Params& P, int l, LAS unsigned char* lds) {
    const int tid = tid_opaque(), lane = tid & 63, wave = tid >> 6;
    bf16_t* Z = (bf16_t*)(P.ws + WS_ZB); const bf16_t* XW = (const bf16_t*)(P.ws + WS_XNB);
    LAS float* buf = (LAS float*)lds;
    LAS float* ybuf = (LAS float*)(lds + 86016);
    const int bid_ = bid_opaque(), nidle_ = (int)gridDim.x > 192 ? (int)gridDim.x - 192 : 0;
    for (int it = (bid_ < 192 || nidle_ == 0) ? bid_ : 192 + (bid_ - 192); it < 192 + 1024; it += (bid_ < 192 ? (nidle_ ? 100000 : (int)gridDim.x) : nidle_)) {
        int rowbase, nsteps, h, qt, part = 0; const float* S0 = nullptr; float* So; bf16_t* yout; size_t ypitch = ZW;
        if (it < 192) { const int chain = it / 12, sub12 = it % 12, b = chain >> 3; h = chain & 7; part = sub12 >> 2; qt = sub12 & 3; nsteps = SEQ / 2; rowbase = b * SEQ + (part ? SEQ / 2 : 0);
            So = (float*)(P.ws + (part == 0 ? WS_SMID : (part == 1 ? WS_SP1 : WS_PHI))) + (size_t)chain * 4096;
            if (part < 2) yout = Z + (size_t)rowbase * ZW + BK + h * 64 + qt * 16; else { yout = (bf16_t*)(P.ws + WS_YPHI) + (size_t)b * (SEQ / 2) * 512 + h * 64 + qt * 16; ypitch = 512; } }
        else { const int si = it - 192, s = si >> 5; h = (si >> 2) & 7; qt = si & 3; rowbase = T_P + s * 32; nsteps = 32; S0 = PIN(7) + ((size_t)((l * 32 + s) * 8 + h)) * 4096; So = P.out + O_RWS + ((size_t)((l * 32 + s) * 8 + h)) * 4096;
            yout = Z + (size_t)rowbase * ZW + BK + h * 64 + qt * 16; }
        const int i0 = qt * 16, nb = nsteps >> 5;
        const int lt = tid - 256, lstep = lt >> 3, lsub = lt & 7;
        const int rr = lane >> 4, jl = lane & 15, li = 4 * wave + rr;
        f32x2v Sa = {0.f, 0.f}, Sb = {0.f, 0.f};
        u32x4 g_ew = {0u,0u,0u,0u}, g_k = g_ew, g_kk = g_ew, g_ka = g_ew, g_r = g_ew, g_v = g_ew;
        if (wave < 4 && S0) { const f32x4 s4 = *(const f32x4*)(S0 + (size_t)(i0 + li) * 64 + 4 * jl); Sa = (f32x2v){s4[0], s4[1]}; Sb = (f32x2v){s4[2], s4[3]}; }
        if (part == 2) { const int d_ = i0 + li - 4 * jl; Sa = (f32x2v){d_ == 0 ? 1.f : 0.f, d_ == 1 ? 1.f : 0.f}; Sb = (f32x2v){d_ == 2 ? 1.f : 0.f, d_ == 3 ? 1.f : 0.f}; }
        for (int bb = -1; bb < nb; ++bb) {
            if (wave >= 4) {
#define SC_LOAD(bt) do { const size_t row_ = (size_t)(rowbase + (bt) * 32 + lstep); g_ew = *(const u32x4*)(XW + row_ * DM + h * 64 + lsub * 8); g_k = *(const u32x4*)(Z + row_ * ZW + CK + h * 64 + lsub * 8); \
        g_kk = *(const u32x4*)(Z + row_ * ZW + BV + h * 64 + lsub * 8); g_ka = *(const u32x4*)(XW + row_ * DM + 512 + h * 64 + lsub * 8); g_r = *(const u32x4*)(Z + row_ * ZW + CR + h * 64 + lsub * 8); \
        if (lsub < 2 && part != 2) g_v = *(const u32x4*)(Z + row_ * ZW + CV + h * 64 + i0 + lsub * 8); } while (0)
#define SC_WRITE(bt) do { LAS float* d = buf + ((bt) & 1) * 10752 + lstep * 336; float f[8]; unpack8(g_ew, f); \
        *(LAS f32x4*)(d + lsub * 8) = (f32x4){__expf(-f[0]), __expf(-f[1]), __expf(-f[2]), __expf(-f[3])}; *(LAS f32x4*)(d + lsub * 8 + 4) = (f32x4){__expf(-f[4]), __expf(-f[5]), __expf(-f[6]), __expf(-f[7])}; \
        unpack8(g_k, f); *(LAS f32x4*)(d + 64 + lsub * 8) = (f32x4){f[0], f[1], f[2], f[3]}; *(LAS f32x4*)(d + 64 + lsub * 8 + 4) = (f32x4){f[4], f[5], f[6], f[7]}; \
        unpack8(g_kk, f); *(LAS f32x4*)(d + 128 + lsub * 8) = (f32x4){f[0], f[1], f[2], f[3]}; *(LAS f32x4*)(d + 128 + lsub * 8 + 4) = (f32x4){f[4], f[5], f[6], f[7]}; \
        unpack8(g_ka, f); *(LAS f32x4*)(d + 192 + lsub * 8) = (f32x4){f[0], f[1], f[2], f[3]}; *(LAS f32x4*)(d + 192 + lsub * 8 + 4) = (f32x4){f[4], f[5], f[6], f[7]}; \
        unpack8(g_r, f); *(LAS f32x4*)(d + 256 + lsub * 8) = (f32x4){f[0], f[1], f[2], f[3]}; *(LAS f32x4*)(d + 256 + lsub * 8 + 4) = (f32x4){f[4], f[5], f[6], f[7]}; \
        if (lsub < 2) { unpack8(g_v, f); *(LAS f32x4*)(d + 320 + lsub * 8) = (f32x4){f[0], f[1], f[2], f[3]}; *(LAS f32x4*)(d + 320 + lsub * 8 + 4) = (f32x4){f[4], f[5], f[6], f[7]}; } } while (0)
                if (bb == -1) { SC_LOAD(0); SC_WRITE(0); if (nb > 1) SC_LOAD(1); }
                else { if (bb + 1 < nb) SC_WRITE(bb + 1); if (bb + 2 < nb) SC_LOAD(bb + 2); }
                if (bb >= 1 && lsub < 2) {
                    const LAS float* y = ybuf + ((bb - 1) & 1) * 512 + lstep * 16 + lsub * 8; float f[8];
#pragma unroll
                    for (int e = 0; e < 8; ++e) f[e] = y[e];
                    *(u32x4*)(yout + (size_t)((bb - 1) * 32 + lstep) * ypitch + lsub * 8) = pack8(f);
                }
            } else if (bb >= 0) {
                __builtin_amdgcn_s_setprio(3);
                const LAS float* bp = buf + (bb & 1) * 10752 + 4 * jl; const LAS float* vp_ = buf + (bb & 1) * 10752 + 320 + li; LAS float* yb = ybuf + (bb & 1) * 512;
                float ysel = 0.f, yprev = 0.f;
                f32x4 cw = *(const LAS f32x4*)(bp), ck_ = *(const LAS f32x4*)(bp + 64), ckk = *(const LAS f32x4*)(bp + 128), cka = *(const LAS f32x4*)(bp + 192), cr = *(const LAS f32x4*)(bp + 256); float cv = vp_[0];
                f32x2v m = Sa * (f32x2v){ckk[0], ckk[1]}; m = Sb * (f32x2v){ckk[2], ckk[3]} + m;
                float a = m.x + m.y;
#pragma unroll
                for (int st = 0; st < 32; ++st) {
                    const int sn = (st + 1 < 32) ? st + 1 : st;
                    const f32x4 nw = *(const LAS f32x4*)(bp + sn * 336), nk = *(const LAS f32x4*)(bp + sn * 336 + 64), nkk = *(const LAS f32x4*)(bp + sn * 336 + 128), nka = *(const LAS f32x4*)(bp + sn * 336 + 192), nr = *(const LAS f32x4*)(bp + sn * 336 + 256); const float nv = vp_[sn * 336];
                    float b = yprev;
                    a += dppf<0xB1>(a); b += dppf<0xB1>(b); a += dppf<0x4E>(a); b += dppf<0x4E>(b); a += dppf<0x141>(a); b += dppf<0x141>(b); a += dppf<0x140>(a); b += dppf<0x140>(b);
                    if (st > 0) { ysel = (jl == ((st - 1) & 3)) ? b : ysel; if (((st - 1) & 3) == 3 && jl < 4) yb[(st - 4 + jl) * 16 + li] = ysel; }
                    const float nsa = -a; const f32x2v vi2 = {cv, cv}, ns2 = {nsa, nsa};
                    const f32x2v ta = (f32x2v){cka[0], cka[1]} * ns2 + (f32x2v){ck_[0], ck_[1]} * vi2, tb = (f32x2v){cka[2], cka[3]} * ns2 + (f32x2v){ck_[2], ck_[3]} * vi2;
                    Sa = Sa * (f32x2v){cw[0], cw[1]} + ta; Sb = Sb * (f32x2v){cw[2], cw[3]} + tb;
                    f32x2v ym = Sa * (f32x2v){cr[0], cr[1]}; ym = Sb * (f32x2v){cr[2], cr[3]} + ym; yprev = ym.x + ym.y;
                    f32x2v mm = Sa * (f32x2v){nkk[0], nkk[1]}; mm = Sb * (f32x2v){nkk[2], nkk[3]} + mm; a = mm.x + mm.y;
                    cw = nw; ck_ = nk; ckk = nkk; cka = nka; cr = nr; cv = nv;
                }
                { float b = red16(yprev); ysel = (jl == 3) ? b : ysel; if (jl < 4) yb[(28 + jl) * 16 + li] = ysel; }
                __builtin_amdgcn_s_setprio(0);
            }
            __syncthreads();
        }
        if (wave >= 4 && lsub < 2) { const LAS float* y = ybuf + ((nb - 1) & 1) * 512 + lstep * 16 + lsub * 8; float f[8];
#pragma unroll
            for (int e = 0; e < 8; ++e) f[e] = y[e];
            *(u32x4*)(yout + (size_t)((nb - 1) * 32 + lstep) * ypitch + lsub * 8) = pack8(f); }
        if (wave < 4) *(f32x4*)(So + (size_t)(i0 + li) * 64 + 4 * jl) = (f32x4){Sa.x, Sa.y, Sb.x, Sb.y};
        __syncthreads();
    }
    {
        unsigned* ctr = (unsigned*)(P.ws + 14336) + l;
        LAS int* slot = (LAS int*)(lds + 131072 + 1024);
        int nxt = 0;
        if (tid == 0) nxt = (int)atomicAdd(ctr, 1u);
        for (;;) {
            __syncthreads();
            if (tid == 0) { slot[0] = nxt; nxt = (int)atomicAdd(ctr, 1u); }
            __syncthreads();
            const int idx = slot[0];
            if (idx >= 2048) break;
            attn_item(P, l, lds, 1024 + idx, tid);
        }
    }
}

__device__ __forceinline__ void e2_phase(const Params& P, int l) {
    const int tid = tid_opaque(), tok = tid >> 3, sub = tid & 7;
    bf16_t* Z = (bf16_t*)(P.ws + WS_ZB);
    {
        const float* SM = (const float*)(P.ws + WS_SMID); const float* S1 = (const float*)(P.ws + WS_SP1); const float* PH = (const float*)(P.ws + WS_PHI);
        for (int e = bid_opaque() * 512 + tid; e < 16 * 4096; e += gridDim.x * 512) { const int chain = e >> 12, i = (e >> 6) & 63, j = e & 63; float a = S1[e];
#pragma unroll 16
            for (int m = 0; m < 64; ++m) a += SM[chain * 4096 + i * 64 + m] * PH[chain * 4096 + m * 64 + j];
            P.out[O_RWP + (size_t)(l * 16 + chain) * 4096 + i * 64 + j] = a; }
    }
    const int wave = tid >> 6, lane = tid & 63, fr = lane & 15, fq = lane >> 4, tt = wave & 3, ih = wave >> 2;
    for (int t_ = bid_opaque(); t_ < 528; t_ += gridDim.x) {
        const int tile = (t_ >= 256 && t_ < 512) ? 256 + ((t_ - 256) ^ 128) : t_;
        if (tile < 512 && (tile & 255) >= 128) {
            const int b = tile >> 8, tl = ((tile & 255) - 128) * 64 + tt * 16 + fr;
            for (int h = 0; h < 8; ++h) {
                const float* SM = (const float*)(P.ws + WS_SMID) + (size_t)(b * 8 + h) * 4096;
                const bf16_t* yp = (const bf16_t*)(P.ws + WS_YPHI) + ((size_t)b * (SEQ / 2) + tl) * 512 + h * 64;
                const bf16x8 yb0 = *(const bf16x8*)(yp + 8 * fq), yb1 = *(const bf16x8*)(yp + 32 + 8 * fq);
                bf16_t* yrow = Z + (size_t)(b * SEQ + SEQ / 2 + tl) * ZW + BK + h * 64;
#pragma unroll
                for (int q = 0; q < 2; ++q) { const int i = (ih * 2 + q) * 16 + fr; f32x4 acc = (f32x4){0.f, 0.f, 0.f, 0.f};
#pragma unroll
                    for (int kk = 0; kk < 2; ++kk) { const f32x4 s0 = *(const f32x4*)(SM + i * 64 + 32 * kk + 8 * fq), s1 = *(const f32x4*)(SM + i * 64 + 32 * kk + 8 * fq + 4);
                        u32x4 w; w.x = cvt_pk_bf16(s0[0], s0[1]); w.y = cvt_pk_bf16(s0[2], s0[3]); w.z = cvt_pk_bf16(s1[0], s1[1]); w.w = cvt_pk_bf16(s1[2], s1[3]);
                        acc = __builtin_amdgcn_mfma_f32_16x16x32_bf16(__builtin_bit_cast(bf16x8, w), kk ? yb1 : yb0, acc, 0, 0, 0); }
                    bf16_t* dp = yrow + (ih * 2 + q) * 16 + 4 * fq; const u32x2 o = *(const u32x2*)dp; u32x2 w;
                    w.x = cvt_pk_bf16(bflo(o.x) + acc[0], bfhi(o.x) + acc[1]); w.y = cvt_pk_bf16(bflo(o.y) + acc[2], bfhi(o.y) + acc[3]); *(u32x2*)dp = w; }
            }
            __syncthreads();
        }
        const size_t row = (size_t)tile * 64 + tok;
#pragma unroll
        for (int hq = 0; hq < 2; ++hq) {
            u32x4 ry[4], rv[4], rg[4]; float bnv[4];
#pragma unroll
            for (int q = 0; q < 4; ++q) { const int h = hq * 4 + q, hc = h * 64 + sub * 8; ry[q] = *(const u32x4*)(Z + row * ZW + BK + hc); rv[q] = *(const u32x4*)(Z + row * ZW + CV + hc); rg[q] = *(const u32x4*)(Z + row * ZW + BG + hc);
                bnv[q] = ((const float*)(P.ws + WS_BONUS))[row * 8 + h]; }
#pragma unroll
            for (int q = 0; q < 4; ++q) { const int h = hq * 4 + q, hc = h * 64 + sub * 8; float y[8], v[8], g[8], o[8];
                unpack8(ry[q], y); unpack8(rv[q], v); unpack8(rg[q], g);
                float s_ = 0.f;
#pragma unroll
                for (int e = 0; e < 8; ++e) s_ += y[e];
                const float mean = sum8(s_) * (1.f / 64.f); float q2 = 0.f;
#pragma unroll
                for (int e = 0; e < 8; ++e) { const float d = y[e] - mean; q2 += d * d; }
                const float rs = rsqrtf(sum8(q2) * (1.f / 64.f) + 64e-5f);
                const float bn = bnv[q];
                const float* lw = PIN(23) + l * 512 + hc; const float* lb = PIN(24) + l * 512 + hc;
#pragma unroll
                for (int e = 0; e < 8; ++e) o[e] = ((y[e] - mean) * rs * lw[e] + lb[e] + bn * v[e]) * g[e];
                *(u32x4*)(Z + row * ZW + CR + hc) = pack8(o); }
        }
    }
}

#define XB_TMO      128
#define XB_XCNT(j)  (256  + 64 * (j))
#define XB_XSUB(j)  (1280 + 64 * (j))
#define XB_XGEN(j)  (2304 + 64 * (j))
#define XB_TOP      3328
#define XB_TOPGEN   3392
#define XCD_BAR_WORDS 3456
#define XB_SPIN_CAP (1u << 22)
__device__ __forceinline__ unsigned xb_ld(unsigned* p)              { return __hip_atomic_load(p, __ATOMIC_RELAXED, __HIP_MEMORY_SCOPE_AGENT); }
__device__ __forceinline__ unsigned xb_add(unsigned* p, unsigned v) { return __hip_atomic_fetch_add(p, v, __ATOMIC_RELAXED, __HIP_MEMORY_SCOPE_AGENT); }
__device__ __forceinline__ unsigned xb_xcc_id() { return (unsigned)__builtin_amdgcn_s_getreg((3 << 11) | 20) & 0xFu; }
#define XB_SPIN(cond, bar) do { unsigned _sp = 0; while (cond) { __builtin_amdgcn_s_sleep(1); \
    if ((++_sp & 255u) == 0u) { if (xb_ld(&(bar)[XB_TMO])) break; if (_sp > XB_SPIN_CAP) { atomicAdd(&(bar)[XB_TMO], 1u); break; } } } } while (0)
struct XcdBarrier { unsigned* bar; unsigned x; volatile LAS unsigned* st; };
__device__ __forceinline__ XcdBarrier xcd_barrier_post(unsigned* bar, volatile LAS unsigned* st) {
    XcdBarrier b; b.bar = bar; b.x = xb_xcc_id(); b.st = st;
    if (threadIdx.x == 0) (void)xb_add(&bar[XB_XCNT(b.x)], 1u);
    return b;
}
__device__ __forceinline__ void xcd_barrier_complete(unsigned* bar, unsigned x, unsigned& nloc, unsigned& nx) {
    const unsigned G = gridDim.x * gridDim.y * gridDim.z;
    unsigned sum, cnt, mine, sp = 0u;
    for (;;) {
        sum = 0u; cnt = 0u; mine = 0u;
#pragma unroll
        for (unsigned j = 0; j < 16; ++j) { const unsigned c = xb_ld(&bar[XB_XCNT(j)]); sum += c; cnt += (c > 0u) ? 1u : 0u; mine = (j == x) ? c : mine; }
        if (sum == G) break;
        __builtin_amdgcn_s_sleep(1);
        if ((++sp & 255u) == 0u) { if (xb_ld(&bar[XB_TMO])) break; if (sp > XB_SPIN_CAP) { atomicAdd(&bar[XB_TMO], 1u); break; } }
    }
    nloc = mine > 0u ? mine : 1u; nx = cnt > 0u ? cnt : 1u;
}
__device__ __forceinline__ void xcd_barrier(const XcdBarrier& b) {
    asm volatile("s_waitcnt vmcnt(0)" ::: "memory");
    __syncthreads();
    if (threadIdx.x == 0) {
        unsigned* bar = b.bar;
        __builtin_amdgcn_s_waitcnt(0);
        unsigned nloc = b.st[0], nx = b.st[1];
        if (nloc == 0u) { xcd_barrier_complete(bar, b.x, nloc, nx); b.st[0] = nloc; b.st[1] = nx; }
        const unsigned old = xb_add(&bar[XB_XSUB(b.x)], 1u);
        const unsigned gen = old / nloc;
        if (old + 1u == (gen + 1u) * nloc) {
            __builtin_amdgcn_fence(__ATOMIC_RELEASE, "agent");
            asm volatile("s_waitcnt vmcnt(0)" ::: "memory");
            const unsigned og = xb_add(&bar[XB_TOP], 1u);
            const unsigned tg = og / nx;
            if (og + 1u == (tg + 1u) * nx) xb_add(&bar[XB_TOPGEN], 1u);
            else XB_SPIN(xb_ld(&bar[XB_TOPGEN]) == tg, bar);
            __builtin_amdgcn_fence(__ATOMIC_ACQUIRE, "agent");
            xb_add(&bar[XB_XGEN(b.x)], 1u);
            asm volatile("s_waitcnt vmcnt(0)" ::: "memory");
        } else {
            XB_SPIN(xb_ld(&bar[XB_XGEN(b.x)]) == gen, bar);
            __builtin_amdgcn_fence(__ATOMIC_ACQUIRE, "agent");
            asm volatile("s_waitcnt vmcnt(0)" ::: "memory");
        }
    }
    __syncthreads();
}

__global__ void __launch_bounds__(512, 2) mega_fwd(Params P) {
    extern __shared__ __attribute__((aligned(16))) unsigned char lds_raw[];
    LAS unsigned char* lds = (LAS unsigned char*)lds_raw;
    unsigned char* ws = P.ws;
    bf16_t* Z = (bf16_t*)(ws + WS_ZB); bf16_t* XNB = (bf16_t*)(ws + WS_XNB); bf16_t* LOB = (bf16_t*)(ws + WS_LOB); bf16_t* WT = (bf16_t*)(ws + WS_W);
    volatile LAS unsigned* bst = (volatile LAS unsigned*)(lds + 131072 + 512);
    if (threadIdx.x < 2) bst[threadIdx.x] = 0u;
    __syncthreads();
    XcdBarrier xbar = xcd_barrier_post((unsigned*)ws, bst);
    for (int ph = P.ph_lo; ph < P.ph_hi; ++ph) {
        if (ph == 0) { convert_weights(P, 0, lds); row_norm_pass(P, 0, 0); }
        else {
            const int l = (ph - 1) / NPH_LAYER, k = (ph - 1) % NPH_LAYER;
            GemmDesc g; g.sched = -1; g.lda = g.ldb = 1024; g.K = 1024; g.nM = 132; g.nN = 4; g.epi = 0; g.perm = 1; g.d0 = nullptr; g.ldc0 = 1024; g.d1 = nullptr; g.x = nullptr; g.z = Z; g.A = nullptr; g.B = nullptr; g.skip = 0;
            switch (k) {
            case 0: g.sched = 0; g.A = (const char*)XNB; g.B = (const char*)(WT + W_Z); g.nN = 21; g.d0 = Z; g.ldc0 = ZW; break;
            case 1: e1_phase(P, l, lds); break;
            case 2: p2_phase(P, l, lds); break;
            case 3: p3_phase(P, l, lds); break;
            case 4: g.sched = 0; g.A = (const char*)LOB; g.lda = 256; g.B = (const char*)(WT + W_BD); g.ldb = 256; g.K = 256; g.nN = 6; g.epi = 1; g.d0 = XNB; break;
            case 5: c2_phase(P, l, lds); break;
            case 6: scan_phase(P, l, lds); break;
            case 7: e2_phase(P, l); row_norm_pass(P, l, 1); break;
            case 8: g.sched = 0; g.A = (const char*)XNB; g.B = (const char*)(WT + W_GL); g.nN = 12; g.epi = 2; g.d0 = Z; g.ldc0 = ZW; break;
            case 9: g.sched = 1; g.A = (const char*)Z; g.lda = ZW; g.B = (const char*)(WT + W_B); g.ldb = 512; g.K = 512; g.epi = 3; g.d0 = XNB; break;
            case 10: g.sched = 0; g.A = (const char*)XNB; g.B = (const char*)(WT + W_O); g.epi = 4; g.perm = 0; g.x = P.out; break;
            case 11: row_norm_pass(P, l, 2); break;
            case 12: g.sched = 0; g.A = (const char*)Z; g.B = (const char*)(WT + W_GU); g.nN = 22; g.epi = 5; g.d0 = (bf16_t*)(ws + WS_H); g.ldc0 = FF; break;
            case 13: g.sched = 0; g.A = (const char*)(ws + WS_H); g.lda = FF; g.B = (const char*)(WT + W_D); g.ldb = FF; g.K = FF; g.epi = 4; g.perm = 0; g.x = P.out; g.d1 = (bf16_t*)(ws + WS_XB); break;
            case 14: g.sched = 0; g.A = (const char*)(ws + WS_XB); g.B = (const char*)(WT + W_PG); g.d0 = Z; break;
            default: finish_pass(P, l); if (l == 0) convert_weights(P, 1, lds); break;
            }
            for (int rep = 0; rep < (k == 13 ? 2 : 1); ++rep) {
                if (rep == 1) { g.A = (const char*)LOB; g.lda = 256; g.B = (const char*)(WT + W_P); g.ldb = 256; g.K = 256; g.epi = 0; g.perm = 1; g.d0 = XNB; g.ldc0 = 1024; g.d1 = nullptr; g.x = nullptr;
                    g.skip = ((int)gridDim.x >= 128 && 528 > 2 * (int)gridDim.x && 528 < 3 * (int)gridDim.x) ? 528 - 2 * (int)gridDim.x : 0; }
                if (g.sched >= 0) gemm_phase(lds, g);
            }
#ifdef DBG_REP_MASK
            if ((DBG_REP_MASK >> k) & 1) { cg::this_grid().sync(); if (g.sched >= 0) gemm_phase(lds, g); else if (k == 6) scan_phase(P, l, lds); else if (k == 2) p2_phase(P, l, lds); }
#endif
        }
        if (ph + 1 < P.ph_hi) { if (P.ph_hi < 0) cg::this_grid().sync(); else xcd_barrier(xbar); }
#ifdef DBG_EXTRA_SYNC
        if (ph + 1 < P.ph_hi) { cg::this_grid().sync(); cg::this_grid().sync(); }
#endif
    }
#ifdef DBG_DUMP_Z
    cg::this_grid().sync();
    for (size_t e = (size_t)blockIdx.x * 512 + threadIdx.x; e < (size_t)T_ALL * 512; e += (size_t)gridDim.x * 512) {
        const size_t r = e >> 9; const int c = (int)(e & 511);
        P.out[e] = bf2f(XNB[e]); (void)r; (void)c;
    }
#endif
}

extern "C" void kernel_launch(void* const* d_in, const int* in_sizes, int n_in, void* d_out, int out_size, void* d_ws, size_t ws_size, hipStream_t stream) {
    static int grid = 0;
    if (grid == 0) {
        if (n_in != 34 || out_size != 45603840 || ws_size < WS_END2) { fprintf(stderr, "kernel_launch: unexpected shapes n_in %d out %d ws %zu\n", n_in, out_size, ws_size); grid = -1; return; }
        int dev = 0, cus = 0, per_cu = 0;
        hipGetDevice(&dev); hipDeviceGetAttribute(&cus, hipDeviceAttributeMultiprocessorCount, dev);
        hipFuncSetAttribute((const void*)mega_fwd, hipFuncAttributeMaxDynamicSharedMemorySize, LDS_BYTES);
        hipOccupancyMaxActiveBlocksPerMultiprocessor(&per_cu, (const void*)mega_fwd, 512, LDS_BYTES);
        if (per_cu < 1) { fprintf(stderr, "kernel_launch: occupancy query says %d blocks per CU\n", per_cu); per_cu = 1; }
        (void)hipGetLastError();
        grid = cus * per_cu;
        fprintf(stderr, "kernel_launch: grid %d (cus %d x %d)\n", grid, cus, per_cu);
    }
    if (grid < 0) return;
#ifdef DBG_POISON
    (void)hipMemsetAsync(d_ws, 0xFF, WS_END, stream);
#endif
    (void)hipMemsetAsync(d_ws, 0, 16384, stream);
    Params p{};
    for (int i = 0; i < 34; ++i) p.in[i] = (const float*)d_in[i];
    p.out = (float*)d_out; p.ws = (unsigned char*)d_ws;
#if MK_PER_PHASE
    for (int ph = 0; ph < NPHASES; ++ph) { p.ph_lo = ph; p.ph_hi = ph + 1; hipLaunchKernelGGL(mega_fwd, dim3(grid), dim3(512), LDS_BYTES, stream, p); }
#else
#ifdef DBG_PH_HI
    p.ph_lo = 0; p.ph_hi = DBG_PH_HI;
#else
    p.ph_lo = 0; p.ph_hi = NPHASES;
#endif
    void* args[] = {&p};
    hipError_t e = hipLaunchCooperativeKernel((const void*)mega_fwd, dim3(grid), dim3(512), args, LDS_BYTES, stream);
    if (e != hipSuccess) fprintf(stderr, "cooperative launch failed: %s (grid %d)\n", hipGetErrorString(e), grid);
#endif
}
```

```cpp
#include <hip/hip_runtime.h>
#include <hip/hip_cooperative_groups.h>
#include <cstdio>
#include <cstdint>
namespace cg = cooperative_groups;


#ifndef MK_PER_PHASE
#define MK_PER_PHASE 0
#endif

#define LAS __attribute__((address_space(3)))
typedef unsigned short bf16_t;
typedef short bf16x8 __attribute__((ext_vector_type(8)));
typedef float f32x4 __attribute__((ext_vector_type(4)));
typedef unsigned u32x4 __attribute__((ext_vector_type(4)));
typedef unsigned u32x2 __attribute__((ext_vector_type(2)));

constexpr int T_ALL = 33792, T_P = 32768, SEQ = 16384, DM = 1024, ZW = 5376, FF = 2816;
constexpr int AQ = 0, AK = 512, AV = 1024, BQ = 1536, BK = 2048, BV = 2560, BG = 3072, CR = 3584, CK = 4096, CV = 4608, CLO = 5120;
constexpr float EPS = 1e-6f;
constexpr int NPH_LAYER = 16, NPHASES = 1 + 2 * NPH_LAYER;
constexpr size_t O_YP = 0, O_AKP = 34603008, O_AVP = 35651584, O_RETP = 36700160, O_RWP = 36962304, O_SHP = 37093376,
                 O_AKS = 37100544, O_AVS = 38149120, O_RETS = 39197696, O_RWS = 43392000, O_SHS = 45489152;
constexpr size_t MiB = 1u << 20;
constexpr size_t WS_W = 1 * MiB, WS_XNB = 43 * MiB, WS_LOB = 109 * MiB, WS_ZB = 126 * MiB, WS_BONUS = 473 * MiB, WS_CZB = 475 * MiB, WS_END = 477 * MiB;
constexpr size_t WS_YPHI = 478 * MiB, WS_SMID = 495 * MiB, WS_SP1 = 496 * MiB, WS_PHI = 497 * MiB, WS_END2 = 498 * MiB;
constexpr size_t WS_H = WS_ZB + 66 * MiB, WS_XB = WS_ZB + 248 * MiB;
constexpr size_t W_Z = 0, W_GL = 5505024, W_BD = 8650752, W_B = 9043968, W_O = 10616832, W_GU = 11665408, W_D = 17432576, W_P = 20316160, W_PG = 20578304;
constexpr int LDS_BYTES = 147456;

struct Params { const float* in[34]; float* out; unsigned char* ws; int ph_lo, ph_hi; };

__device__ __forceinline__ const float* ld_in(const Params& P, int i) { asm volatile("" : "+s"(i)); return P.in[i]; }
#define PIN(i) ld_in(P, i)
__device__ __forceinline__ int tid_opaque() { int t = threadIdx.x; asm volatile("" : "+v"(t)); return t; }
__device__ __forceinline__ int bid_opaque() { int b = blockIdx.x; asm volatile("" : "+s"(b)); return b; }
typedef __bf16 bf16x2v __attribute__((ext_vector_type(2)));
typedef float f32x2v __attribute__((ext_vector_type(2)));
__device__ __forceinline__ unsigned cvt_pk_bf16(float lo, float hi) { f32x2v v = {lo, hi}; bf16x2v b = __builtin_convertvector(v, bf16x2v); return __builtin_bit_cast(unsigned, b); }
__device__ __forceinline__ float bflo(unsigned w) { return __uint_as_float(w << 16); }
__device__ __forceinline__ float bfhi(unsigned w) { return __uint_as_float(w & 0xffff0000u); }
__device__ __forceinline__ float bf2f(bf16_t b) { return __uint_as_float((unsigned)b << 16); }
__device__ __forceinline__ bf16_t f2bf(float f) { return (bf16_t)(cvt_pk_bf16(f, f) & 0xffffu); }
__device__ __forceinline__ void unpack8(u32x4 w, float* f) { f[0] = bflo(w.x); f[1] = bfhi(w.x); f[2] = bflo(w.y); f[3] = bfhi(w.y); f[4] = bflo(w.z); f[5] = bfhi(w.z); f[6] = bflo(w.w); f[7] = bfhi(w.w); }
__device__ __forceinline__ u32x4 pack8(const float* f) { u32x4 w; w.x = cvt_pk_bf16(f[0], f[1]); w.y = cvt_pk_bf16(f[2], f[3]); w.z = cvt_pk_bf16(f[4], f[5]); w.w = cvt_pk_bf16(f[6], f[7]); return w; }
__device__ __forceinline__ float sigmoidf_(float x) { return __builtin_amdgcn_rcpf(1.f + __builtin_amdgcn_exp2f(-1.4426950408889634f * x)); }
__device__ __forceinline__ float wave_sum(float v) {
#pragma unroll
    for (int o = 1; o < 64; o <<= 1) v += __shfl_xor(v, o);
    return v;
}
__device__ __forceinline__ float sum8(float v) { v += __shfl_xor(v, 1); v += __shfl_xor(v, 2); v += __shfl_xor(v, 4); return v; }
template <int CTRL> __device__ __forceinline__ float dppf(float x) { return __builtin_bit_cast(float, __builtin_amdgcn_update_dpp(0, __builtin_bit_cast(int, x), CTRL, 0xf, 0xf, false)); }
__device__ __forceinline__ float red16(float x) { x += dppf<0xB1>(x); x += dppf<0x4E>(x); x += dppf<0x141>(x); x += dppf<0x140>(x); return x; }
__device__ __forceinline__ float gamma_l2(int h) { return __log2f(1.f - __builtin_amdgcn_exp2f(-5.f - (float)h)); }
#define LDSW() asm volatile("s_waitcnt lgkmcnt(0)" ::: "memory")

constexpr int BM = 256, BKT = 64, HALF = 128, HTB = HALF * BKT * 2;
__device__ __forceinline__ int lds_byte(int r, int c) { const int st = (r >> 4) * 2 + (c >> 5), rr = r & 15, cc = c & 31, ob = rr * 64 + cc * 2; return st * 1024 + (ob ^ (((ob >> 9) & 1) << 5)); }
__device__ __forceinline__ void stage_rc(int b, int& R, int& C) { const int st = b / 1024, sb = b % 1024, swz = sb ^ (((sb >> 9) & 1) << 5); R = (st >> 1) * 16 + swz / 64; C = (st & 1) * 32 + (swz % 64) / 2; }
__device__ __forceinline__ int perm32(int rho) { const int n = rho >> 4, i = rho & 15; return 8 * (i >> 2) + 4 * n + (i & 3); }

struct Unit { const char* a; const char* b; int pm, pn, aux; };
struct GemmDesc {
    const char* A; const char* B; int lda, ldb, K, nM, nN, sched, epi, perm;
    bf16_t* d0; int ldc0; bf16_t* d1; float* x; bf16_t* z;
    int skip;
};
__device__ __forceinline__ void tile_map(int L, int nM, int nN, int& pm, int& pn) {
    const int nwg = nM * nN; int wgid = L;
    { const int q = nwg / 8, r = nwg % 8, xcd = wgid % 8, off = wgid / 8; wgid = (xcd < r ? xcd * (q + 1) : r * (q + 1) + (xcd - r) * q) + off; }
    const int nig = 8 * nN, gid = wgid / nig, fm = gid * 8, gsz = (nM - fm) < 8 ? (nM - fm) : 8;
    pm = fm + ((wgid % nig) % gsz); pn = (wgid % nig) / gsz;
}
__device__ __forceinline__ int gl_off(int b) { return b == 0 ? 512 : (b == 1 ? 2048 : 4096); }
__device__ __forceinline__ int br_off(int b) { return b == 0 ? AQ : (b == 1 ? BQ : CR); }
__device__ __forceinline__ bool unit_next(const GemmDesc& g, int i, int G, int c, Unit& u) {
    const int nwg = g.nM * g.nN;
    if (g.sched == 0) {
        if (c < g.skip) return false;
        const long L = (long)i * (G - g.skip) + (c - g.skip); if (L >= nwg) return false;
        tile_map((int)L, g.nM, g.nN, u.pm, u.pn); u.aux = 0;
        u.a = g.A + (size_t)u.pm * 256 * g.lda * 2; u.b = g.B + (size_t)u.pn * 256 * g.ldb * 2; return true;
    } else {
        const long L = (long)(i / 3) * G + c; if (L >= nwg) return false;
        const int b = i % 3; tile_map((int)L, g.nM, g.nN, u.pm, u.pn); u.aux = b;
        u.a = g.A + (size_t)u.pm * 256 * g.lda * 2 + br_off(b) * 2; u.b = g.B + (size_t)b * 1024 * 512 * 2 + (size_t)u.pn * 256 * g.ldb * 2; return true;
    }
}
__device__ __forceinline__ void gemm_epilogue(const GemmDesc& g, const f32x4 (&acc)[2][2][4][2], const Unit& u, int wr, int wc, int fr, int fq) {
    const int row0 = u.pm * BM + wr * 64 + fr;
    if (g.epi == 4) {
        const int col0 = u.pn * BM + wc * 32 + 4 * fq;
#pragma unroll
        for (int ai = 0; ai < 2; ++ai)
#pragma unroll
            for (int m = 0; m < 4; ++m) { const size_t ro = (size_t)(row0 + ai * HALF + m * 16) * DM + col0;
#pragma unroll
                for (int bj = 0; bj < 2; ++bj)
#pragma unroll
                    for (int n = 0; n < 2; ++n) { f32x4* p = (f32x4*)(g.x + ro + bj * HALF + n * 16); const f32x4 v = *p + acc[ai][bj][m][n]; *p = v;
                        if (g.d1) { u32x2 w; w.x = cvt_pk_bf16(v[0], v[1]); w.y = cvt_pk_bf16(v[2], v[3]); *(u32x2*)(g.d1 + ro + bj * HALF + n * 16) = w; } } }
        return;
    }
    const int cl = wc * 32 + 8 * fq;
    if (g.epi == 5) {
#pragma unroll
        for (int ai = 0; ai < 2; ++ai)
#pragma unroll
            for (int m = 0; m < 4; ++m) { const size_t ro = (size_t)(row0 + ai * HALF + m * 16) * g.ldc0 + u.pn * 128 + cl; float h[8];
#pragma unroll
                for (int n = 0; n < 2; ++n)
#pragma unroll
                    for (int e = 0; e < 4; ++e) { const float gt = acc[ai][0][m][n][e], up = acc[ai][1][m][n][e]; h[n * 4 + e] = gt * sigmoidf_(gt) * up; }
                *(u32x4*)(g.d0 + ro) = pack8(h); }
        return;
    }
    bf16_t* base = g.d0; int ldc = g.ldc0, colt = u.pn * BM; bool sg = false;
    if (g.epi == 1) { if (u.pn >= 4) { base = g.z; ldc = ZW; colt = BG + (u.pn - 4) * BM; } }
    else if (g.epi == 2) { colt = gl_off(u.pn >> 2) + (u.pn & 3) * BM; sg = true; }
    const bool gated = (g.epi == 3); const int gcol = gated ? gl_off(u.aux) : 0;
#pragma unroll
    for (int ai = 0; ai < 2; ++ai)
#pragma unroll
        for (int m = 0; m < 4; ++m) { const int row = row0 + ai * HALF + m * 16;
#pragma unroll
            for (int bj = 0; bj < 2; ++bj) { float v[8];
#pragma unroll
                for (int n = 0; n < 2; ++n)
#pragma unroll
                    for (int e = 0; e < 4; ++e) v[n * 4 + e] = acc[ai][bj][m][n][e];
                bf16_t* dp = base + (size_t)row * ldc + colt + bj * HALF + cl;
                if (sg) {
#pragma unroll
                    for (int e = 0; e < 8; ++e) v[e] = sigmoidf_(v[e]);
                }
                if (gated) { float gt[8]; unpack8(*(const u32x4*)(g.z + (size_t)row * ZW + gcol + u.pn * BM + bj * HALF + cl), gt);
#pragma unroll
                    for (int e = 0; e < 8; ++e) v[e] *= gt[e];
                    if (u.aux > 0) { float pv[8]; unpack8(*(const u32x4*)dp, pv);
#pragma unroll
                        for (int e = 0; e < 8; ++e) v[e] += pv[e]; } }
                *(u32x4*)dp = pack8(v); } }
}

__device__ __forceinline__ void gemm_phase(LAS unsigned char* lds, const GemmDesc& g) {
    const int tid = tid_opaque(), wid = __builtin_amdgcn_readfirstlane(tid >> 6), lane = tid & 63, wr = wid >> 2, wc = wid & 3, fr = lane & 15, fq = lane >> 4;
    const int G = gridDim.x, cb = bid_opaque();
    const int K = g.K, nt = K / BKT;
    unsigned voffA[2], voffB[2];
#pragma unroll
    for (int i = 0; i < 2; ++i) { int R, C; stage_rc(tid * 16 + i * 8192, R, C); const int Rb = g.perm ? ((R & ~31) + perm32(R & 31)) : R;
        voffA[i] = (unsigned)(R * g.lda + C) * 2u; voffB[i] = (unsigned)(Rb * g.ldb + C) * 2u; }
    const size_t kstep = (size_t)(BKT * 2);
    const size_t hstepA = (size_t)HALF * g.lda * 2, hstepB = (size_t)HALF * g.ldb * 2;
    const unsigned ldsw = (unsigned)wid * 1024u;
    const int aoff = lds_byte(wr * 64 + fr, fq * 8), boff = lds_byte(wc * 32 + fr, fq * 8);
#define PG8_SA(b, h) (((b) * 2 + (h)) * HTB)
#define PG8_SB(b, h) ((4 + (b) * 2 + (h)) * HTB)
#define PG8_STAGE(bufoff, gbase, voff) do { _Pragma("unroll") for (int _i = 0; _i < 2; ++_i) \
        __builtin_amdgcn_global_load_lds((const unsigned*)((const char*)(gbase) + (voff)[_i]), (LAS unsigned*)(lds + (bufoff) + ldsw + _i * 8192), 16, 0, 0); } while (0)
#define PG8_LDA(dst, b, h) do { _Pragma("unroll") for (int m = 0; m < 4; ++m) _Pragma("unroll") for (int k = 0; k < 2; ++k) dst[m][k] = *(const LAS bf16x8*)(lds + PG8_SA(b, h) + aoff + m * 2048 + k * 1024); } while (0)
#define PG8_LDB(dst, b, h) do { _Pragma("unroll") for (int n = 0; n < 2; ++n) _Pragma("unroll") for (int k = 0; k < 2; ++k) dst[n][k] = *(const LAS bf16x8*)(lds + PG8_SB(b, h) + boff + n * 2048 + k * 1024); } while (0)
#define PG8_MMA(ai, bj, At, Bt) do { __builtin_amdgcn_s_setprio(1); _Pragma("unroll") for (int m = 0; m < 4; ++m) _Pragma("unroll") for (int n = 0; n < 2; ++n) _Pragma("unroll") for (int k = 0; k < 2; ++k) \
        acc[ai][bj][m][n] = __builtin_amdgcn_mfma_f32_16x16x32_bf16(Bt[n][k], At[m][k], acc[ai][bj][m][n], 0, 0, 0); __builtin_amdgcn_s_setprio(0); } while (0)
#define PG8_WAIT_V(n) asm volatile("s_waitcnt vmcnt(" #n ")" ::: "memory")
#define PG8_WAIT_L(n) asm volatile("s_waitcnt lgkmcnt(" #n ")" ::: "memory")
#define PG8_BAR __builtin_amdgcn_s_barrier()
#define PG8_SCHED __builtin_amdgcn_sched_barrier(0)
    Unit cur, nxt; int ui = 0;
    if (!unit_next(g, 0, G, cb, cur)) return;
    f32x4 acc[2][2][4][2];
#pragma unroll
    for (int a = 0; a < 2; ++a)
#pragma unroll
        for (int b = 0; b < 2; ++b)
#pragma unroll
            for (int m = 0; m < 4; ++m)
#pragma unroll
                for (int n = 0; n < 2; ++n) acc[a][b][m][n] = (f32x4){0.f, 0.f, 0.f, 0.f};
    bf16x8 At[4][2], B0[2][2], B1[2][2];
    const char* cA = cur.a; const char* cB = cur.b;
    PG8_STAGE(PG8_SB(0, 0), cB, voffB); PG8_STAGE(PG8_SB(0, 1), cB + hstepB, voffB); PG8_STAGE(PG8_SA(0, 0), cA, voffA); PG8_STAGE(PG8_SA(0, 1), cA + hstepA, voffA);
    if (wr == 1) PG8_BAR;
    PG8_WAIT_V(2); PG8_BAR;
    PG8_STAGE(PG8_SB(1, 0), cB + kstep, voffB); PG8_STAGE(PG8_SA(1, 0), cA + kstep, voffA); PG8_STAGE(PG8_SB(1, 1), cB + hstepB + kstep, voffB);
    PG8_WAIT_V(6); PG8_BAR;
    for (;;) {
        const bool has_next = unit_next(g, ui + 1, G, cb, nxt);
        const char* nA = has_next ? nxt.a : cA; const char* nB = has_next ? nxt.b : cB;
        for (int t = 0; t < nt; t += 2) {
            const bool last = (t == nt - 2);
            const char* a1 = cA + (size_t)(t + 1) * kstep;
            const char* a2 = last ? nA : cA + (size_t)(t + 2) * kstep; const char* b2 = last ? nB : cB + (size_t)(t + 2) * kstep;
            const char* a3 = a2 + kstep; const char* b3 = b2 + kstep;
            PG8_LDB(B0, 0, 0); PG8_LDB(B1, 0, 1); PG8_SCHED; PG8_LDA(At, 0, 0); PG8_STAGE(PG8_SA(1, 1), a1 + hstepA, voffA);
            PG8_WAIT_V(8); PG8_WAIT_L(0); PG8_BAR; PG8_MMA(0, 0, At, B0); PG8_MMA(0, 1, At, B1); PG8_BAR; PG8_SCHED;
            PG8_LDA(At, 0, 1); PG8_STAGE(PG8_SB(0, 0), b2, voffB); PG8_STAGE(PG8_SB(0, 1), b2 + hstepB, voffB); PG8_STAGE(PG8_SA(0, 0), a2, voffA);
            PG8_WAIT_V(8); PG8_WAIT_L(0); PG8_BAR; PG8_MMA(1, 0, At, B0); PG8_MMA(1, 1, At, B1); PG8_BAR; PG8_SCHED;
            PG8_LDB(B0, 1, 0); PG8_LDB(B1, 1, 1); PG8_SCHED; PG8_LDA(At, 1, 0); PG8_STAGE(PG8_SA(0, 1), a2 + hstepA, voffA);
            PG8_WAIT_V(8); PG8_WAIT_L(0); PG8_BAR; PG8_MMA(0, 0, At, B0); PG8_MMA(0, 1, At, B1); PG8_BAR; PG8_SCHED;
            PG8_LDA(At, 1, 1); PG8_STAGE(PG8_SB(1, 0), b3, voffB); PG8_STAGE(PG8_SB(1, 1), b3 + hstepB, voffB); PG8_STAGE(PG8_SA(1, 0), a3, voffA);
            PG8_WAIT_V(8); PG8_WAIT_L(0); PG8_BAR; PG8_MMA(1, 0, At, B0); PG8_MMA(1, 1, At, B1); PG8_BAR; PG8_SCHED;
        }
        if (wr == 0) PG8_BAR;
        gemm_epilogue(g, acc, cur, wr, wc, fr, fq);
        if (!has_next) break;
#pragma unroll
        for (int a = 0; a < 2; ++a)
#pragma unroll
            for (int b = 0; b < 2; ++b)
#pragma unroll
                for (int m = 0; m < 4; ++m)
#pragma unroll
                    for (int n = 0; n < 2; ++n) acc[a][b][m][n] = (f32x4){0.f, 0.f, 0.f, 0.f};
        cur = nxt; cA = nA; cB = nB; ++ui;
        if (wr == 1) PG8_BAR;
    }
    PG8_WAIT_V(0);
    PG8_BAR;
}

struct MatDesc { const float* W; int ldw, col0, K, N; bf16_t* T; int ldt, koff, rowmode, rowoff; };
__device__ __forceinline__ MatDesc get_mat(const Params& P, int l, int m) {
    bf16_t* wb = (bf16_t*)(P.ws + WS_W); MatDesc d; d.col0 = 0; d.koff = 0; d.rowmode = 0; d.rowoff = 0;
    switch (m) {
    case 0: d.W = PIN(10) + (size_t)l * 1024 * 8448; d.ldw = 8448; d.K = 1024; d.N = 5376; d.T = wb + W_Z; d.ldt = 1024; break;
    case 1: d.W = PIN(10) + (size_t)l * 1024 * 8448; d.ldw = 8448; d.col0 = 5376; d.K = 1024; d.N = 3072; d.T = wb + W_GL; d.ldt = 1024; break;
    case 2: d.W = PIN(16) + (size_t)l * 64 * 512; d.ldw = 512; d.K = 64; d.N = 512; d.T = wb + W_BD; d.ldt = 256; break;
    case 3: d.W = PIN(18) + (size_t)l * 64 * 512; d.ldw = 512; d.K = 64; d.N = 512; d.T = wb + W_BD; d.ldt = 256; d.koff = 64; d.rowoff = 512; break;
    case 4: d.W = PIN(19) + (size_t)l * 128 * 512; d.ldw = 512; d.K = 128; d.N = 512; d.T = wb + W_BD; d.ldt = 256; d.koff = 128; d.rowoff = 1024; break;
    case 5: case 6: case 7: d.W = PIN(25) + (size_t)(l * 3 + (m - 5)) * 512 * 1024; d.ldw = 1024; d.K = 512; d.N = 1024; d.T = wb + W_B + (size_t)(m - 5) * 1024 * 512; d.ldt = 512; break;
    case 8: d.W = PIN(26) + (size_t)l * 1024 * 1024; d.ldw = 1024; d.K = 1024; d.N = 1024; d.T = wb + W_O; d.ldt = 1024; break;
    case 9: d.W = PIN(28) + (size_t)l * 1024 * FF; d.ldw = FF; d.K = 1024; d.N = FF; d.T = wb + W_GU; d.ldt = 1024; d.rowmode = 1; break;
    case 10: d.W = PIN(29) + (size_t)l * 1024 * FF; d.ldw = FF; d.K = 1024; d.N = FF; d.T = wb + W_GU; d.ldt = 1024; d.rowmode = 1; d.rowoff = 128; break;
    case 11: d.W = PIN(30) + (size_t)l * FF * 1024; d.ldw = 1024; d.K = FF; d.N = 1024; d.T = wb + W_D; d.ldt = FF; break;
    case 12: d.W = PIN(31) + (size_t)l * 256 * 1024; d.ldw = 1024; d.K = 256; d.N = 1024; d.T = wb + W_P; d.ldt = 256; break;
    default: d.W = PIN(33) + (size_t)l * 1024 * 1024; d.ldw = 1024; d.K = 1024; d.N = 1024; d.T = wb + W_PG; d.ldt = 1024; break;
    }
    return d;
}
__device__ __forceinline__ void convert_weights(const Params& P, int l, LAS unsigned char* lds) {
    const int tid = tid_opaque(), lane = tid & 63, wave = tid >> 6;
    LAS float* scr = (LAS float*)(lds + wave * 8704);
    const int gw = bid_opaque() * 8 + wave, NGW = gridDim.x * 8;
    for (int m = 0; m < 14; ++m) {
        const MatDesc d = get_mat(P, l, m);
        const int nblk = d.N / 32, nit = (d.K / 64) * nblk;
        for (int it = gw; it < nit; it += NGW) {
            const int kb = it / nblk, nb = it % nblk, k0 = 64 * kb, n0 = 32 * nb;
#pragma unroll 8
            for (int i = 0; i < 32; ++i) { const int kk = 2 * i + (lane >> 5); scr[kk * 33 + (lane & 31)] = d.W[(size_t)(k0 + kk) * d.ldw + d.col0 + n0 + (lane & 31)]; }
            LDSW();
            const int c = lane & 7;
#pragma unroll
            for (int j = 0; j < 4; ++j) { const int n = (lane >> 3) + 8 * j; const LAS float* s = scr + (8 * c) * 33 + n;
                u32x4 o; o.x = cvt_pk_bf16(s[0 * 33], s[1 * 33]); o.y = cvt_pk_bf16(s[2 * 33], s[3 * 33]); o.z = cvt_pk_bf16(s[4 * 33], s[5 * 33]); o.w = cvt_pk_bf16(s[6 * 33], s[7 * 33]);
                const int ng = n0 + n; const int drow = d.rowoff + (d.rowmode ? (256 * (ng >> 7) + (ng & 127)) : ng);
                *(u32x4*)(d.T + (size_t)drow * d.ldt + d.koff + k0 + 8 * c) = o; }
            LDSW();
        }
    }
    bf16_t* bd = (bf16_t*)(P.ws + WS_W) + W_BD;
    for (int e = bid_opaque() * 512 + tid; e < 1536 * 32; e += gridDim.x * 512) {
        const int row = e >> 5, k8 = (e & 31) * 8; const int blk = row >> 9;
        const bool diag = (blk == 0) ? (k8 < 64) : (blk == 1 ? (k8 >= 64 && k8 < 128) : (k8 >= 128));
        if (!diag) *(u32x4*)(bd + (size_t)row * 256 + k8) = (u32x4){0u, 0u, 0u, 0u};
    }
}

__device__ __forceinline__ void row_norm_pass(const Params& P, int l, int mode) {
    const int tid_ = tid_opaque(); const int lane = tid_ & 63, wave = tid_ >> 6;
    const int gw = bid_opaque() * 8 + wave, NGW = gridDim.x * 8;
    const float* gain = (mode == 2 ? PIN(27) : PIN(9)) + (size_t)l * DM;
    bf16_t* dst = (bf16_t*)(P.ws + (mode == 2 ? WS_ZB : WS_XNB));
    f32x4 gv[4];
#pragma unroll
    for (int j = 0; j < 4; ++j) gv[j] = *((const f32x4*)gain + lane + 64 * j);
    for (int r = gw; r < T_ALL; r += NGW) {
        const float* src = (mode == 0) ? (r < T_P ? PIN(0) + (size_t)r * DM : PIN(1) + (size_t)(r - T_P) * DM) : P.out + (size_t)r * DM;
        f32x4 v[4]; float s = 0.f;
#pragma unroll
        for (int j = 0; j < 4; ++j) { v[j] = *((const f32x4*)src + lane + 64 * j); s += v[j][0] * v[j][0] + v[j][1] * v[j][1] + v[j][2] * v[j][2] + v[j][3] * v[j][3]; }
        const float rs = rsqrtf(wave_sum(s) * (1.f / DM) + EPS);
#pragma unroll
        for (int j = 0; j < 4; ++j) {
            if (mode == 0) *((f32x4*)(P.out + (size_t)r * DM) + lane + 64 * j) = v[j];
            const f32x4 o = v[j] * rs * gv[j]; u32x2 w; w.x = cvt_pk_bf16(o[0], o[1]); w.y = cvt_pk_bf16(o[2], o[3]);
            *((u32x2*)(dst + (size_t)r * DM) + lane + 64 * j) = w; }
        if (mode == 2) {
            const float* pr = (r < T_P) ? PIN(2) + ((size_t)l * T_P + r) * 256 : PIN(3) + ((size_t)l * 1024 + (r - T_P)) * 256;
            const f32x4 pv = *((const f32x4*)pr + lane); u32x2 w; w.x = cvt_pk_bf16(pv[0], pv[1]); w.y = cvt_pk_bf16(pv[2], pv[3]);
            *((u32x2*)((bf16_t*)(P.ws + WS_LOB) + (size_t)r * 256) + lane) = w;
        }
    }
}
__device__ __forceinline__ void finish_pass(const Params& P, int l) {
    const int tid_ = tid_opaque(); const int lane = tid_ & 63, wave = tid_ >> 6;
    const int gw = bid_opaque() * 8 + wave, NGW = gridDim.x * 8;
    const float* gp = PIN(32) + (size_t)l * DM; const float* gn = PIN(9) + (size_t)(l < 1 ? l + 1 : l) * DM;
    bf16_t* GR = (bf16_t*)(P.ws + WS_ZB); bf16_t* EB = (bf16_t*)(P.ws + WS_XNB);
    for (int r = gw; r < T_ALL; r += NGW) {
        f32x4 x[4], gr[4], e[4]; float sx = 0.f, se = 0.f;
#pragma unroll
        for (int j = 0; j < 4; ++j) { x[j] = *((const f32x4*)(P.out + (size_t)r * DM) + lane + 64 * j);
            const u32x2 a = *((const u32x2*)(GR + (size_t)r * DM) + lane + 64 * j), b = *((const u32x2*)(EB + (size_t)r * DM) + lane + 64 * j);
            gr[j] = (f32x4){bflo(a.x), bfhi(a.x), bflo(a.y), bfhi(a.y)}; e[j] = (f32x4){bflo(b.x), bfhi(b.x), bflo(b.y), bfhi(b.y)};
#pragma unroll
            for (int k = 0; k < 4; ++k) { sx += x[j][k] * x[j][k]; se += e[j][k] * e[j][k]; } }
        const float rx = rsqrtf(wave_sum(sx) * (1.f / DM) + EPS), re = rsqrtf(wave_sum(se) * (1.f / DM) + EPS);
        float s2 = 0.f;
#pragma unroll
        for (int j = 0; j < 4; ++j) { const f32x4 g4 = *((const f32x4*)gp + lane + 64 * j);
#pragma unroll
            for (int k = 0; k < 4; ++k) { const float xn = x[j][k] + sigmoidf_(gr[j][k] * rx) * (e[j][k] * re * g4[k]); x[j][k] = xn; s2 += xn * xn; }
            *((f32x4*)(P.out + (size_t)r * DM) + lane + 64 * j) = x[j]; }
        if (l < 1) {
            const float r2 = rsqrtf(wave_sum(s2) * (1.f / DM) + EPS);
#pragma unroll
            for (int j = 0; j < 4; ++j) { const f32x4 g4 = *((const f32x4*)gn + lane + 64 * j); const f32x4 o = x[j] * r2 * g4; u32x2 w; w.x = cvt_pk_bf16(o[0], o[1]); w.y = cvt_pk_bf16(o[2], o[3]);
                *((u32x2*)(EB + (size_t)r * DM) + lane + 64 * j) = w; }
        }
    }
}

__device__ __forceinline__ void e1_phase(const Params& P, int l, LAS unsigned char* lds) {
    const int tid = tid_opaque(), tok = tid >> 3, sub = tid & 7, wave = tid >> 6, lane = tid & 63, fr = lane & 15, fq = lane >> 4;
    bf16_t* Z = (bf16_t*)(P.ws + WS_ZB);
    LAS bf16_t* L0 = (LAS bf16_t*)lds;
    LAS bf16_t* L1 = (LAS bf16_t*)(lds + 18432);
    for (int it = bid_opaque(); it < 528 * 7; it += gridDim.x) {
        const int tile = it / 7, job = it % 7, r0 = tile * 64, row = r0 + tok;
        const bool prompt = tile < 512; const int sr = row - T_P;
        bf16_t* zr = Z + (size_t)row * ZW;
        if (job < 2) {
            u32x4 rq[4], rk[4], rv[4];
#pragma unroll
            for (int q = 0; q < 4; ++q) { const int hc = (job * 4 + q) * 64 + sub * 8; rq[q] = *(const u32x4*)(zr + AQ + hc); rk[q] = *(const u32x4*)(zr + AK + hc); rv[q] = *(const u32x4*)(zr + AV + hc); }
            const float* gq = PIN(11) + l * 64 + sub * 8; const float* gk = PIN(12) + l * 64 + sub * 8;
#pragma unroll
            for (int q = 0; q < 4; ++q) { const int h = job * 4 + q; float f[8], o[8];
                unpack8(rq[q], f);
                float ss = 0.f;
#pragma unroll
                for (int e = 0; e < 8; ++e) ss += f[e] * f[e];
                float rs = rsqrtf(sum8(ss) * (1.f / 64.f) + EPS);
#pragma unroll
                for (int e = 0; e < 8; ++e) o[e] = f[e] * rs * gq[e];
                *(u32x4*)(zr + AQ + h * 64 + sub * 8) = pack8(o);
                unpack8(rk[q], f);
                ss = 0.f;
#pragma unroll
                for (int e = 0; e < 8; ++e) ss += f[e] * f[e];
                rs = rsqrtf(sum8(ss) * (1.f / 64.f) + EPS);
#pragma unroll
                for (int e = 0; e < 8; ++e) o[e] = f[e] * rs * gk[e];
                *(u32x4*)(zr + AK + h * 64 + sub * 8) = pack8(o);
                float vv[8]; const u32x4 vraw = rv[q]; unpack8(vraw, vv);
                float* ok = nullptr; float* ov = nullptr;
                if (prompt) { const int b = row >> 14, t = row & (SEQ - 1); if (t >= SEQ - 512) { const size_t o_ = (((size_t)(l * 2 + b) * 512 + (t - (SEQ - 512))) * 512 + h * 64 + sub * 8); ok = P.out + O_AKP + o_; ov = P.out + O_AVP + o_; } }
                else { const size_t o_ = ((size_t)(l * 1024 + sr) * 512 + h * 64 + sub * 8); ok = P.out + O_AKS + o_; ov = P.out + O_AVS + o_; }
                if (ok) { *(f32x4*)ok = (f32x4){o[0], o[1], o[2], o[3]}; *(f32x4*)(ok + 4) = (f32x4){o[4], o[5], o[6], o[7]};
                          *(f32x4*)ov = (f32x4){vv[0], vv[1], vv[2], vv[3]}; *(f32x4*)(ov + 4) = (f32x4){vv[4], vv[5], vv[6], vv[7]}; }
                if (prompt) {
#pragma unroll
                    for (int e = 0; e < 8; ++e) L0[q * 4608 + (sub * 8 + e) * 72 + tok] = ((const unsigned short*)&vraw)[e];
                } }
            if (prompt) {
                __syncthreads();
#pragma unroll
                for (int q = 0; q < 4; ++q) { const u32x4 w = *(const LAS u32x4*)(L0 + q * 4608 + tok * 72 + sub * 8);
                    *(u32x4*)(Z + (size_t)(r0 + tok) * ZW + AV + (job * 4 + q) * 64 + sub * 8) = w; }
                __syncthreads();
            }
        } else if (job < 6) {
            const int h = job - 2; const int pos = prompt ? (row & (SEQ - 1)) : (2048 + (sr & 31));
            float cs[8], sn[8];
#pragma unroll
            for (int e = 0; e < 8; ++e) { const float inv = __builtin_amdgcn_exp2f(-(float)(sub * 8 + e) * (13.287712379549449f / 64.f)); const float ang = (float)pos * inv;
                const float n = rintf(ang * 0.15915494309189535f); float rr = fmaf(-n, 6.2831855f, ang); rr = fmaf(-n, -1.7484555e-7f, rr); cs[e] = __cosf(rr); sn[e] = __sinf(rr); }
            float x1[8], x2[8], o1[8], o2[8];
            unpack8(*(const u32x4*)(zr + BQ + h * 128 + sub * 8), x1); unpack8(*(const u32x4*)(zr + BQ + h * 128 + 64 + sub * 8), x2);
#pragma unroll
            for (int e = 0; e < 8; ++e) { o1[e] = x1[e] * cs[e] - x2[e] * sn[e]; o2[e] = x1[e] * sn[e] + x2[e] * cs[e]; }
            *(u32x4*)(zr + BQ + h * 128 + sub * 8) = pack8(o1); *(u32x4*)(zr + BQ + h * 128 + 64 + sub * 8) = pack8(o2);
            unpack8(*(const u32x4*)(zr + BK + h * 128 + sub * 8), x1); unpack8(*(const u32x4*)(zr + BK + h * 128 + 64 + sub * 8), x2);
#pragma unroll
            for (int e = 0; e < 8; ++e) { o1[e] = (x1[e] * cs[e] - x2[e] * sn[e]) * 0.08838834764831845f; o2[e] = (x1[e] * sn[e] + x2[e] * cs[e]) * 0.08838834764831845f; }
            *(u32x4*)(zr + BK + h * 128 + sub * 8) = pack8(o1); *(u32x4*)(zr + BK + h * 128 + 64 + sub * 8) = pack8(o2);
            if (prompt) {
                const float dk = __builtin_amdgcn_exp2f(gamma_l2(h) * (float)(63 - tok));
                const u32x4 va = *(const u32x4*)(zr + BV + h * 128 + sub * 8), vb = *(const u32x4*)(zr + BV + h * 128 + 64 + sub * 8);
#pragma unroll
                for (int e = 0; e < 8; ++e) { L0[(sub * 8 + e) * 72 + tok] = f2bf(o1[e] * dk); L0[(64 + sub * 8 + e) * 72 + tok] = f2bf(o2[e] * dk);
                    L1[(sub * 8 + e) * 72 + tok] = ((const unsigned short*)&va)[e]; L1[(64 + sub * 8 + e) * 72 + tok] = ((const unsigned short*)&vb)[e]; }
                __syncthreads();
                const int b = row >> 14, c = (r0 & (SEQ - 1)) >> 6;
                bf16_t* St = (bf16_t*)(P.ws + WS_XNB) + ((size_t)((b * 4 + h) * 256 + c)) * 16384;
                const bf16x8 vb0 = *(const LAS bf16x8*)(L1 + (16 * wave + fr) * 72 + 8 * fq), vb1 = *(const LAS bf16x8*)(L1 + (16 * wave + fr) * 72 + 32 + 8 * fq);
#pragma unroll
                for (int dkt = 0; dkt < 8; ++dkt) {
                    const bf16x8 ka0 = *(const LAS bf16x8*)(L0 + (16 * dkt + fr) * 72 + 8 * fq), ka1 = *(const LAS bf16x8*)(L0 + (16 * dkt + fr) * 72 + 32 + 8 * fq);
                    f32x4 a = (f32x4){0.f, 0.f, 0.f, 0.f};
                    a = __builtin_amdgcn_mfma_f32_16x16x32_bf16(ka0, vb0, a, 0, 0, 0); a = __builtin_amdgcn_mfma_f32_16x16x32_bf16(ka1, vb1, a, 0, 0, 0);
                    u32x2 w; w.x = cvt_pk_bf16(a[0], a[1]); w.y = cvt_pk_bf16(a[2], a[3]);
                    *(u32x2*)(St + (size_t)(16 * wave + fr) * 128 + 16 * dkt + 4 * fq) = w;
                }
#pragma unroll
                for (int q = 0; q < 2; ++q) { const int idx = tid + q * 512, i = idx >> 4, hh = (idx >> 3) & 1, pc = idx & 7;
                    const u32x4 w = *(const LAS u32x4*)(L1 + (64 * hh + i) * 72 + pc * 8);
                    *(u32x4*)(Z + (size_t)(r0 + i) * ZW + BV + h * 128 + hh * 64 + pc * 8) = w; }
                __syncthreads();
            }
        } else {
            bool first; const float* sh = nullptr;
            if (prompt) first = (row & (SEQ - 1)) == 0; else { first = (sr & 31) == 0; sh = PIN(8) + ((size_t)l * 32 + (sr >> 5)) * 1792; }
            const float* mu = PIN(14) + (size_t)l * 1792;
            bf16_t* LO = (bf16_t*)(P.ws + WS_LOB) + (size_t)row * 256;
#pragma unroll
            for (int ch = 0; ch < 4; ++ch) { const int lc = sub * 32 + ch * 8, cp = 1536 + lc; float cur[8], prv[8], o[8];
                unpack8(*(const u32x4*)(zr + CLO + lc), cur);
                if (!first) unpack8(*(const u32x4*)(zr - ZW + CLO + lc), prv);
                else {
#pragma unroll
                    for (int e = 0; e < 8; ++e) prv[e] = sh ? sh[cp + e] : 0.f; }
#pragma unroll
                for (int e = 0; e < 8; ++e) { const float c_ = cur[e] + (prv[e] - cur[e]) * mu[cp + e];
                    o[e] = (lc < 64) ? (1.f - 2.f * __builtin_amdgcn_rcpf(__expf(2.f * c_) + 1.f)) : (lc < 128 ? c_ : sigmoidf_(c_)); }
                *(u32x4*)(LO + lc) = pack8(o); }
            bool lastt; float* so;
            if (prompt) { lastt = (row & (SEQ - 1)) == SEQ - 1; so = P.out + O_SHP + (size_t)(l * 2 + (row >> 14)) * 1792; }
            else { lastt = (sr & 31) == 31; so = P.out + O_SHS + (size_t)(l * 32 + (sr >> 5)) * 1792; }
            if (lastt) { for (int q = 0; q < 28; ++q) { const int c0 = (sub * 28 + q) * 8; float f[8]; unpack8(*(const u32x4*)(zr + CR + c0), f);
                    *(f32x4*)(so + c0) = (f32x4){f[0], f[1], f[2], f[3]}; *(f32x4*)(so + c0 + 4) = (f32x4){f[4], f[5], f[6], f[7]}; } }
            if (tid < 192) *(u32x4*)((bf16_t*)(P.ws + WS_CZB) + (size_t)tile * 1536 + tid * 8) = *(const u32x4*)(Z + (size_t)(r0 + 63) * ZW + CR + tid * 8);
        }
    }
}

__device__ __forceinline__ void p2_phase(const Params& P, int l, LAS unsigned char* lds) {
    bf16_t* Z = (bf16_t*)(P.ws + WS_ZB);
    for (int it = bid_opaque(); it < 64 + 128; it += gridDim.x) {
        const int tid = tid_opaque(), lane = tid & 63, wave = tid >> 6;
#ifdef DBG_P2_SKIP_SAMPLE
        if (it >= 64) continue;
#endif
        if (it < 64) {
            const int e4 = it * 512 + tid, chain = e4 >> 12, idx = (e4 & 4095) * 4, h = chain & 3, b = chain >> 2;
            const float g64 = __builtin_amdgcn_exp2f(gamma_l2(h) * 64.f);
            bf16_t* St = (bf16_t*)(P.ws + WS_XNB) + (size_t)chain * 256 * 16384 + idx;
            float s0 = 0.f, s1 = 0.f, s2 = 0.f, s3 = 0.f;
#pragma unroll 16
            for (int c = 0; c < 256; ++c) { const u32x2 d = *(const u32x2*)(St + (size_t)c * 16384);
                s0 = s0 * g64 + bflo(d.x); s1 = s1 * g64 + bfhi(d.x); s2 = s2 * g64 + bflo(d.y); s3 = s3 * g64 + bfhi(d.y);
                u32x2 w; w.x = cvt_pk_bf16(s0, s1); w.y = cvt_pk_bf16(s2, s3); *(u32x2*)(St + (size_t)c * 16384) = w; }
            const int dv = idx >> 7, dk = idx & 127; float* o = P.out + O_RETP + ((size_t)((l * 2 + b) * 4 + h)) * 16384 + dv;
            o[(size_t)dk * 128] = s0; o[(size_t)(dk + 1) * 128] = s1; o[(size_t)(dk + 2) * 128] = s2; o[(size_t)(dk + 3) * 128] = s3;
        } else if (it < 192) {
            const int si = it - 64, s = si >> 2, h = si & 3, rb = T_P + s * 32;
            LAS float* q = (LAS float*)lds; LAS float* k = q + 4096; LAS float* v = k + 4096; LAS float* A = v + 4096; LAS float* ob = A + 1024;
            const float lg = gamma_l2(h);
            { const int n = tid >> 4, sg = tid & 15; const bf16_t* zr = Z + (size_t)(rb + n) * ZW + h * 128 + sg * 8; float f[8];
              const u32x4 wq = *(const u32x4*)(zr + BQ), wk = *(const u32x4*)(zr + BK), wv = *(const u32x4*)(zr + BV);
              unpack8(wq, f); *(LAS f32x4*)(q + n * 128 + sg * 8) = (f32x4){f[0], f[1], f[2], f[3]}; *(LAS f32x4*)(q + n * 128 + sg * 8 + 4) = (f32x4){f[4], f[5], f[6], f[7]};
              unpack8(wk, f); *(LAS f32x4*)(k + n * 128 + sg * 8) = (f32x4){f[0], f[1], f[2], f[3]}; *(LAS f32x4*)(k + n * 128 + sg * 8 + 4) = (f32x4){f[4], f[5], f[6], f[7]};
              unpack8(wv, f); *(LAS f32x4*)(v + n * 128 + sg * 8) = (f32x4){f[0], f[1], f[2], f[3]}; *(LAS f32x4*)(v + n * 128 + sg * 8 + 4) = (f32x4){f[4], f[5], f[6], f[7]}; }
            __syncthreads();
            for (int e = tid; e < 1024; e += 512) { const int n = e >> 5, m = e & 31; float a = 0.f;
                if (m <= n) {
#pragma unroll 8
                    for (int d = 0; d < 128; d += 4) { const f32x4 q4 = *(const LAS f32x4*)(q + n * 128 + d), k4 = *(const LAS f32x4*)(k + m * 128 + d); a += q4[0] * k4[0] + q4[1] * k4[1] + q4[2] * k4[2] + q4[3] * k4[3]; }
                    a *= __builtin_amdgcn_exp2f(lg * (float)(n - m)); }
                A[e] = a; }
            __syncthreads();
            const float* S0 = PIN(6) + ((size_t)((l * 32 + s) * 4 + h)) * 16384;
            { const int e = tid & 127, ng = tid >> 7; float acc[8];
#pragma unroll
              for (int i = 0; i < 8; ++i) acc[i] = 0.f;
#pragma unroll 4
              for (int d = 0; d < 128; d += 4) { const float s0 = S0[(size_t)d * 128 + e], s1 = S0[(size_t)(d + 1) * 128 + e], s2 = S0[(size_t)(d + 2) * 128 + e], s3 = S0[(size_t)(d + 3) * 128 + e];
#pragma unroll
                  for (int i = 0; i < 8; ++i) { const f32x4 q4 = *(const LAS f32x4*)(q + (ng * 8 + i) * 128 + d); acc[i] += q4[0] * s0 + q4[1] * s1 + q4[2] * s2 + q4[3] * s3; } }
#pragma unroll
              for (int i = 0; i < 8; ++i) { const int n = ng * 8 + i; float a = acc[i] * __builtin_amdgcn_exp2f(lg * (float)(n + 1));
                  for (int m = 0; m <= n; ++m) a += A[n * 32 + m] * v[m * 128 + e];
                  ob[n * 128 + e] = a; }
              const int dg = tid >> 7; float* so = P.out + O_RETS + ((size_t)((l * 32 + s) * 4 + h)) * 16384; const float g32 = __builtin_amdgcn_exp2f(lg * 32.f);
              float vd[32];
#pragma unroll
              for (int m = 0; m < 32; ++m) vd[m] = v[m * 128 + e] * __builtin_amdgcn_exp2f(lg * (float)(31 - m));
#pragma unroll 2
              for (int d = dg * 32; d < dg * 32 + 32; d += 4) { float a0 = g32 * S0[(size_t)d * 128 + e], a1 = g32 * S0[(size_t)(d + 1) * 128 + e], a2 = g32 * S0[(size_t)(d + 2) * 128 + e], a3 = g32 * S0[(size_t)(d + 3) * 128 + e];
#pragma unroll
                  for (int m = 0; m < 32; ++m) { const f32x4 k4 = *(const LAS f32x4*)(k + m * 128 + d); a0 += k4[0] * vd[m]; a1 += k4[1] * vd[m]; a2 += k4[2] * vd[m]; a3 += k4[3] * vd[m]; }
                  so[(size_t)d * 128 + e] = a0; so[(size_t)(d + 1) * 128 + e] = a1; so[(size_t)(d + 2) * 128 + e] = a2; so[(size_t)(d + 3) * 128 + e] = a3; }
            }
            __syncthreads();
            { const int e = tid & 127, ng = tid >> 7;
              for (int i = 0; i < 8; ++i) { const int n = ng * 8 + i; float ss = 0.f;
#pragma unroll 8
                  for (int d = 0; d < 128; d += 4) { const f32x4 o4 = *(const LAS f32x4*)(ob + n * 128 + d); ss += o4[0] * o4[0] + o4[1] * o4[1] + o4[2] * o4[2] + o4[3] * o4[3]; }
                  const float rs = rsqrtf(ss * (1.f / 128.f) + EPS); bf16_t* zr = Z + (size_t)(rb + n) * ZW + h * 128 + e; const float gt = bf2f(zr[BG]);
                  zr[BQ] = f2bf(ob[n * 128 + e] * rs * gt * sigmoidf_(gt)); } }
            __syncthreads();
        }
    }
}

__device__ __forceinline__ void sattn_item(const Params& P, int l, LAS unsigned char* lds, int si, int tid_in) {
    int tid = tid_in; asm volatile("" : "+v"(tid));
    const int lane = tid & 63, wave = tid >> 6;
    bf16_t* Z = (bf16_t*)(P.ws + WS_ZB);
    {
            const int s = si >> 4, h = (si >> 1) & 7, qh = si & 1, rb = T_P + s * 32, rq = rb + qh * 16;
            LAS float* q = (LAS float*)lds; LAS float* sc = q + 1024; LAS float* red = sc + 16 * 544;
            const float* ck = PIN(4) + ((size_t)(l * 32 + s) * 512) * 512 + h * 64; const float* cv = PIN(5) + ((size_t)(l * 32 + s) * 512) * 512 + h * 64;
            const float* bias = PIN(13) + (size_t)(l * 8 + h) * 320;
            for (int e = tid; e < 1024; e += 512) q[e] = bf2f(Z[(size_t)(rq + (e >> 6)) * ZW + AQ + h * 64 + (e & 63)]);
            __syncthreads();
            { const int key = tid; float kr[64];
#pragma unroll
                for (int d4 = 0; d4 < 16; ++d4) { const f32x4 t = *(const f32x4*)(ck + (size_t)key * 512 + d4 * 4); kr[d4 * 4] = t[0]; kr[d4 * 4 + 1] = t[1]; kr[d4 * 4 + 2] = t[2]; kr[d4 * 4 + 3] = t[3]; }
                for (int n = 0; n < 16; ++n) { float a = 0.f;
#pragma unroll
                    for (int d = 0; d < 64; ++d) a += q[n * 64 + d] * kr[d];
                    int rel = (512 + qh * 16 + n) - key; rel = rel > 256 ? 256 : rel;
                    sc[n * 544 + key] = a * 0.125f + bias[rel + 63]; } }
            { const int key = 512 + (tid & 31), n = tid >> 5; float kr[64];
#pragma unroll
                for (int d8 = 0; d8 < 8; ++d8) unpack8(*(const u32x4*)(Z + (size_t)(rb + key - 512) * ZW + AK + h * 64 + d8 * 8), kr + d8 * 8);
                float a = 0.f;
#pragma unroll
                for (int d = 0; d < 64; ++d) a += q[n * 64 + d] * kr[d];
                const int rel = (512 + qh * 16 + n) - key;
                sc[n * 544 + key] = a * 0.125f + bias[rel + 63]; }
            __syncthreads();
            for (int n = wave * 2; n < wave * 2 + 2; ++n) { float mx = -1e30f;
                for (int kx = lane; kx < 544; kx += 64) mx = fmaxf(mx, sc[n * 544 + kx]);
#pragma unroll
                for (int o = 1; o < 64; o <<= 1) mx = fmaxf(mx, __shfl_xor(mx, o));
                float sm = 0.f;
                for (int kx = lane; kx < 544; kx += 64) { const float p = __expf(sc[n * 544 + kx] - mx); sc[n * 544 + kx] = p; sm += p; }
                sm = wave_sum(sm); const float inv = 1.f / sm;
                for (int kx = lane; kx < 544; kx += 64) sc[n * 544 + kx] *= inv; }
            __syncthreads();
            { const int d = tid & 63, kg = tid >> 6; float a[16];
#pragma unroll
              for (int n = 0; n < 16; ++n) a[n] = 0.f;
              float vv[68];
#pragma unroll
              for (int i = 0; i < 68; ++i) { const int key = kg * 68 + i; vv[i] = key < 512 ? cv[(size_t)key * 512 + d] : bf2f(Z[(size_t)(rb + key - 512) * ZW + AV + h * 64 + d]); }
#pragma unroll
              for (int i = 0; i < 68; i += 4)
#pragma unroll
                  for (int n = 0; n < 16; ++n) { const f32x4 p4 = *(const LAS f32x4*)(sc + n * 544 + kg * 68 + i); a[n] += p4[0] * vv[i] + p4[1] * vv[i + 1] + p4[2] * vv[i + 2] + p4[3] * vv[i + 3]; }
#pragma unroll
              for (int n = 0; n < 16; ++n) red[(kg * 16 + n) * 64 + d] = a[n]; }
            __syncthreads();
            for (int e = tid; e < 1024; e += 512) { const int n = e >> 6, d = e & 63; float a = 0.f;
#pragma unroll
                for (int kg = 0; kg < 8; ++kg) a += red[(kg * 16 + n) * 64 + d];
                Z[(size_t)(rq + n) * ZW + AQ + h * 64 + d] = f2bf(a); }
            __syncthreads();
    }
}

__device__ __forceinline__ void p3_phase(const Params& P, int l, LAS unsigned char* lds) {
    const int tid = tid_opaque(), lane = tid & 63, wave = tid >> 6, fr = lane & 15, fq = lane >> 4;
    bf16_t* Z = (bf16_t*)(P.ws + WS_ZB);
    {
        const int qs = wave & 3, dh = wave >> 2;
        LAS bf16_t* SL = (LAS bf16_t*)lds;
        LAS bf16_t* KL = (LAS bf16_t*)(lds + 34816);
        LAS bf16_t* VL = (LAS bf16_t*)(lds + 52224);
        LAS float* XL = (LAS float*)(lds + 70656);
        u32x4 gs[4], gk[2], gv[2];
#define RT_LOAD(it_) do { const int h_ = (it_) & 3, c_ = ((it_) >> 2) & 255, b_ = (it_) >> 10; const size_t cb_ = (size_t)(b_ * SEQ + c_ * 64); \
        const bf16_t* St_ = (const bf16_t*)(P.ws + WS_XNB) + ((size_t)((b_ * 4 + h_) * 256 + (c_ > 0 ? c_ - 1 : 0))) * 16384; \
        _Pragma("unroll") for (int i_ = 0; i_ < 4; ++i_) { const int p_ = tid + 512 * i_; gs[i_] = *(const u32x4*)(St_ + (p_ >> 4) * 128 + (p_ & 15) * 8); } \
        _Pragma("unroll") for (int i_ = 0; i_ < 2; ++i_) { const int p_ = tid + 512 * i_, r_ = p_ >> 4, sg_ = p_ & 15; gk[i_] = *(const u32x4*)(Z + (cb_ + r_) * ZW + BK + h_ * 128 + sg_ * 8); gv[i_] = *(const u32x4*)(Z + (cb_ + r_) * ZW + BV + h_ * 128 + sg_ * 8); } } while (0)
#define RT_WRITE() do { _Pragma("unroll") for (int i_ = 0; i_ < 4; ++i_) { const int p_ = tid + 512 * i_; *(LAS u32x4*)(SL + (p_ >> 4) * 136 + (p_ & 15) * 8) = gs[i_]; } \
        _Pragma("unroll") for (int i_ = 0; i_ < 2; ++i_) { const int p_ = tid + 512 * i_, r_ = p_ >> 4, sg_ = p_ & 15; *(LAS u32x4*)(KL + r_ * 136 + sg_ * 8) = gk[i_]; *(LAS u32x4*)(VL + ((sg_ >> 3) * 64 + r_) * 72 + (sg_ & 7) * 8) = gv[i_]; } } while (0)
        int it = bid_opaque();
        if (it < 2048) RT_LOAD(it);
        for (; it < 2048; it += gridDim.x) {
            const int h = it & 3, c = (it >> 2) & 255, b = it >> 10;
            const int cb = b * SEQ + c * 64, qrow = cb + qs * 16 + fr; const float lg = gamma_l2(h);
            bf16x8 qf[4];
#pragma unroll
            for (int kk = 0; kk < 4; ++kk) qf[kk] = *(const bf16x8*)(Z + (size_t)qrow * ZW + BQ + h * 128 + 32 * kk + 8 * fq);
            RT_WRITE();
            __syncthreads();
            if (it + (int)gridDim.x < 2048) RT_LOAD(it + (int)gridDim.x);
            f32x4 acc[4];
#pragma unroll
            for (int dt = 0; dt < 4; ++dt) acc[dt] = (f32x4){0.f, 0.f, 0.f, 0.f};
            if (c > 0) {
#pragma unroll
                for (int dt = 0; dt < 4; ++dt)
#pragma unroll
                    for (int kk = 0; kk < 4; ++kk) acc[dt] = __builtin_amdgcn_mfma_f32_16x16x32_bf16(*(const LAS bf16x8*)(SL + (16 * (4 * dh + dt) + fr) * 136 + 32 * kk + 8 * fq), qf[kk], acc[dt], 0, 0, 0);
                const float dq = __builtin_amdgcn_exp2f(lg * (float)(qs * 16 + fr + 1));
#pragma unroll
                for (int dt = 0; dt < 4; ++dt) acc[dt] = acc[dt] * dq;
            }
            const int nu = (qs >> 1) + 1;
            for (int u = 0; u < nu; ++u) {
                unsigned pw[4];
#pragma unroll
                for (int t = 0; t < 2; ++t) { f32x4 sc_ = (f32x4){0.f, 0.f, 0.f, 0.f};
#pragma unroll
                    for (int kk = 0; kk < 4; ++kk) sc_ = __builtin_amdgcn_mfma_f32_16x16x32_bf16(*(const LAS bf16x8*)(KL + (32 * u + 16 * t + fr) * 136 + 32 * kk + 8 * fq), qf[kk], sc_, 0, 0, 0);
                    float pv[4];
#pragma unroll
                    for (int j = 0; j < 4; ++j) { const int n = qs * 16 + fr, m = 32 * u + 16 * t + 4 * fq + j; pv[j] = (m <= n) ? sc_[j] * __builtin_amdgcn_exp2f(lg * (float)(n - m)) : 0.f; }
                    pw[t * 2] = cvt_pk_bf16(pv[0], pv[1]); pw[t * 2 + 1] = cvt_pk_bf16(pv[2], pv[3]); }
                u32x4 w4; w4.x = pw[0]; w4.y = pw[1]; w4.z = pw[2]; w4.w = pw[3]; const bf16x8 pf = __builtin_bit_cast(bf16x8, w4);
#pragma unroll
                for (int dt = 0; dt < 4; ++dt) { const LAS bf16_t* vp = VL + (16 * (4 * dh + dt) + fr) * 72 + 32 * u + 4 * fq;
                    const u32x2 v0 = *(const LAS u32x2*)vp, v1 = *(const LAS u32x2*)(vp + 16); u32x4 w; w.x = v0.x; w.y = v0.y; w.z = v1.x; w.w = v1.y;
                    acc[dt] = __builtin_amdgcn_mfma_f32_16x16x32_bf16(__builtin_bit_cast(bf16x8, w), pf, acc[dt], 0, 0, 0); }
            }
            float ss = 0.f;
#pragma unroll
            for (int dt = 0; dt < 4; ++dt) ss += acc[dt][0] * acc[dt][0] + acc[dt][1] * acc[dt][1] + acc[dt][2] * acc[dt][2] + acc[dt][3] * acc[dt][3];
            ss += __shfl_xor(ss, 16); ss += __shfl_xor(ss, 32);
            if (fq == 0) XL[(qs * 2 + dh) * 16 + fr] = ss;
            __syncthreads();
            const float rs = rsqrtf((XL[(qs * 2) * 16 + fr] + XL[(qs * 2 + 1) * 16 + fr]) * (1.f / 128.f) + EPS);
#pragma unroll
            for (int dt = 0; dt < 4; ++dt) { const int dvc = 16 * (4 * dh + dt) + 4 * fq; const u32x2 gw = *(const u32x2*)(Z + (size_t)qrow * ZW + BG + h * 128 + dvc);
                const float g0 = bflo(gw.x), g1 = bfhi(gw.x), g2 = bflo(gw.y), g3 = bfhi(gw.y); u32x2 w;
                w.x = cvt_pk_bf16(acc[dt][0] * rs * g0 * sigmoidf_(g0), acc[dt][1] * rs * g1 * sigmoidf_(g1)); w.y = cvt_pk_bf16(acc[dt][2] * rs * g2 * sigmoidf_(g2), acc[dt][3] * rs * g3 * sigmoidf_(g3));
                *(u32x2*)(Z + (size_t)qrow * ZW + BQ + h * 128 + dvc) = w; }
        }
        __syncthreads();
    }
}

__device__ __forceinline__ void attn_item(const Params& P, int l, LAS unsigned char* lds, int it, int tid) {
    const int lane = tid & 63, wave = tid >> 6, fr = lane & 15, fq = lane >> 4;
    bf16_t* Z = (bf16_t*)(P.ws + WS_ZB);
    {

            const int ia = it - 1024, hp = ia & 3, c = (ia >> 2) & 255, b = ia >> 10, hsel = wave >> 2, h = hp * 2 + hsel, qs = wave & 3;
            const int sb = b * SEQ, qpos = c * 64 + qs * 16 + fr; const size_t qrow = (size_t)(sb + qpos);
            LAS bf16_t* KS = (LAS bf16_t*)lds;
            LAS bf16_t* VS = (LAS bf16_t*)(lds + 36864);
            LAS float* BL = (LAS float*)(lds + 73728);
            const bf16x8 q0 = *(const bf16x8*)(Z + qrow * ZW + AQ + h * 64 + 8 * fq), q1 = *(const bf16x8*)(Z + qrow * ZW + AQ + h * 64 + 32 + 8 * fq);
            f32x4 acc[4];
#pragma unroll
            for (int dt = 0; dt < 4; ++dt) acc[dt] = (f32x4){0.f, 0.f, 0.f, 0.f};
            float mrun = -1e30f, lrun = 0.f;
            const int jlo = c >= 8 ? 0 : 8 - c;
            u32x4 gk[2], gv[2];
#define AT_LOAD(j_) do { const size_t rb_ = (size_t)(sb + (c - 8 + (j_)) * 64); _Pragma("unroll") for (int i_ = 0; i_ < 2; ++i_) { const int p_ = tid + 512 * i_, hd_ = p_ >> 9, r_ = (p_ >> 3) & 63, sg_ = p_ & 7; \
        gk[i_] = *(const u32x4*)(Z + (rb_ + r_) * ZW + AK + (hp * 2 + hd_) * 64 + sg_ * 8); gv[i_] = *(const u32x4*)(Z + (rb_ + r_) * ZW + AV + (hp * 2 + hd_) * 64 + sg_ * 8); } } while (0)
#define AT_WRITE(st_) do { _Pragma("unroll") for (int i_ = 0; i_ < 2; ++i_) { const int p_ = tid + 512 * i_, hd_ = p_ >> 9, r_ = (p_ >> 3) & 63, sg_ = p_ & 7; \
        *(LAS u32x4*)(KS + ((st_) * 2 + hd_) * 4608 + r_ * 72 + sg_ * 8) = gk[i_]; *(LAS u32x4*)(VS + ((st_) * 2 + hd_) * 4608 + r_ * 72 + sg_ * 8) = gv[i_]; } } while (0)
            AT_LOAD(jlo);
            for (int e = tid; e < 640; e += 512) BL[e] = PIN(13)[(size_t)(l * 8 + hp * 2) * 320 + e] * 1.4426950408889634f;
            AT_WRITE(0);
            __syncthreads();
            for (int j = jlo; j < 9; ++j) {
                const int st = (j - jlo) & 1;
                if (j < 8) AT_LOAD(j + 1);
                const LAS bf16_t* ks = KS + (st * 2 + hsel) * 4608; const LAS bf16_t* vs = VS + (st * 2 + hsel) * 4608; const LAS float* bl = BL + hsel * 320;
#pragma unroll
                for (int u = 0; u < 2; ++u) {
                    const int kb = (c - 8 + j) * 64 + 32 * u;
                    float sv[8];
#pragma unroll
                    for (int t = 0; t < 2; ++t) { const LAS bf16_t* kp = ks + (32 * u + 16 * t + fr) * 72 + 8 * fq;
                        f32x4 sc_ = (f32x4){0.f, 0.f, 0.f, 0.f};
                        sc_ = __builtin_amdgcn_mfma_f32_16x16x32_bf16(*(const LAS bf16x8*)kp, q0, sc_, 0, 0, 0); sc_ = __builtin_amdgcn_mfma_f32_16x16x32_bf16(*(const LAS bf16x8*)(kp + 32), q1, sc_, 0, 0, 0);
                        if (j <= 3) {
                            const float bc = bl[319];
#pragma unroll
                            for (int jj = 0; jj < 4; ++jj) sv[t * 4 + jj] = sc_[jj] * 0.18033688011112042f + bc;
                        } else {
#pragma unroll
                            for (int jj = 0; jj < 4; ++jj) { int rel = qpos - (kb + 16 * t + 4 * fq + jj); rel = rel > 256 ? 256 : rel; sv[t * 4 + jj] = sc_[jj] * 0.18033688011112042f + bl[rel + 63]; }
                        } }
                    float mx = sv[0];
#pragma unroll
                    for (int e = 1; e < 8; ++e) mx = fmaxf(mx, sv[e]);
                    mx = fmaxf(mx, __shfl_xor(mx, 16)); mx = fmaxf(mx, __shfl_xor(mx, 32));
                    const float mnew = fmaxf(mrun, mx), alpha = __builtin_amdgcn_exp2f(mrun - mnew); mrun = mnew;
                    float ps = 0.f;
#pragma unroll
                    for (int e = 0; e < 8; ++e) { sv[e] = __builtin_amdgcn_exp2f(sv[e] - mnew); ps += sv[e]; }
                    lrun = lrun * alpha + ps;
                    u32x4 pw; pw.x = cvt_pk_bf16(sv[0], sv[1]); pw.y = cvt_pk_bf16(sv[2], sv[3]); pw.z = cvt_pk_bf16(sv[4], sv[5]); pw.w = cvt_pk_bf16(sv[6], sv[7]);
                    const bf16x8 pf = __builtin_bit_cast(bf16x8, pw);
#pragma unroll
                    for (int dt = 0; dt < 4; ++dt) { const LAS bf16_t* vp = vs + (16 * dt + fr) * 72 + 32 * u + 4 * fq;
                        const u32x2 v0 = *(const LAS u32x2*)vp, v1 = *(const LAS u32x2*)(vp + 16); u32x4 w; w.x = v0.x; w.y = v0.y; w.z = v1.x; w.w = v1.y;
                        acc[dt] = acc[dt] * alpha;
                        acc[dt] = __builtin_amdgcn_mfma_f32_16x16x32_bf16(__builtin_bit_cast(bf16x8, w), pf, acc[dt], 0, 0, 0); }
                }
                if (j < 8) AT_WRITE(st ^ 1);
                __syncthreads();
            }
            lrun += __shfl_xor(lrun, 16); lrun += __shfl_xor(lrun, 32);
            const float inv = 1.f / lrun;
#pragma unroll
            for (int dt = 0; dt < 4; ++dt) { u32x2 w; w.x = cvt_pk_bf16(acc[dt][0] * inv, acc[dt][1] * inv); w.y = cvt_pk_bf16(acc[dt][2] * inv, acc[dt][3] * inv);
                *(u32x2*)(Z + qrow * ZW + AQ + h * 64 + 16 * dt + 4 * fq) = w; }
    }
}

__device__ __forceinline__ void c2_phase(const Params& P, int l, LAS unsigned char* lds) {
    const int tid = tid_opaque(), tok = tid >> 3, sub = tid & 7;
    bf16_t* Z = (bf16_t*)(P.ws + WS_ZB); bf16_t* XW = (bf16_t*)(P.ws + WS_XNB);
    (void)lds;
    for (int it = bid_opaque(); it < 528 * 4; it += gridDim.x) {
        const int tile = it >> 2, hp = it & 3, r0 = tile * 64, row = r0 + tok; const bool prompt = tile < 512; const int sr = row - T_P;
        const bool sfirst = !prompt && (sr & 31) == 0; const float* sh = sfirst ? PIN(8) + ((size_t)l * 32 + (sr >> 5)) * 1792 : nullptr;
        const bool pzero = prompt && tok == 0 && (r0 & (SEQ - 1)) == 0;
        const bf16_t* prow = (tok > 0) ? Z + (size_t)(row - 1) * ZW + CR : (const bf16_t*)(P.ws + WS_CZB) + (size_t)(tile > 0 ? tile - 1 : 0) * 1536;
        u32x4 cu[2][3], pv_[2][3], wa[2][2];
#pragma unroll
        for (int q = 0; q < 2; ++q) { const int hc = (hp * 2 + q) * 64 + sub * 8;
#pragma unroll
            for (int part = 0; part < 3; ++part) { cu[q][part] = *(const u32x4*)(Z + (size_t)row * ZW + CR + part * 512 + hc); pv_[q][part] = *(const u32x4*)(prow + part * 512 + hc); }
            wa[q][0] = *(const u32x4*)(XW + (size_t)row * DM + hc); wa[q][1] = *(const u32x4*)(XW + (size_t)row * DM + 512 + hc); }
        asm volatile("s_waitcnt vmcnt(0)" ::: "memory");
        __syncthreads();
        const float* mu = PIN(14) + (size_t)l * 1792;
#pragma unroll
        for (int q = 0; q < 2; ++q) { const int h = hp * 2 + q, hc = h * 64 + sub * 8;
            float r[8], k[8], v[8], wr_[8], ar_[8], kk[8], pr[8], pk[8], pvv[8];
            unpack8(cu[q][0], r); unpack8(cu[q][1], k); unpack8(cu[q][2], v); unpack8(pv_[q][0], pr); unpack8(pv_[q][1], pk); unpack8(pv_[q][2], pvv); unpack8(wa[q][0], wr_); unpack8(wa[q][1], ar_);
#pragma unroll
            for (int e = 0; e < 8; ++e) { float a_ = pr[e], b_ = pk[e], c_ = pvv[e];
                if (sfirst) { a_ = sh[hc + e]; b_ = sh[512 + hc + e]; c_ = sh[1024 + hc + e]; } else if (pzero) { a_ = 0.f; b_ = 0.f; c_ = 0.f; }
                r[e] = r[e] + (a_ - r[e]) * mu[hc + e]; k[e] = k[e] + (b_ - k[e]) * mu[512 + hc + e]; v[e] = v[e] + (c_ - v[e]) * mu[1024 + hc + e]; }
            const float* w0 = PIN(15) + l * 512 + hc; const float* a0 = PIN(17) + l * 512 + hc; const float* kkw = PIN(20) + l * 512 + hc; const float* kaw = PIN(21) + l * 512 + hc; const float* rk = PIN(22) + l * 512 + hc;
            float ss = 0.f, bn = 0.f;
#pragma unroll
            for (int e = 0; e < 8; ++e) { kk[e] = k[e] * kkw[e]; ss += kk[e] * kk[e]; }
            const float rn = rsqrtf(fmaxf(sum8(ss), 1e-24f));
#pragma unroll
            for (int e = 0; e < 8; ++e) { const float a = sigmoidf_(a0[e] + ar_[e]); const float ew = 0.6065306597126334f * sigmoidf_(w0[e] + wr_[e]);
                kk[e] *= rn; k[e] = k[e] * (1.f + (a - 1.f) * kaw[e]); bn += r[e] * k[e] * rk[e]; wr_[e] = ew; ar_[e] = kk[e] * a; }
            bn = sum8(bn);
            *(u32x4*)(Z + (size_t)row * ZW + CR + hc) = pack8(r); *(u32x4*)(Z + (size_t)row * ZW + CK + hc) = pack8(k); *(u32x4*)(Z + (size_t)row * ZW + CV + hc) = pack8(v);
            *(u32x4*)(Z + (size_t)row * ZW + BV + hc) = pack8(kk); *(u32x4*)(XW + (size_t)row * DM + hc) = pack8(wr_); *(u32x4*)(XW + (size_t)row * DM + 512 + hc) = pack8(ar_);
            if (sub == 0) ((float*)(P.ws + WS_BONUS))[(size_t)row * 8 + h] = bn; }
        __syncthreads();
    }
}

__device__ __forceinline__ void scan_phase(const Params& P, int l, LAS unsigned char* lds) {
    const int tid = tid_opaque(), lane = tid & 63, wave = tid >> 6;
    bf16_t* Z = (bf16_t*)(P.ws + WS_ZB); const bf16_t* XW = (const bf16_t*)(P.ws + WS_XNB);
    LAS float* buf = (LAS float*)lds;
    LAS float* ybuf = (LAS float*)(lds + 86016);
    const int bid_ = bid_opaque(), nidle_ = (int)gridDim.x > 192 ? (int)gridDim.x - 192 : 0;
    for (int it = (bid_ < 192 || nidle_ == 0) ? bid_ : 192 + (bid_ - 192); it < 192 + 1024; it += (bid_ < 192 ? (nidle_ ? 100000 : (int)gridDim.x) : nidle_)) {
        int rowbase, nsteps, h, qt, part = 0; const float* S0 = nullptr; float* So; bf16_t* yout; size_t ypitch = ZW;
        if (it < 192) { const int chain = it / 12, sub12 = it % 12, b = chain >> 3; h = chain & 7; part = sub12 >> 2; qt = sub12 & 3; nsteps = SEQ / 2; rowbase = b * SEQ + (part ? SEQ / 2 : 0);
            So = (float*)(P.ws + (part == 0 ? WS_SMID : (part == 1 ? WS_SP1 : WS_PHI))) + (size_t)chain * 4096;
            if (part < 2) yout = Z + (size_t)rowbase * ZW + BK + h * 64 + qt * 16; else { yout = (bf16_t*)(P.ws + WS_YPHI) + (size_t)b * (SEQ / 2) * 512 + h * 64 + qt * 16; ypitch = 512; } }
        else { const int si = it - 192, s = si >> 5; h = (si >> 2) & 7; qt = si & 3; rowbase = T_P + s * 32; nsteps = 32; S0 = PIN(7) + ((size_t)((l * 32 + s) * 8 + h)) * 4096; So = P.out + O_RWS + ((size_t)((l * 32 + s) * 8 + h)) * 4096;
            yout = Z + (size_t)rowbase * ZW + BK + h * 64 + qt * 16; }
        const int i0 = qt * 16, nb = nsteps >> 5;
        const int lt = tid - 256, lstep = lt >> 3, lsub = lt & 7;
        const int rr = lane >> 4, jl = lane & 15, li = 4 * wave + rr;
        f32x2v Sa = {0.f, 0.f}, Sb = {0.f, 0.f};
        u32x4 g_ew = {0u,0u,0u,0u}, g_k = g_ew, g_kk = g_ew, g_ka = g_ew, g_r = g_ew, g_v = g_ew;
        if (wave < 4 && S0) { const f32x4 s4 = *(const f32x4*)(S0 + (size_t)(i0 + li) * 64 + 4 * jl); Sa = (f32x2v){s4[0], s4[1]}; Sb = (f32x2v){s4[2], s4[3]}; }
        if (part == 2) { const int d_ = i0 + li - 4 * jl; Sa = (f32x2v){d_ == 0 ? 1.f : 0.f, d_ == 1 ? 1.f : 0.f}; Sb = (f32x2v){d_ == 2 ? 1.f : 0.f, d_ == 3 ? 1.f : 0.f}; }
        for (int bb = -1; bb < nb; ++bb) {
            if (wave >= 4) {
#define SC_LOAD(bt) do { const size_t row_ = (size_t)(rowbase + (bt) * 32 + lstep); g_ew = *(const u32x4*)(XW + row_ * DM + h * 64 + lsub * 8); g_k = *(const u32x4*)(Z + row_ * ZW + CK + h * 64 + lsub * 8); \
        g_kk = *(const u32x4*)(Z + row_ * ZW + BV + h * 64 + lsub * 8); g_ka = *(const u32x4*)(XW + row_ * DM + 512 + h * 64 + lsub * 8); g_r = *(const u32x4*)(Z + row_ * ZW + CR + h * 64 + lsub * 8); \
        if (lsub < 2 && part != 2) g_v = *(const u32x4*)(Z + row_ * ZW + CV + h * 64 + i0 + lsub * 8); } while (0)
#define SC_WRITE(bt) do { LAS float* d = buf + ((bt) & 1) * 10752 + lstep * 336; float f[8]; unpack8(g_ew, f); \
        *(LAS f32x4*)(d + lsub * 8) = (f32x4){__expf(-f[0]), __expf(-f[1]), __expf(-f[2]), __expf(-f[3])}; *(LAS f32x4*)(d + lsub * 8 + 4) = (f32x4){__expf(-f[4]), __expf(-f[5]), __expf(-f[6]), __expf(-f[7])}; \
        unpack8(g_k, f); *(LAS f32x4*)(d + 64 + lsub * 8) = (f32x4){f[0], f[1], f[2], f[3]}; *(LAS f32x4*)(d + 64 + lsub * 8 + 4) = (f32x4){f[4], f[5], f[6], f[7]}; \
        unpack8(g_kk, f); *(LAS f32x4*)(d + 128 + lsub * 8) = (f32x4){f[0], f[1], f[2], f[3]}; *(LAS f32x4*)(d + 128 + lsub * 8 + 4) = (f32x4){f[4], f[5], f[6], f[7]}; \
        unpack8(g_ka, f); *(LAS f32x4*)(d + 192 + lsub * 8) = (f32x4){f[0], f[1], f[2], f[3]}; *(LAS f32x4*)(d + 192 + lsub * 8 + 4) = (f32x4){f[4], f[5], f[6], f[7]}; \
        unpack8(g_r, f); *(LAS f32x4*)(d + 256 + lsub * 8) = (f32x4){f[0], f[1], f[2], f[3]}; *(LAS f32x4*)(d + 256 + lsub * 8 + 4) = (f32x4){f[4], f[5], f[6], f[7]}; \
        if (lsub < 2) { unpack8(g_v, f); *(LAS f32x4*)(d + 320 + lsub * 8) = (f32x4){f[0], f[1], f[2], f[3]}; *(LAS f32x4*)(d + 320 + lsub * 8 + 4) = (f32x4){f[4], f[5], f[6], f[7]}; } } while (0)
                if (bb == -1) { SC_LOAD(0); SC_WRITE(0); if (nb > 1) SC_LOAD(1); }
                else { if (bb + 1 < nb) SC_WRITE(bb + 1); if (bb + 2 < nb) SC_LOAD(bb + 2); }
                if (bb >= 1 && lsub < 2) {
                    const LAS float* y = ybuf + ((bb - 1) & 1) * 512 + lstep * 16 + lsub * 8; float f[8];
#pragma unroll
                    for (int e = 0; e < 8; ++e) f[e] = y[e];
                    *(u32x4*)(yout + (size_t)((bb - 1) * 32 + lstep) * ypitch + lsub * 8) = pack8(f);
                }
            } else if (bb >= 0) {
                __builtin_amdgcn_s_setprio(3);
                const LAS float* bp = buf + (bb & 1) * 10752 + 4 * jl; const LAS float* vp_ = buf + (bb & 1) * 10752 + 320 + li; LAS float* yb = ybuf + (bb & 1) * 512;
                float ysel = 0.f, yprev = 0.f;
                f32x4 cw = *(const LAS f32x4*)(bp), ck_ = *(const LAS f32x4*)(bp + 64), ckk = *(const LAS f32x4*)(bp + 128), cka = *(const LAS f32x4*)(bp + 192), cr = *(const LAS f32x4*)(bp + 256); float cv = vp_[0];
                f32x2v m = Sa * (f32x2v){ckk[0], ckk[1]}; m = Sb * (f32x2v){ckk[2], ckk[3]} + m;
                float a = m.x + m.y;
#pragma unroll
                for (int st = 0; st < 32; ++st) {
                    const int sn = (st + 1 < 32) ? st + 1 : st;
                    const f32x4 nw = *(const LAS f32x4*)(bp + sn * 336), nk = *(const LAS f32x4*)(bp + sn * 336 + 64), nkk = *(const LAS f32x4*)(bp + sn * 336 + 128), nka = *(const LAS f32x4*)(bp + sn * 336 + 192), nr = *(const LAS f32x4*)(bp + sn * 336 + 256); const float nv = vp_[sn * 336];
                    float b = yprev;
                    a += dppf<0xB1>(a); b += dppf<0xB1>(b); a += dppf<0x4E>(a); b += dppf<0x4E>(b); a += dppf<0x141>(a); b += dppf<0x141>(b); a += dppf<0x140>(a); b += dppf<0x140>(b);
                    if (st > 0) { ysel = (jl == ((st - 1) & 3)) ? b : ysel; if (((st - 1) & 3) == 3 && jl < 4) yb[(st - 4 + jl) * 16 + li] = ysel; }
                    const float nsa = -a; const f32x2v vi2 = {cv, cv}, ns2 = {nsa, nsa};
                    const f32x2v ta = (f32x2v){cka[0], cka[1]} * ns2 + (f32x2v){ck_[0], ck_[1]} * vi2, tb = (f32x2v){cka[2], cka[3]} * ns2 + (f32x2v){ck_[2], ck_[3]} * vi2;
                    Sa = Sa * (f32x2v){cw[0], cw[1]} + ta; Sb = Sb * (f32x2v){cw[2], cw[3]} + tb;
                    f32x2v ym = Sa * (f32x2v){cr[0], cr[1]}; ym = Sb * (f32x2v){cr[2], cr[3]} + ym; yprev = ym.x + ym.y;
                    f32x2v mm = Sa * (f32x2v){nkk[0], nkk[1]}; mm = Sb * (f32x2v){nkk[2], nkk[3]} + mm; a = mm.x + mm.y;
                    cw = nw; ck_ = nk; ckk = nkk; cka = nka; cr = nr; cv = nv;
                }
                { float b = red16(yprev); ysel = (jl == 3) ? b : ysel; if (jl < 4) yb[(28 + jl) * 16 + li] = ysel; }
                __builtin_amdgcn_s_setprio(0);
            }
            __syncthreads();
        }
        if (wave >= 4 && lsub < 2) { const LAS float* y = ybuf + ((nb - 1) & 1) * 512 + lstep * 16 + lsub * 8; float f[8];
#pragma unroll
            for (int e = 0; e < 8; ++e) f[e] = y[e];
            *(u32x4*)(yout + (size_t)((nb - 1) * 32 + lstep) * ypitch + lsub * 8) = pack8(f); }
        if (wave < 4) *(f32x4*)(So + (size_t)(i0 + li) * 64 + 4 * jl) = (f32x4){Sa.x, Sa.y, Sb.x, Sb.y};
        __syncthreads();
    }
    {
        unsigned* ctr = (unsigned*)(P.ws + 14336) + l;
        LAS int* slot = (LAS int*)(lds + 131072 + 1024);
        int nxt = 0;
        if (tid == 0) nxt = (int)atomicAdd(ctr, 1u);
        for (;;) {
            __syncthreads();
            if (tid == 0) { slot[0] = nxt; nxt = (int)atomicAdd(ctr, 1u); }
            __syncthreads();
            const int idx = slot[0];
            if (idx >= 512 + 2048) break;
            if (idx < 512) sattn_item(P, l, lds, idx, tid); else attn_item(P, l, lds, 1024 + idx - 512, tid);
        }
    }
}

__device__ __forceinline__ void e2_phase(const Params& P, int l) {
    const int tid = tid_opaque(), tok = tid >> 3, sub = tid & 7;
    bf16_t* Z = (bf16_t*)(P.ws + WS_ZB);
    {
        const float* SM = (const float*)(P.ws + WS_SMID); const float* S1 = (const float*)(P.ws + WS_SP1); const float* PH = (const float*)(P.ws + WS_PHI);
        for (int e = bid_opaque() * 512 + tid; e < 16 * 4096; e += gridDim.x * 512) { const int chain = e >> 12, i = (e >> 6) & 63, j = e & 63; float a = S1[e];
#pragma unroll 16
            for (int m = 0; m < 64; ++m) a += SM[chain * 4096 + i * 64 + m] * PH[chain * 4096 + m * 64 + j];
            P.out[O_RWP + (size_t)(l * 16 + chain) * 4096 + i * 64 + j] = a; }
    }
    const int wave = tid >> 6, lane = tid & 63, fr = lane & 15, fq = lane >> 4, tt = wave & 3, ih = wave >> 2;
    for (int t_ = bid_opaque(); t_ < 528; t_ += gridDim.x) {
        const int tile = (t_ >= 256 && t_ < 512) ? 256 + ((t_ - 256) ^ 128) : t_;
        if (tile < 512 && (tile & 255) >= 128) {
            const int b = tile >> 8, tl = ((tile & 255) - 128) * 64 + tt * 16 + fr;
            for (int h = 0; h < 8; ++h) {
                const float* SM = (const float*)(P.ws + WS_SMID) + (size_t)(b * 8 + h) * 4096;
                const bf16_t* yp = (const bf16_t*)(P.ws + WS_YPHI) + ((size_t)b * (SEQ / 2) + tl) * 512 + h * 64;
                const bf16x8 yb0 = *(const bf16x8*)(yp + 8 * fq), yb1 = *(const bf16x8*)(yp + 32 + 8 * fq);
                bf16_t* yrow = Z + (size_t)(b * SEQ + SEQ / 2 + tl) * ZW + BK + h * 64;
#pragma unroll
                for (int q = 0; q < 2; ++q) { const int i = (ih * 2 + q) * 16 + fr; f32x4 acc = (f32x4){0.f, 0.f, 0.f, 0.f};
#pragma unroll
                    for (int kk = 0; kk < 2; ++kk) { const f32x4 s0 = *(const f32x4*)(SM + i * 64 + 32 * kk + 8 * fq), s1 = *(const f32x4*)(SM + i * 64 + 32 * kk + 8 * fq + 4);
                        u32x4 w; w.x = cvt_pk_bf16(s0[0], s0[1]); w.y = cvt_pk_bf16(s0[2], s0[3]); w.z = cvt_pk_bf16(s1[0], s1[1]); w.w = cvt_pk_bf16(s1[2], s1[3]);
                        acc = __builtin_amdgcn_mfma_f32_16x16x32_bf16(__builtin_bit_cast(bf16x8, w), kk ? yb1 : yb0, acc, 0, 0, 0); }
                    bf16_t* dp = yrow + (ih * 2 + q) * 16 + 4 * fq; const u32x2 o = *(const u32x2*)dp; u32x2 w;
                    w.x = cvt_pk_bf16(bflo(o.x) + acc[0], bfhi(o.x) + acc[1]); w.y = cvt_pk_bf16(bflo(o.y) + acc[2], bfhi(o.y) + acc[3]); *(u32x2*)dp = w; }
            }
            __syncthreads();
        }
        const size_t row = (size_t)tile * 64 + tok;
#pragma unroll
        for (int hq = 0; hq < 2; ++hq) {
            u32x4 ry[4], rv[4], rg[4]; float bnv[4];
#pragma unroll
            for (int q = 0; q < 4; ++q) { const int h = hq * 4 + q, hc = h * 64 + sub * 8; ry[q] = *(const u32x4*)(Z + row * ZW + BK + hc); rv[q] = *(const u32x4*)(Z + row * ZW + CV + hc); rg[q] = *(const u32x4*)(Z + row * ZW + BG + hc);
                bnv[q] = ((const float*)(P.ws + WS_BONUS))[row * 8 + h]; }
#pragma unroll
            for (int q = 0; q < 4; ++q) { const int h = hq * 4 + q, hc = h * 64 + sub * 8; float y[8], v[8], g[8], o[8];
                unpack8(ry[q], y); unpack8(rv[q], v); unpack8(rg[q], g);
                float s_ = 0.f;
#pragma unroll
                for (int e = 0; e < 8; ++e) s_ += y[e];
                const float mean = sum8(s_) * (1.f / 64.f); float q2 = 0.f;
#pragma unroll
                for (int e = 0; e < 8; ++e) { const float d = y[e] - mean; q2 += d * d; }
                const float rs = rsqrtf(sum8(q2) * (1.f / 64.f) + 64e-5f);
                const float bn = bnv[q];
                const float* lw = PIN(23) + l * 512 + hc; const float* lb = PIN(24) + l * 512 + hc;
#pragma unroll
                for (int e = 0; e < 8; ++e) o[e] = ((y[e] - mean) * rs * lw[e] + lb[e] + bn * v[e]) * g[e];
                *(u32x4*)(Z + row * ZW + CR + hc) = pack8(o); }
        }
    }
}

#define XB_TMO      128
#define XB_XCNT(j)  (256  + 64 * (j))
#define XB_XSUB(j)  (1280 + 64 * (j))
#define XB_XGEN(j)  (2304 + 64 * (j))
#define XB_TOP      3328
#define XB_TOPGEN   3392
#define XCD_BAR_WORDS 3456
#define XB_SPIN_CAP (1u << 22)
__device__ __forceinline__ unsigned xb_ld(unsigned* p)              { return __hip_atomic_load(p, __ATOMIC_RELAXED, __HIP_MEMORY_SCOPE_AGENT); }
__device__ __forceinline__ unsigned xb_add(unsigned* p, unsigned v) { return __hip_atomic_fetch_add(p, v, __ATOMIC_RELAXED, __HIP_MEMORY_SCOPE_AGENT); }
__device__ __forceinline__ unsigned xb_xcc_id() { return (unsigned)__builtin_amdgcn_s_getreg((3 << 11) | 20) & 0xFu; }
#define XB_SPIN(cond, bar) do { unsigned _sp = 0; while (cond) { __builtin_amdgcn_s_sleep(1); \
    if ((++_sp & 255u) == 0u) { if (xb_ld(&(bar)[XB_TMO])) break; if (_sp > XB_SPIN_CAP) { atomicAdd(&(bar)[XB_TMO], 1u); break; } } } } while (0)
struct XcdBarrier { unsigned* bar; unsigned x; volatile LAS unsigned* st; };
__device__ __forceinline__ XcdBarrier xcd_barrier_post(unsigned* bar, volatile LAS unsigned* st) {
    XcdBarrier b; b.bar = bar; b.x = xb_xcc_id(); b.st = st;
    if (threadIdx.x == 0) (void)xb_add(&bar[XB_XCNT(b.x)], 1u);
    return b;
}
__device__ __forceinline__ void xcd_barrier_complete(unsigned* bar, unsigned x, unsigned& nloc, unsigned& nx) {
    const unsigned G = gridDim.x * gridDim.y * gridDim.z;
    unsigned sum, cnt, mine, sp = 0u;
    for (;;) {
        sum = 0u; cnt = 0u; mine = 0u;
#pragma unroll
        for (unsigned j = 0; j < 16; ++j) { const unsigned c = xb_ld(&bar[XB_XCNT(j)]); sum += c; cnt += (c > 0u) ? 1u : 0u; mine = (j == x) ? c : mine; }
        if (sum == G) break;
        __builtin_amdgcn_s_sleep(1);
        if ((++sp & 255u) == 0u) { if (xb_ld(&bar[XB_TMO])) break; if (sp > XB_SPIN_CAP) { atomicAdd(&bar[XB_TMO], 1u); break; } }
    }
    nloc = mine > 0u ? mine : 1u; nx = cnt > 0u ? cnt : 1u;
}
__device__ __forceinline__ void xcd_barrier(const XcdBarrier& b) {
    asm volatile("s_waitcnt vmcnt(0)" ::: "memory");
    __syncthreads();
    if (threadIdx.x == 0) {
        unsigned* bar = b.bar;
        __builtin_amdgcn_s_waitcnt(0);
        unsigned nloc = b.st[0], nx = b.st[1];
        if (nloc == 0u) { xcd_barrier_complete(bar, b.x, nloc, nx); b.st[0] = nloc; b.st[1] = nx; }
        const unsigned old = xb_add(&bar[XB_XSUB(b.x)], 1u);
        const unsigned gen = old / nloc;
        if (old + 1u == (gen + 1u) * nloc) {
            __builtin_amdgcn_fence(__ATOMIC_RELEASE, "agent");
            asm volatile("s_waitcnt vmcnt(0)" ::: "memory");
            const unsigned og = xb_add(&bar[XB_TOP], 1u);
            const unsigned tg = og / nx;
            if (og + 1u == (tg + 1u) * nx) xb_add(&bar[XB_TOPGEN], 1u);
            else XB_SPIN(xb_ld(&bar[XB_TOPGEN]) == tg, bar);
            __builtin_amdgcn_fence(__ATOMIC_ACQUIRE, "agent");
            xb_add(&bar[XB_XGEN(b.x)], 1u);
            asm volatile("s_waitcnt vmcnt(0)" ::: "memory");
        } else {
            XB_SPIN(xb_ld(&bar[XB_XGEN(b.x)]) == gen, bar);
            __builtin_amdgcn_fence(__ATOMIC_ACQUIRE, "agent");
            asm volatile("s_waitcnt vmcnt(0)" ::: "memory");
        }
    }
    __syncthreads();
}

__global__ void __launch_bounds__(512, 2) mega_fwd(Params P) {
    extern __shared__ __attribute__((aligned(16))) unsigned char lds_raw[];
    LAS unsigned char* lds = (LAS unsigned char*)lds_raw;
    unsigned char* ws = P.ws;
    bf16_t* Z = (bf16_t*)(ws + WS_ZB); bf16_t* XNB = (bf16_t*)(ws + WS_XNB); bf16_t* LOB = (bf16_t*)(ws + WS_LOB); bf16_t* WT = (bf16_t*)(ws + WS_W);
    volatile LAS unsigned* bst = (volatile LAS unsigned*)(lds + 131072 + 512);
    if (threadIdx.x < 2) bst[threadIdx.x] = 0u;
    __syncthreads();
    XcdBarrier xbar = xcd_barrier_post((unsigned*)ws, bst);
    for (int ph = P.ph_lo; ph < P.ph_hi; ++ph) {
        if (ph == 0) { convert_weights(P, 0, lds); row_norm_pass(P, 0, 0); }
        else {
            const int l = (ph - 1) / NPH_LAYER, k = (ph - 1) % NPH_LAYER;
            GemmDesc g; g.sched = -1; g.lda = g.ldb = 1024; g.K = 1024; g.nM = 132; g.nN = 4; g.epi = 0; g.perm = 1; g.d0 = nullptr; g.ldc0 = 1024; g.d1 = nullptr; g.x = nullptr; g.z = Z; g.A = nullptr; g.B = nullptr; g.skip = 0;
            switch (k) {
            case 0: g.sched = 0; g.A = (const char*)XNB; g.B = (const char*)(WT + W_Z); g.nN = 21; g.d0 = Z; g.ldc0 = ZW; break;
            case 1: e1_phase(P, l, lds); break;
            case 2: p2_phase(P, l, lds); break;
            case 3: p3_phase(P, l, lds); break;
            case 4: g.sched = 0; g.A = (const char*)LOB; g.lda = 256; g.B = (const char*)(WT + W_BD); g.ldb = 256; g.K = 256; g.nN = 6; g.epi = 1; g.d0 = XNB; break;
            case 5: c2_phase(P, l, lds); break;
            case 6: scan_phase(P, l, lds); break;
            case 7: e2_phase(P, l); row_norm_pass(P, l, 1); break;
            case 8: g.sched = 0; g.A = (const char*)XNB; g.B = (const char*)(WT + W_GL); g.nN = 12; g.epi = 2; g.d0 = Z; g.ldc0 = ZW; break;
            case 9: g.sched = 1; g.A = (const char*)Z; g.lda = ZW; g.B = (const char*)(WT + W_B); g.ldb = 512; g.K = 512; g.epi = 3; g.d0 = XNB; break;
            case 10: g.sched = 0; g.A = (const char*)XNB; g.B = (const char*)(WT + W_O); g.epi = 4; g.perm = 0; g.x = P.out; break;
            case 11: row_norm_pass(P, l, 2); break;
            case 12: g.sched = 0; g.A = (const char*)Z; g.B = (const char*)(WT + W_GU); g.nN = 22; g.epi = 5; g.d0 = (bf16_t*)(ws + WS_H); g.ldc0 = FF; break;
            case 13: g.sched = 0; g.A = (const char*)(ws + WS_H); g.lda = FF; g.B = (const char*)(WT + W_D); g.ldb = FF; g.K = FF; g.epi = 4; g.perm = 0; g.x = P.out; g.d1 = (bf16_t*)(ws + WS_XB); break;
            case 14: g.sched = 0; g.A = (const char*)(ws + WS_XB); g.B = (const char*)(WT + W_PG); g.d0 = Z; break;
            default: finish_pass(P, l); if (l == 0) convert_weights(P, 1, lds); break;
            }
            for (int rep = 0; rep < (k == 13 ? 2 : 1); ++rep) {
                if (rep == 1) { g.A = (const char*)LOB; g.lda = 256; g.B = (const char*)(WT + W_P); g.ldb = 256; g.K = 256; g.epi = 0; g.perm = 1; g.d0 = XNB; g.ldc0 = 1024; g.d1 = nullptr; g.x = nullptr;
                    g.skip = ((int)gridDim.x >= 128 && 528 > 2 * (int)gridDim.x && 528 < 3 * (int)gridDim.x) ? 528 - 2 * (int)gridDim.x : 0; }
                if (g.sched >= 0) gemm_phase(lds, g);
            }
#ifdef DBG_REP_MASK
            if ((DBG_REP_MASK >> k) & 1) { cg::this_grid().sync(); if (g.sched >= 0) gemm_phase(lds, g); else if (k == 6) scan_phase(P, l, lds); else if (k == 2) p2_phase(P, l, lds); }
#endif
        }
        if (ph + 1 < P.ph_hi) { if (P.ph_hi < 0) cg::this_grid().sync(); else xcd_barrier(xbar); }
#ifdef DBG_EXTRA_SYNC
        if (ph + 1 < P.ph_hi) { cg::this_grid().sync(); cg::this_grid().sync(); }
#endif
    }
#ifdef DBG_DUMP_Z
    cg::this_grid().sync();
    for (size_t e = (size_t)blockIdx.x * 512 + threadIdx.x; e < (size_t)T_ALL * 512; e += (size_t)gridDim.x * 512) {
        const size_t r = e >> 9; const int c = (int)(e & 511);
        P.out[e] = bf2f(XNB[e]); (void)r; (void)c;
    }
#endif
}

extern "C" void kernel_launch(void* const* d_in, const int* in_sizes, int n_in, void* d_out, int out_size, void* d_ws, size_t ws_size, hipStream_t stream) {
    static int grid = 0;
    if (grid == 0) {
        if (n_in != 34 || out_size != 45603840 || ws_size < WS_END2) { fprintf(stderr, "kernel_launch: unexpected shapes n_in %d out %d ws %zu\n", n_in, out_size, ws_size); grid = -1; return; }
        int dev = 0, cus = 0, per_cu = 0;
        hipGetDevice(&dev); hipDeviceGetAttribute(&cus, hipDeviceAttributeMultiprocessorCount, dev);
        hipFuncSetAttribute((const void*)mega_fwd, hipFuncAttributeMaxDynamicSharedMemorySize, LDS_BYTES);
        hipOccupancyMaxActiveBlocksPerMultiprocessor(&per_cu, (const void*)mega_fwd, 512, LDS_BYTES);
        if (per_cu < 1) { fprintf(stderr, "kernel_launch: occupancy query says %d blocks per CU\n", per_cu); per_cu = 1; }
        (void)hipGetLastError();
        grid = cus * per_cu;
        fprintf(stderr, "kernel_launch: grid %d (cus %d x %d)\n", grid, cus, per_cu);
    }
    if (grid < 0) return;
#ifdef DBG_POISON
    (void)hipMemsetAsync(d_ws, 0xFF, WS_END, stream);
#endif
    (void)hipMemsetAsync(d_ws, 0, 16384, stream);
    Params p{};
    for (int i = 0; i < 34; ++i) p.in[i] = (const float*)d_in[i];
    p.out = (float*)d_out; p.ws = (unsigned char*)d_ws;
#if MK_PER_PHASE
    for (int ph = 0; ph < NPHASES; ++ph) { p.ph_lo = ph; p.ph_hi = ph + 1; hipLaunchKernelGGL(mega_fwd, dim3(grid), dim3(512), LDS_BYTES, stream, p); }
#else
#ifdef DBG_PH_HI
    p.ph_lo = 0; p.ph_hi = DBG_PH_HI;
#else
    p.ph_lo = 0; p.ph_hi = NPHASES;
#endif
    void* args[] = {&p};
    hipError_t e = hipLaunchCooperativeKernel((const void*)mega_fwd, dim3(grid), dim3(512), args, LDS_BYTES, stream);
    if (e != hipSuccess) fprintf(stderr, "cooperative launch failed: %s (grid %d)\n", hipGetErrorString(e), grid);
#endif
}
```

```cpp
#include <hip/hip_runtime.h>
#include <hip/hip_cooperative_groups.h>
#include <cstdio>
#include <cstdint>
namespace cg = cooperative_groups;


#ifndef MK_PER_PHASE
#define MK_PER_PHASE 0
#endif

#define LAS __attribute__((address_space(3)))
typedef unsigned short bf16_t;
typedef short bf16x8 __attribute__((ext_vector_type(8)));
typedef float f32x4 __attribute__((ext_vector_type(4)));
typedef unsigned u32x4 __attribute__((ext_vector_type(4)));
typedef unsigned u32x2 __attribute__((ext_vector_type(2)));

constexpr int T_ALL = 33792, T_P = 32768, SEQ = 16384, DM = 1024, ZW = 5376, FF = 2816;
constexpr int AQ = 0, AK = 512, AV = 1024, BQ = 1536, BK = 2048, BV = 2560, BG = 3072, CR = 3584, CK = 4096, CV = 4608, CLO = 5120;
constexpr float EPS = 1e-6f;
constexpr int NPH_LAYER = 16, NPHASES = 1 + 2 * NPH_LAYER;
constexpr size_t O_YP = 0, O_AKP = 34603008, O_AVP = 35651584, O_RETP = 36700160, O_RWP = 36962304, O_SHP = 37093376,
                 O_AKS = 37100544, O_AVS = 38149120, O_RETS = 39197696, O_RWS = 43392000, O_SHS = 45489152;
constexpr size_t MiB = 1u << 20;
constexpr size_t WS_W = 1 * MiB, WS_XNB = 43 * MiB, WS_LOB = 109 * MiB, WS_ZB = 126 * MiB, WS_BONUS = 473 * MiB, WS_CZB = 475 * MiB, WS_END = 477 * MiB;
constexpr size_t WS_YPHI = 478 * MiB, WS_SMID = 495 * MiB, WS_SP1 = 496 * MiB, WS_PHI = 497 * MiB, WS_END2 = 498 * MiB;
constexpr size_t WS_H = WS_ZB + 66 * MiB, WS_XB = WS_ZB + 248 * MiB;
constexpr size_t W_Z = 0, W_GL = 5505024, W_BD = 8650752, W_B = 9043968, W_O = 10616832, W_GU = 11665408, W_D = 17432576, W_P = 20316160, W_PG = 20578304;
constexpr int LDS_BYTES = 147456;

struct Params { const float* in[34]; float* out; unsigned char* ws; int ph_lo, ph_hi; };

__device__ __forceinline__ const float* ld_in(const Params& P, int i) { asm volatile("" : "+s"(i)); return P.in[i]; }
#define PIN(i) ld_in(P, i)
__device__ __forceinline__ int tid_opaque() { int t = threadIdx.x; asm volatile("" : "+v"(t)); return t; }
__device__ __forceinline__ int bid_opaque() { int b = blockIdx.x; asm volatile("" : "+s"(b)); return b; }
typedef __bf16 bf16x2v __attribute__((ext_vector_type(2)));
typedef float f32x2v __attribute__((ext_vector_type(2)));
__device__ __forceinline__ unsigned cvt_pk_bf16(float lo, float hi) { f32x2v v = {lo, hi}; bf16x2v b = __builtin_convertvector(v, bf16x2v); return __builtin_bit_cast(unsigned, b); }
__device__ __forceinline__ float bflo(unsigned w) { return __uint_as_float(w << 16); }
__device__ __forceinline__ float bfhi(unsigned w) { return __uint_as_float(w & 0xffff0000u); }
__device__ __forceinline__ float bf2f(bf16_t b) { return __uint_as_float((unsigned)b << 16); }
__device__ __forceinline__ bf16_t f2bf(float f) { return (bf16_t)(cvt_pk_bf16(f, f) & 0xffffu); }
__device__ __forceinline__ void unpack8(u32x4 w, float* f) { f[0] = bflo(w.x); f[1] = bfhi(w.x); f[2] = bflo(w.y); f[3] = bfhi(w.y); f[4] = bflo(w.z); f[5] = bfhi(w.z); f[6] = bflo(w.w); f[7] = bfhi(w.w); }
__device__ __forceinline__ u32x4 pack8(const float* f) { u32x4 w; w.x = cvt_pk_bf16(f[0], f[1]); w.y = cvt_pk_bf16(f[2], f[3]); w.z = cvt_pk_bf16(f[4], f[5]); w.w = cvt_pk_bf16(f[6], f[7]); return w; }
__device__ __forceinline__ float sigmoidf_(float x) { return __builtin_amdgcn_rcpf(1.f + __builtin_amdgcn_exp2f(-1.4426950408889634f * x)); }
__device__ __forceinline__ float wave_sum(float v) {
#pragma unroll
    for (int o = 1; o < 64; o <<= 1) v += __shfl_xor(v, o);
    return v;
}
__device__ __forceinline__ float sum8(float v) { v += __shfl_xor(v, 1); v += __shfl_xor(v, 2); v += __shfl_xor(v, 4); return v; }
template <int CTRL> __device__ __forceinline__ float dppf(float x) { return __builtin_bit_cast(float, __builtin_amdgcn_update_dpp(0, __builtin_bit_cast(int, x), CTRL, 0xf, 0xf, false)); }
__device__ __forceinline__ float red16(float x) { x += dppf<0xB1>(x); x += dppf<0x4E>(x); x += dppf<0x141>(x); x += dppf<0x140>(x); return x; }
__device__ __forceinline__ float gamma_l2(int h) { return __log2f(1.f - __builtin_amdgcn_exp2f(-5.f - (float)h)); }
#define LDSW() asm volatile("s_waitcnt lgkmcnt(0)" ::: "memory")

constexpr int BM = 256, BKT = 64, HALF = 128, HTB = HALF * BKT * 2;
__device__ __forceinline__ int lds_byte(int r, int c) { const int st = (r >> 4) * 2 + (c >> 5), rr = r & 15, cc = c & 31, ob = rr * 64 + cc * 2; return st * 1024 + (ob ^ (((ob >> 9) & 1) << 5)); }
__device__ __forceinline__ void stage_rc(int b, int& R, int& C) { const int st = b / 1024, sb = b % 1024, swz = sb ^ (((sb >> 9) & 1) << 5); R = (st >> 1) * 16 + swz / 64; C = (st & 1) * 32 + (swz % 64) / 2; }
__device__ __forceinline__ int perm32(int rho) { const int n = rho >> 4, i = rho & 15; return 8 * (i >> 2) + 4 * n + (i & 3); }

struct Unit { const char* a; const char* b; int pm, pn, aux; };
struct GemmDesc {
    const char* A; const char* B; int lda, ldb, K, nM, nN, sched, epi, perm;
    bf16_t* d0; int ldc0; bf16_t* d1; float* x; bf16_t* z;
    const float* xs0; const float* xs1;
    int skip;
};
__device__ __forceinline__ void tile_map(int L, int nM, int nN, int& pm, int& pn) {
    const int nwg = nM * nN; int wgid = L;
    { const int q = nwg / 8, r = nwg % 8, xcd = wgid % 8, off = wgid / 8; wgid = (xcd < r ? xcd * (q + 1) : r * (q + 1) + (xcd - r) * q) + off; }
    const int nig = 8 * nN, gid = wgid / nig, fm = gid * 8, gsz = (nM - fm) < 8 ? (nM - fm) : 8;
    pm = fm + ((wgid % nig) % gsz); pn = (wgid % nig) / gsz;
}
__device__ __forceinline__ int gl_off(int b) { return b == 0 ? 512 : (b == 1 ? 2048 : 4096); }
__device__ __forceinline__ int br_off(int b) { return b == 0 ? AQ : (b == 1 ? BQ : CR); }
__device__ __forceinline__ bool unit_next(const GemmDesc& g, int i, int G, int c, Unit& u) {
    const int nwg = g.nM * g.nN;
    if (g.sched == 0) {
        if (c < g.skip) return false;
        const long L = (long)i * (G - g.skip) + (c - g.skip); if (L >= nwg) return false;
        tile_map((int)L, g.nM, g.nN, u.pm, u.pn); u.aux = 0;
        u.a = g.A + (size_t)u.pm * 256 * g.lda * 2; u.b = g.B + (size_t)u.pn * 256 * g.ldb * 2; return true;
    } else {
        const long L = (long)(i / 3) * G + c; if (L >= nwg) return false;
        const int b = i % 3; tile_map((int)L, g.nM, g.nN, u.pm, u.pn); u.aux = b;
        u.a = g.A + (size_t)u.pm * 256 * g.lda * 2 + br_off(b) * 2; u.b = g.B + (size_t)b * 1024 * 512 * 2 + (size_t)u.pn * 256 * g.ldb * 2; return true;
    }
}
__device__ __forceinline__ void gemm_epilogue(const GemmDesc& g, const f32x4 (&acc)[2][2][4][2], const Unit& u, int wr, int wc, int fr, int fq) {
    const int row0 = u.pm * BM + wr * 64 + fr;
    if (g.epi == 4) {
        const int col0 = u.pn * BM + wc * 32 + 4 * fq;
#pragma unroll
        for (int ai = 0; ai < 2; ++ai)
#pragma unroll
            for (int m = 0; m < 4; ++m) { const int row_ = row0 + ai * HALF + m * 16; const size_t ro = (size_t)row_ * DM + col0;
                const float* sp = g.xs0 ? (row_ < T_P ? g.xs0 + ro : g.xs1 + (ro - (size_t)T_P * DM)) : g.x + ro;
#pragma unroll
                for (int bj = 0; bj < 2; ++bj)
#pragma unroll
                    for (int n = 0; n < 2; ++n) { f32x4* p = (f32x4*)(g.x + ro + bj * HALF + n * 16); const f32x4 v = *(const f32x4*)(sp + bj * HALF + n * 16) + acc[ai][bj][m][n]; *p = v;
                        if (g.d1) { u32x2 w; w.x = cvt_pk_bf16(v[0], v[1]); w.y = cvt_pk_bf16(v[2], v[3]); *(u32x2*)(g.d1 + ro + bj * HALF + n * 16) = w; } } }
        return;
    }
    const int cl = wc * 32 + 8 * fq;
    if (g.epi == 5) {
#pragma unroll
        for (int ai = 0; ai < 2; ++ai)
#pragma unroll
            for (int m = 0; m < 4; ++m) { const size_t ro = (size_t)(row0 + ai * HALF + m * 16) * g.ldc0 + u.pn * 128 + cl; float h[8];
#pragma unroll
                for (int n = 0; n < 2; ++n)
#pragma unroll
                    for (int e = 0; e < 4; ++e) { const float gt = acc[ai][0][m][n][e], up = acc[ai][1][m][n][e]; h[n * 4 + e] = gt * sigmoidf_(gt) * up; }
                *(u32x4*)(g.d0 + ro) = pack8(h); }
        return;
    }
    bf16_t* base = g.d0; int ldc = g.ldc0, colt = u.pn * BM; bool sg = false;
    if (g.epi == 1) { if (u.pn >= 4) { base = g.z; ldc = ZW; colt = BG + (u.pn - 4) * BM; } }
    else if (g.epi == 2) { colt = gl_off(u.pn >> 2) + (u.pn & 3) * BM; sg = true; }
    const bool gated = (g.epi == 3); const int gcol = gated ? gl_off(u.aux) : 0;
#pragma unroll
    for (int ai = 0; ai < 2; ++ai)
#pragma unroll
        for (int m = 0; m < 4; ++m) { const int row = row0 + ai * HALF + m * 16;
#pragma unroll
            for (int bj = 0; bj < 2; ++bj) { float v[8];
#pragma unroll
                for (int n = 0; n < 2; ++n)
#pragma unroll
                    for (int e = 0; e < 4; ++e) v[n * 4 + e] = acc[ai][bj][m][n][e];
                bf16_t* dp = base + (size_t)row * ldc + colt + bj * HALF + cl;
                if (sg) {
#pragma unroll
                    for (int e = 0; e < 8; ++e) v[e] = sigmoidf_(v[e]);
                }
                if (gated) { float gt[8]; unpack8(*(const u32x4*)(g.z + (size_t)row * ZW + gcol + u.pn * BM + bj * HALF + cl), gt);
#pragma unroll
                    for (int e = 0; e < 8; ++e) v[e] *= gt[e];
                    if (u.aux > 0) { float pv[8]; unpack8(*(const u32x4*)dp, pv);
#pragma unroll
                        for (int e = 0; e < 8; ++e) v[e] += pv[e]; } }
                *(u32x4*)dp = pack8(v); } }
}

__device__ __forceinline__ void gemm_phase(LAS unsigned char* lds, const GemmDesc& g) {
    const int tid = tid_opaque(), wid = __builtin_amdgcn_readfirstlane(tid >> 6), lane = tid & 63, wr = wid >> 2, wc = wid & 3, fr = lane & 15, fq = lane >> 4;
    const int G = gridDim.x, cb = bid_opaque();
    const int K = g.K, nt = K / BKT;
    unsigned voffA[2], voffB[2];
#pragma unroll
    for (int i = 0; i < 2; ++i) { int R, C; stage_rc(tid * 16 + i * 8192, R, C); const int Rb = g.perm ? ((R & ~31) + perm32(R & 31)) : R;
        voffA[i] = (unsigned)(R * g.lda + C) * 2u; voffB[i] = (unsigned)(Rb * g.ldb + C) * 2u; }
    const size_t kstep = (size_t)(BKT * 2);
    const size_t hstepA = (size_t)HALF * g.lda * 2, hstepB = (size_t)HALF * g.ldb * 2;
    const unsigned ldsw = (unsigned)wid * 1024u;
    const int aoff = lds_byte(wr * 64 + fr, fq * 8), boff = lds_byte(wc * 32 + fr, fq * 8);
#define PG8_SA(b, h) (((b) * 2 + (h)) * HTB)
#define PG8_SB(b, h) ((4 + (b) * 2 + (h)) * HTB)
#define PG8_STAGE(bufoff, gbase, voff) do { _Pragma("unroll") for (int _i = 0; _i < 2; ++_i) \
        __builtin_amdgcn_global_load_lds((const unsigned*)((const char*)(gbase) + (voff)[_i]), (LAS unsigned*)(lds + (bufoff) + ldsw + _i * 8192), 16, 0, 0); } while (0)
#define PG8_LDA(dst, b, h) do { _Pragma("unroll") for (int m = 0; m < 4; ++m) _Pragma("unroll") for (int k = 0; k < 2; ++k) dst[m][k] = *(const LAS bf16x8*)(lds + PG8_SA(b, h) + aoff + m * 2048 + k * 1024); } while (0)
#define PG8_LDB(dst, b, h) do { _Pragma("unroll") for (int n = 0; n < 2; ++n) _Pragma("unroll") for (int k = 0; k < 2; ++k) dst[n][k] = *(const LAS bf16x8*)(lds + PG8_SB(b, h) + boff + n * 2048 + k * 1024); } while (0)
#define PG8_MMA(ai, bj, At, Bt) do { __builtin_amdgcn_s_setprio(1); _Pragma("unroll") for (int m = 0; m < 4; ++m) _Pragma("unroll") for (int n = 0; n < 2; ++n) _Pragma("unroll") for (int k = 0; k < 2; ++k) \
        acc[ai][bj][m][n] = __builtin_amdgcn_mfma_f32_16x16x32_bf16(Bt[n][k], At[m][k], acc[ai][bj][m][n], 0, 0, 0); __builtin_amdgcn_s_setprio(0); } while (0)
#define PG8_WAIT_V(n) asm volatile("s_waitcnt vmcnt(" #n ")" ::: "memory")
#define PG8_WAIT_L(n) asm volatile("s_waitcnt lgkmcnt(" #n ")" ::: "memory")
#define PG8_BAR __builtin_amdgcn_s_barrier()
#define PG8_SCHED __builtin_amdgcn_sched_barrier(0)
    Unit cur, nxt; int ui = 0;
    if (!unit_next(g, 0, G, cb, cur)) return;
    f32x4 acc[2][2][4][2];
#pragma unroll
    for (int a = 0; a < 2; ++a)
#pragma unroll
        for (int b = 0; b < 2; ++b)
#pragma unroll
            for (int m = 0; m < 4; ++m)
#pragma unroll
                for (int n = 0; n < 2; ++n) acc[a][b][m][n] = (f32x4){0.f, 0.f, 0.f, 0.f};
    bf16x8 At[4][2], B0[2][2], B1[2][2];
    const char* cA = cur.a; const char* cB = cur.b;
    PG8_STAGE(PG8_SB(0, 0), cB, voffB); PG8_STAGE(PG8_SB(0, 1), cB + hstepB, voffB); PG8_STAGE(PG8_SA(0, 0), cA, voffA); PG8_STAGE(PG8_SA(0, 1), cA + hstepA, voffA);
    if (wr == 1) PG8_BAR;
    PG8_WAIT_V(2); PG8_BAR;
    PG8_STAGE(PG8_SB(1, 0), cB + kstep, voffB); PG8_STAGE(PG8_SA(1, 0), cA + kstep, voffA); PG8_STAGE(PG8_SB(1, 1), cB + hstepB + kstep, voffB);
    PG8_WAIT_V(6); PG8_BAR;
    for (;;) {
        const bool has_next = unit_next(g, ui + 1, G, cb, nxt);
        const char* nA = has_next ? nxt.a : cA; const char* nB = has_next ? nxt.b : cB;
        for (int t = 0; t < nt; t += 2) {
            const bool last = (t == nt - 2);
            const char* a1 = cA + (size_t)(t + 1) * kstep;
            const char* a2 = last ? nA : cA + (size_t)(t + 2) * kstep; const char* b2 = last ? nB : cB + (size_t)(t + 2) * kstep;
            const char* a3 = a2 + kstep; const char* b3 = b2 + kstep;
            PG8_LDB(B0, 0, 0); PG8_LDB(B1, 0, 1); PG8_SCHED; PG8_LDA(At, 0, 0); PG8_STAGE(PG8_SA(1, 1), a1 + hstepA, voffA);
            PG8_WAIT_V(8); PG8_WAIT_L(0); PG8_BAR; PG8_MMA(0, 0, At, B0); PG8_MMA(0, 1, At, B1); PG8_BAR; PG8_SCHED;
            PG8_LDA(At, 0, 1); PG8_STAGE(PG8_SB(0, 0), b2, voffB); PG8_STAGE(PG8_SB(0, 1), b2 + hstepB, voffB); PG8_STAGE(PG8_SA(0, 0), a2, voffA);
            PG8_WAIT_V(8); PG8_WAIT_L(0); PG8_BAR; PG8_MMA(1, 0, At, B0); PG8_MMA(1, 1, At, B1); PG8_BAR; PG8_SCHED;
            PG8_LDB(B0, 1, 0); PG8_LDB(B1, 1, 1); PG8_SCHED; PG8_LDA(At, 1, 0); PG8_STAGE(PG8_SA(0, 1), a2 + hstepA, voffA);
            PG8_WAIT_V(8); PG8_WAIT_L(0); PG8_BAR; PG8_MMA(0, 0, At, B0); PG8_MMA(0, 1, At, B1); PG8_BAR; PG8_SCHED;
            PG8_LDA(At, 1, 1); PG8_STAGE(PG8_SB(1, 0), b3, voffB); PG8_STAGE(PG8_SB(1, 1), b3 + hstepB, voffB); PG8_STAGE(PG8_SA(1, 0), a3, voffA);
            PG8_WAIT_V(8); PG8_WAIT_L(0); PG8_BAR; PG8_MMA(1, 0, At, B0); PG8_MMA(1, 1, At, B1); PG8_BAR; PG8_SCHED;
        }
        if (wr == 0) PG8_BAR;
        gemm_epilogue(g, acc, cur, wr, wc, fr, fq);
        if (!has_next) break;
#pragma unroll
        for (int a = 0; a < 2; ++a)
#pragma unroll
            for (int b = 0; b < 2; ++b)
#pragma unroll
                for (int m = 0; m < 4; ++m)
#pragma unroll
                    for (int n = 0; n < 2; ++n) acc[a][b][m][n] = (f32x4){0.f, 0.f, 0.f, 0.f};
        cur = nxt; cA = nA; cB = nB; ++ui;
        if (wr == 1) PG8_BAR;
    }
    PG8_WAIT_V(0);
    PG8_BAR;
}

struct MatDesc { const float* W; int ldw, col0, K, N; bf16_t* T; int ldt, koff, rowmode, rowoff; };
__device__ __forceinline__ MatDesc get_mat(const Params& P, int l, int m) {
    bf16_t* wb = (bf16_t*)(P.ws + WS_W); MatDesc d; d.col0 = 0; d.koff = 0; d.rowmode = 0; d.rowoff = 0;
    switch (m) {
    case 0: d.W = PIN(10) + (size_t)l * 1024 * 8448; d.ldw = 8448; d.K = 1024; d.N = 5376; d.T = wb + W_Z; d.ldt = 1024; break;
    case 1: d.W = PIN(10) + (size_t)l * 1024 * 8448; d.ldw = 8448; d.col0 = 5376; d.K = 1024; d.N = 3072; d.T = wb + W_GL; d.ldt = 1024; break;
    case 2: d.W = PIN(16) + (size_t)l * 64 * 512; d.ldw = 512; d.K = 64; d.N = 512; d.T = wb + W_BD; d.ldt = 256; break;
    case 3: d.W = PIN(18) + (size_t)l * 64 * 512; d.ldw = 512; d.K = 64; d.N = 512; d.T = wb + W_BD; d.ldt = 256; d.koff = 64; d.rowoff = 512; break;
    case 4: d.W = PIN(19) + (size_t)l * 128 * 512; d.ldw = 512; d.K = 128; d.N = 512; d.T = wb + W_BD; d.ldt = 256; d.koff = 128; d.rowoff = 1024; break;
    case 5: case 6: case 7: d.W = PIN(25) + (size_t)(l * 3 + (m - 5)) * 512 * 1024; d.ldw = 1024; d.K = 512; d.N = 1024; d.T = wb + W_B + (size_t)(m - 5) * 1024 * 512; d.ldt = 512; break;
    case 8: d.W = PIN(26) + (size_t)l * 1024 * 1024; d.ldw = 1024; d.K = 1024; d.N = 1024; d.T = wb + W_O; d.ldt = 1024; break;
    case 9: d.W = PIN(28) + (size_t)l * 1024 * FF; d.ldw = FF; d.K = 1024; d.N = FF; d.T = wb + W_GU; d.ldt = 1024; d.rowmode = 1; break;
    case 10: d.W = PIN(29) + (size_t)l * 1024 * FF; d.ldw = FF; d.K = 1024; d.N = FF; d.T = wb + W_GU; d.ldt = 1024; d.rowmode = 1; d.rowoff = 128; break;
    case 11: d.W = PIN(30) + (size_t)l * FF * 1024; d.ldw = 1024; d.K = FF; d.N = 1024; d.T = wb + W_D; d.ldt = FF; break;
    case 12: d.W = PIN(31) + (size_t)l * 256 * 1024; d.ldw = 1024; d.K = 256; d.N = 1024; d.T = wb + W_P; d.ldt = 256; break;
    default: d.W = PIN(33) + (size_t)l * 1024 * 1024; d.ldw = 1024; d.K = 1024; d.N = 1024; d.T = wb + W_PG; d.ldt = 1024; break;
    }
    return d;
}
__device__ __forceinline__ void convert_weights(const Params& P, int l, LAS unsigned char* lds) {
    const int tid = tid_opaque(), lane = tid & 63, wave = tid >> 6;
    LAS float* scr = (LAS float*)(lds + wave * 8704);
    const int gw = bid_opaque() * 8 + wave, NGW = gridDim.x * 8;
    for (int m = 0; m < 14; ++m) {
        const MatDesc d = get_mat(P, l, m);
        const int nblk = d.N / 32, nit = (d.K / 64) * nblk;
        for (int it = gw; it < nit; it += NGW) {
            const int kb = it / nblk, nb = it % nblk, k0 = 64 * kb, n0 = 32 * nb;
#pragma unroll 8
            for (int i = 0; i < 32; ++i) { const int kk = 2 * i + (lane >> 5); scr[kk * 33 + (lane & 31)] = d.W[(size_t)(k0 + kk) * d.ldw + d.col0 + n0 + (lane & 31)]; }
            LDSW();
            const int c = lane & 7;
#pragma unroll
            for (int j = 0; j < 4; ++j) { const int n = (lane >> 3) + 8 * j; const LAS float* s = scr + (8 * c) * 33 + n;
                u32x4 o; o.x = cvt_pk_bf16(s[0 * 33], s[1 * 33]); o.y = cvt_pk_bf16(s[2 * 33], s[3 * 33]); o.z = cvt_pk_bf16(s[4 * 33], s[5 * 33]); o.w = cvt_pk_bf16(s[6 * 33], s[7 * 33]);
                const int ng = n0 + n; const int drow = d.rowoff + (d.rowmode ? (256 * (ng >> 7) + (ng & 127)) : ng);
                *(u32x4*)(d.T + (size_t)drow * d.ldt + d.koff + k0 + 8 * c) = o; }
            LDSW();
        }
    }
    bf16_t* bd = (bf16_t*)(P.ws + WS_W) + W_BD;
    for (int e = bid_opaque() * 512 + tid; e < 1536 * 32; e += gridDim.x * 512) {
        const int row = e >> 5, k8 = (e & 31) * 8; const int blk = row >> 9;
        const bool diag = (blk == 0) ? (k8 < 64) : (blk == 1 ? (k8 >= 64 && k8 < 128) : (k8 >= 128));
        if (!diag) *(u32x4*)(bd + (size_t)row * 256 + k8) = (u32x4){0u, 0u, 0u, 0u};
    }
}

__device__ __forceinline__ void row_norm_pass(const Params& P, int l, int mode) {
    const int tid_ = tid_opaque(); const int lane = tid_ & 63, wave = tid_ >> 6;
    const int gw = bid_opaque() * 8 + wave, NGW = gridDim.x * 8;
    const float* gain = (mode == 2 ? PIN(27) : PIN(9)) + (size_t)l * DM;
    bf16_t* dst = (bf16_t*)(P.ws + (mode == 2 ? WS_ZB : WS_XNB));
    f32x4 gv[4];
#pragma unroll
    for (int j = 0; j < 4; ++j) gv[j] = *((const f32x4*)gain + lane + 64 * j);
    for (int r = gw; r < T_ALL; r += NGW) {
        const float* src = (mode == 0 || (mode == 1 && l == 0)) ? (r < T_P ? PIN(0) + (size_t)r * DM : PIN(1) + (size_t)(r - T_P) * DM) : P.out + (size_t)r * DM;
        f32x4 v[4]; float s = 0.f;
#pragma unroll
        for (int j = 0; j < 4; ++j) { v[j] = *((const f32x4*)src + lane + 64 * j); s += v[j][0] * v[j][0] + v[j][1] * v[j][1] + v[j][2] * v[j][2] + v[j][3] * v[j][3]; }
        const float rs = rsqrtf(wave_sum(s) * (1.f / DM) + EPS);
#pragma unroll
        for (int j = 0; j < 4; ++j) {
            const f32x4 o = v[j] * rs * gv[j]; u32x2 w; w.x = cvt_pk_bf16(o[0], o[1]); w.y = cvt_pk_bf16(o[2], o[3]);
            *((u32x2*)(dst + (size_t)r * DM) + lane + 64 * j) = w; }
        if (mode == 2) {
            const float* pr = (r < T_P) ? PIN(2) + ((size_t)l * T_P + r) * 256 : PIN(3) + ((size_t)l * 1024 + (r - T_P)) * 256;
            const f32x4 pv = *((const f32x4*)pr + lane); u32x2 w; w.x = cvt_pk_bf16(pv[0], pv[1]); w.y = cvt_pk_bf16(pv[2], pv[3]);
            *((u32x2*)((bf16_t*)(P.ws + WS_LOB) + (size_t)r * 256) + lane) = w;
        }
    }
}
__device__ __forceinline__ void finish_pass(const Params& P, int l) {
    const int tid_ = tid_opaque(); const int lane = tid_ & 63, wave = tid_ >> 6;
    const int gw = bid_opaque() * 8 + wave, NGW = gridDim.x * 8;
    const float* gp = PIN(32) + (size_t)l * DM; const float* gn = PIN(9) + (size_t)(l < 1 ? l + 1 : l) * DM;
    bf16_t* GR = (bf16_t*)(P.ws + WS_ZB); bf16_t* EB = (bf16_t*)(P.ws + WS_XNB);
    for (int r = gw; r < T_ALL; r += NGW) {
        f32x4 x[4], gr[4], e[4]; float sx = 0.f, se = 0.f;
#pragma unroll
        for (int j = 0; j < 4; ++j) { x[j] = *((const f32x4*)(P.out + (size_t)r * DM) + lane + 64 * j);
            const u32x2 a = *((const u32x2*)(GR + (size_t)r * DM) + lane + 64 * j), b = *((const u32x2*)(EB + (size_t)r * DM) + lane + 64 * j);
            gr[j] = (f32x4){bflo(a.x), bfhi(a.x), bflo(a.y), bfhi(a.y)}; e[j] = (f32x4){bflo(b.x), bfhi(b.x), bflo(b.y), bfhi(b.y)};
#pragma unroll
            for (int k = 0; k < 4; ++k) { sx += x[j][k] * x[j][k]; se += e[j][k] * e[j][k]; } }
        const float rx = rsqrtf(wave_sum(sx) * (1.f / DM) + EPS), re = rsqrtf(wave_sum(se) * (1.f / DM) + EPS);
        float s2 = 0.f;
#pragma unroll
        for (int j = 0; j < 4; ++j) { const f32x4 g4 = *((const f32x4*)gp + lane + 64 * j);
#pragma unroll
            for (int k = 0; k < 4; ++k) { const float xn = x[j][k] + sigmoidf_(gr[j][k] * rx) * (e[j][k] * re * g4[k]); x[j][k] = xn; s2 += xn * xn; }
            *((f32x4*)(P.out + (size_t)r * DM) + lane + 64 * j) = x[j]; }
        if (l < 1) {
            const float r2 = rsqrtf(wave_sum(s2) * (1.f / DM) + EPS);
#pragma unroll
            for (int j = 0; j < 4; ++j) { const f32x4 g4 = *((const f32x4*)gn + lane + 64 * j); const f32x4 o = x[j] * r2 * g4; u32x2 w; w.x = cvt_pk_bf16(o[0], o[1]); w.y = cvt_pk_bf16(o[2], o[3]);
                *((u32x2*)(EB + (size_t)r * DM) + lane + 64 * j) = w; }
        }
    }
}

__device__ __forceinline__ void e1_phase(const Params& P, int l, LAS unsigned char* lds) {
    const int tid = tid_opaque(), tok = tid >> 3, sub = tid & 7, wave = tid >> 6, lane = tid & 63, fr = lane & 15, fq = lane >> 4;
    bf16_t* Z = (bf16_t*)(P.ws + WS_ZB);
    LAS bf16_t* L0 = (LAS bf16_t*)lds;
    LAS bf16_t* L1 = (LAS bf16_t*)(lds + 18432);
    for (int it = bid_opaque(); it < 528 * 7; it += gridDim.x) {
        const int tile = it / 7, job = it % 7, r0 = tile * 64, row = r0 + tok;
        const bool prompt = tile < 512; const int sr = row - T_P;
        bf16_t* zr = Z + (size_t)row * ZW;
        if (job < 2) {
            u32x4 rq[4], rk[4], rv[4];
#pragma unroll
            for (int q = 0; q < 4; ++q) { const int hc = (job * 4 + q) * 64 + sub * 8; rq[q] = *(const u32x4*)(zr + AQ + hc); rk[q] = *(const u32x4*)(zr + AK + hc); rv[q] = *(const u32x4*)(zr + AV + hc); }
            const float* gq = PIN(11) + l * 64 + sub * 8; const float* gk = PIN(12) + l * 64 + sub * 8;
#pragma unroll
            for (int q = 0; q < 4; ++q) { const int h = job * 4 + q; float f[8], o[8];
                unpack8(rq[q], f);
                float ss = 0.f;
#pragma unroll
                for (int e = 0; e < 8; ++e) ss += f[e] * f[e];
                float rs = rsqrtf(sum8(ss) * (1.f / 64.f) + EPS);
#pragma unroll
                for (int e = 0; e < 8; ++e) o[e] = f[e] * rs * gq[e];
                *(u32x4*)(zr + AQ + h * 64 + sub * 8) = pack8(o);
                unpack8(rk[q], f);
                ss = 0.f;
#pragma unroll
                for (int e = 0; e < 8; ++e) ss += f[e] * f[e];
                rs = rsqrtf(sum8(ss) * (1.f / 64.f) + EPS);
#pragma unroll
                for (int e = 0; e < 8; ++e) o[e] = f[e] * rs * gk[e];
                *(u32x4*)(zr + AK + h * 64 + sub * 8) = pack8(o);
                float vv[8]; const u32x4 vraw = rv[q]; unpack8(vraw, vv);
                float* ok = nullptr; float* ov = nullptr;
                if (prompt) { const int b = row >> 14, t = row & (SEQ - 1); if (t >= SEQ - 512) { const size_t o_ = (((size_t)(l * 2 + b) * 512 + (t - (SEQ - 512))) * 512 + h * 64 + sub * 8); ok = P.out + O_AKP + o_; ov = P.out + O_AVP + o_; } }
                else { const size_t o_ = ((size_t)(l * 1024 + sr) * 512 + h * 64 + sub * 8); ok = P.out + O_AKS + o_; ov = P.out + O_AVS + o_; }
                if (ok) { *(f32x4*)ok = (f32x4){o[0], o[1], o[2], o[3]}; *(f32x4*)(ok + 4) = (f32x4){o[4], o[5], o[6], o[7]};
                          *(f32x4*)ov = (f32x4){vv[0], vv[1], vv[2], vv[3]}; *(f32x4*)(ov + 4) = (f32x4){vv[4], vv[5], vv[6], vv[7]}; }
                if (prompt) {
#pragma unroll
                    for (int e = 0; e < 8; ++e) L0[q * 4608 + (sub * 8 + e) * 72 + tok] = ((const unsigned short*)&vraw)[e];
                } }
            if (prompt) {
                __syncthreads();
#pragma unroll
                for (int q = 0; q < 4; ++q) { const u32x4 w = *(const LAS u32x4*)(L0 + q * 4608 + tok * 72 + sub * 8);
                    *(u32x4*)(Z + (size_t)(r0 + tok) * ZW + AV + (job * 4 + q) * 64 + sub * 8) = w; }
                __syncthreads();
            }
        } else if (job < 6) {
            const int h = job - 2; const int pos = prompt ? (row & (SEQ - 1)) : (2048 + (sr & 31));
            float cs[8], sn[8];
#pragma unroll
            for (int e = 0; e < 8; ++e) { const float inv = __builtin_amdgcn_exp2f(-(float)(sub * 8 + e) * (13.287712379549449f / 64.f)); const float ang = (float)pos * inv;
                const float n = rintf(ang * 0.15915494309189535f); float rr = fmaf(-n, 6.2831855f, ang); rr = fmaf(-n, -1.7484555e-7f, rr); cs[e] = __cosf(rr); sn[e] = __sinf(rr); }
            float x1[8], x2[8], o1[8], o2[8];
            unpack8(*(const u32x4*)(zr + BQ + h * 128 + sub * 8), x1); unpack8(*(const u32x4*)(zr + BQ + h * 128 + 64 + sub * 8), x2);
#pragma unroll
            for (int e = 0; e < 8; ++e) { o1[e] = x1[e] * cs[e] - x2[e] * sn[e]; o2[e] = x1[e] * sn[e] + x2[e] * cs[e]; }
            *(u32x4*)(zr + BQ + h * 128 + sub * 8) = pack8(o1); *(u32x4*)(zr + BQ + h * 128 + 64 + sub * 8) = pack8(o2);
            unpack8(*(const u32x4*)(zr + BK + h * 128 + sub * 8), x1); unpack8(*(const u32x4*)(zr + BK + h * 128 + 64 + sub * 8), x2);
#pragma unroll
            for (int e = 0; e < 8; ++e) { o1[e] = (x1[e] * cs[e] - x2[e] * sn[e]) * 0.08838834764831845f; o2[e] = (x1[e] * sn[e] + x2[e] * cs[e]) * 0.08838834764831845f; }
            *(u32x4*)(zr + BK + h * 128 + sub * 8) = pack8(o1); *(u32x4*)(zr + BK + h * 128 + 64 + sub * 8) = pack8(o2);
            if (prompt) {
                const float dk = __builtin_amdgcn_exp2f(gamma_l2(h) * (float)(63 - tok));
                const u32x4 va = *(const u32x4*)(zr + BV + h * 128 + sub * 8), vb = *(const u32x4*)(zr + BV + h * 128 + 64 + sub * 8);
#pragma unroll
                for (int e = 0; e < 8; ++e) { L0[(sub * 8 + e) * 72 + tok] = f2bf(o1[e] * dk); L0[(64 + sub * 8 + e) * 72 + tok] = f2bf(o2[e] * dk);
                    L1[(sub * 8 + e) * 72 + tok] = ((const unsigned short*)&va)[e]; L1[(64 + sub * 8 + e) * 72 + tok] = ((const unsigned short*)&vb)[e]; }
                __syncthreads();
                const int b = row >> 14, c = (r0 & (SEQ - 1)) >> 6;
                bf16_t* St = (bf16_t*)(P.ws + WS_XNB) + ((size_t)((b * 4 + h) * 256 + c)) * 16384;
                const bf16x8 vb0 = *(const LAS bf16x8*)(L1 + (16 * wave + fr) * 72 + 8 * fq), vb1 = *(const LAS bf16x8*)(L1 + (16 * wave + fr) * 72 + 32 + 8 * fq);
#pragma unroll
                for (int dkt = 0; dkt < 8; ++dkt) {
                    const bf16x8 ka0 = *(const LAS bf16x8*)(L0 + (16 * dkt + fr) * 72 + 8 * fq), ka1 = *(const LAS bf16x8*)(L0 + (16 * dkt + fr) * 72 + 32 + 8 * fq);
                    f32x4 a = (f32x4){0.f, 0.f, 0.f, 0.f};
                    a = __builtin_amdgcn_mfma_f32_16x16x32_bf16(ka0, vb0, a, 0, 0, 0); a = __builtin_amdgcn_mfma_f32_16x16x32_bf16(ka1, vb1, a, 0, 0, 0);
                    u32x2 w; w.x = cvt_pk_bf16(a[0], a[1]); w.y = cvt_pk_bf16(a[2], a[3]);
                    *(u32x2*)(St + (size_t)(16 * wave + fr) * 128 + 16 * dkt + 4 * fq) = w;
                }
#pragma unroll
                for (int q = 0; q < 2; ++q) { const int idx = tid + q * 512, i = idx >> 4, hh = (idx >> 3) & 1, pc = idx & 7;
                    const u32x4 w = *(const LAS u32x4*)(L1 + (64 * hh + i) * 72 + pc * 8);
                    *(u32x4*)(Z + (size_t)(r0 + i) * ZW + BV + h * 128 + hh * 64 + pc * 8) = w; }
                __syncthreads();
            }
        } else {
            bool first; const float* sh = nullptr;
            if (prompt) first = (row & (SEQ - 1)) == 0; else { first = (sr & 31) == 0; sh = PIN(8) + ((size_t)l * 32 + (sr >> 5)) * 1792; }
            const float* mu = PIN(14) + (size_t)l * 1792;
            bf16_t* LO = (bf16_t*)(P.ws + WS_LOB) + (size_t)row * 256;
#pragma unroll
            for (int ch = 0; ch < 4; ++ch) { const int lc = sub * 32 + ch * 8, cp = 1536 + lc; float cur[8], prv[8], o[8];
                unpack8(*(const u32x4*)(zr + CLO + lc), cur);
                if (!first) unpack8(*(const u32x4*)(zr - ZW + CLO + lc), prv);
                else {
#pragma unroll
                    for (int e = 0; e < 8; ++e) prv[e] = sh ? sh[cp + e] : 0.f; }
#pragma unroll
                for (int e = 0; e < 8; ++e) { const float c_ = cur[e] + (prv[e] - cur[e]) * mu[cp + e];
                    o[e] = (lc < 64) ? (1.f - 2.f * __builtin_amdgcn_rcpf(__expf(2.f * c_) + 1.f)) : (lc < 128 ? c_ : sigmoidf_(c_)); }
                *(u32x4*)(LO + lc) = pack8(o); }
            bool lastt; float* so;
            if (prompt) { lastt = (row & (SEQ - 1)) == SEQ - 1; so = P.out + O_SHP + (size_t)(l * 2 + (row >> 14)) * 1792; }
            else { lastt = (sr & 31) == 31; so = P.out + O_SHS + (size_t)(l * 32 + (sr >> 5)) * 1792; }
            if (lastt) { for (int q = 0; q < 28; ++q) { const int c0 = (sub * 28 + q) * 8; float f[8]; unpack8(*(const u32x4*)(zr + CR + c0), f);
                    *(f32x4*)(so + c0) = (f32x4){f[0], f[1], f[2], f[3]}; *(f32x4*)(so + c0 + 4) = (f32x4){f[4], f[5], f[6], f[7]}; } }
            if (tid < 192) *(u32x4*)((bf16_t*)(P.ws + WS_CZB) + (size_t)tile * 1536 + tid * 8) = *(const u32x4*)(Z + (size_t)(r0 + 63) * ZW + CR + tid * 8);
        }
    }
}

__device__ __forceinline__ void p2_phase(const Params& P, int l, LAS unsigned char* lds) {
    bf16_t* Z = (bf16_t*)(P.ws + WS_ZB);
    for (int it = bid_opaque(); it < 64 + 128; it += gridDim.x) {
        const int tid = tid_opaque(), lane = tid & 63, wave = tid >> 6;
#ifdef DBG_P2_SKIP_SAMPLE
        if (it >= 64) continue;
#endif
        if (it < 64) {
            const int e4 = it * 512 + tid, chain = e4 >> 12, idx = (e4 & 4095) * 4, h = chain & 3, b = chain >> 2;
            const float g64 = __builtin_amdgcn_exp2f(gamma_l2(h) * 64.f);
            bf16_t* St = (bf16_t*)(P.ws + WS_XNB) + (size_t)chain * 256 * 16384 + idx;
            float s0 = 0.f, s1 = 0.f, s2 = 0.f, s3 = 0.f;
#pragma unroll 16
            for (int c = 0; c < 256; ++c) { const u32x2 d = *(const u32x2*)(St + (size_t)c * 16384);
                s0 = s0 * g64 + bflo(d.x); s1 = s1 * g64 + bfhi(d.x); s2 = s2 * g64 + bflo(d.y); s3 = s3 * g64 + bfhi(d.y);
                u32x2 w; w.x = cvt_pk_bf16(s0, s1); w.y = cvt_pk_bf16(s2, s3); *(u32x2*)(St + (size_t)c * 16384) = w; }
            const int dv = idx >> 7, dk = idx & 127; float* o = P.out + O_RETP + ((size_t)((l * 2 + b) * 4 + h)) * 16384 + dv;
            o[(size_t)dk * 128] = s0; o[(size_t)(dk + 1) * 128] = s1; o[(size_t)(dk + 2) * 128] = s2; o[(size_t)(dk + 3) * 128] = s3;
        } else if (it < 192) {
            const int si = it - 64, s = si >> 2, h = si & 3, rb = T_P + s * 32;
            LAS float* q = (LAS float*)lds; LAS float* k = q + 4096; LAS float* v = k + 4096; LAS float* A = v + 4096; LAS float* ob = A + 1024;
            const float lg = gamma_l2(h);
            { const int n = tid >> 4, sg = tid & 15; const bf16_t* zr = Z + (size_t)(rb + n) * ZW + h * 128 + sg * 8; float f[8];
              const u32x4 wq = *(const u32x4*)(zr + BQ), wk = *(const u32x4*)(zr + BK), wv = *(const u32x4*)(zr + BV);
              unpack8(wq, f); *(LAS f32x4*)(q + n * 128 + sg * 8) = (f32x4){f[0], f[1], f[2], f[3]}; *(LAS f32x4*)(q + n * 128 + sg * 8 + 4) = (f32x4){f[4], f[5], f[6], f[7]};
              unpack8(wk, f); *(LAS f32x4*)(k + n * 128 + sg * 8) = (f32x4){f[0], f[1], f[2], f[3]}; *(LAS f32x4*)(k + n * 128 + sg * 8 + 4) = (f32x4){f[4], f[5], f[6], f[7]};
              unpack8(wv, f); *(LAS f32x4*)(v + n * 128 + sg * 8) = (f32x4){f[0], f[1], f[2], f[3]}; *(LAS f32x4*)(v + n * 128 + sg * 8 + 4) = (f32x4){f[4], f[5], f[6], f[7]}; }
            __syncthreads();
            for (int e = tid; e < 1024; e += 512) { const int n = e >> 5, m = e & 31; float a = 0.f;
                if (m <= n) {
#pragma unroll 8
                    for (int d = 0; d < 128; d += 4) { const f32x4 q4 = *(const LAS f32x4*)(q + n * 128 + d), k4 = *(const LAS f32x4*)(k + m * 128 + d); a += q4[0] * k4[0] + q4[1] * k4[1] + q4[2] * k4[2] + q4[3] * k4[3]; }
                    a *= __builtin_amdgcn_exp2f(lg * (float)(n - m)); }
                A[e] = a; }
            __syncthreads();
            const float* S0 = PIN(6) + ((size_t)((l * 32 + s) * 4 + h)) * 16384;
            { const int e = tid & 127, ng = tid >> 7; float acc[8];
#pragma unroll
              for (int i = 0; i < 8; ++i) acc[i] = 0.f;
#pragma unroll 4
              for (int d = 0; d < 128; d += 4) { const float s0 = S0[(size_t)d * 128 + e], s1 = S0[(size_t)(d + 1) * 128 + e], s2 = S0[(size_t)(d + 2) * 128 + e], s3 = S0[(size_t)(d + 3) * 128 + e];
#pragma unroll
                  for (int i = 0; i < 8; ++i) { const f32x4 q4 = *(const LAS f32x4*)(q + (ng * 8 + i) * 128 + d); acc[i] += q4[0] * s0 + q4[1] * s1 + q4[2] * s2 + q4[3] * s3; } }
#pragma unroll
              for (int i = 0; i < 8; ++i) { const int n = ng * 8 + i; float a = acc[i] * __builtin_amdgcn_exp2f(lg * (float)(n + 1));
                  for (int m = 0; m <= n; ++m) a += A[n * 32 + m] * v[m * 128 + e];
                  ob[n * 128 + e] = a; }
              const int dg = tid >> 7; float* so = P.out + O_RETS + ((size_t)((l * 32 + s) * 4 + h)) * 16384; const float g32 = __builtin_amdgcn_exp2f(lg * 32.f);
              float vd[32];
#pragma unroll
              for (int m = 0; m < 32; ++m) vd[m] = v[m * 128 + e] * __builtin_amdgcn_exp2f(lg * (float)(31 - m));
#pragma unroll 2
              for (int d = dg * 32; d < dg * 32 + 32; d += 4) { float a0 = g32 * S0[(size_t)d * 128 + e], a1 = g32 * S0[(size_t)(d + 1) * 128 + e], a2 = g32 * S0[(size_t)(d + 2) * 128 + e], a3 = g32 * S0[(size_t)(d + 3) * 128 + e];
#pragma unroll
                  for (int m = 0; m < 32; ++m) { const f32x4 k4 = *(const LAS f32x4*)(k + m * 128 + d); a0 += k4[0] * vd[m]; a1 += k4[1] * vd[m]; a2 += k4[2] * vd[m]; a3 += k4[3] * vd[m]; }
                  so[(size_t)d * 128 + e] = a0; so[(size_t)(d + 1) * 128 + e] = a1; so[(size_t)(d + 2) * 128 + e] = a2; so[(size_t)(d + 3) * 128 + e] = a3; }
            }
            __syncthreads();
            { const int e = tid & 127, ng = tid >> 7;
              for (int i = 0; i < 8; ++i) { const int n = ng * 8 + i; float ss = 0.f;
#pragma unroll 8
                  for (int d = 0; d < 128; d += 4) { const f32x4 o4 = *(const LAS f32x4*)(ob + n * 128 + d); ss += o4[0] * o4[0] + o4[1] * o4[1] + o4[2] * o4[2] + o4[3] * o4[3]; }
                  const float rs = rsqrtf(ss * (1.f / 128.f) + EPS); bf16_t* zr = Z + (size_t)(rb + n) * ZW + h * 128 + e; const float gt = bf2f(zr[BG]);
                  zr[BQ] = f2bf(ob[n * 128 + e] * rs * gt * sigmoidf_(gt)); } }
            __syncthreads();
        }
    }
}

__device__ __forceinline__ void sattn_item(const Params& P, int l, LAS unsigned char* lds, int si, int tid_in) {
    int tid = tid_in; asm volatile("" : "+v"(tid));
    const int lane = tid & 63, wave = tid >> 6;
    bf16_t* Z = (bf16_t*)(P.ws + WS_ZB);
    {
            const int s = si >> 4, h = (si >> 1) & 7, qh = si & 1, rb = T_P + s * 32, rq = rb + qh * 16;
            LAS float* q = (LAS float*)lds; LAS float* sc = q + 1024; LAS float* red = sc + 16 * 544;
            const float* ck = PIN(4) + ((size_t)(l * 32 + s) * 512) * 512 + h * 64; const float* cv = PIN(5) + ((size_t)(l * 32 + s) * 512) * 512 + h * 64;
            const float* bias = PIN(13) + (size_t)(l * 8 + h) * 320;
            for (int e = tid; e < 1024; e += 512) q[e] = bf2f(Z[(size_t)(rq + (e >> 6)) * ZW + AQ + h * 64 + (e & 63)]);
            __syncthreads();
            { const int key = tid; float kr[64];
#pragma unroll
                for (int d4 = 0; d4 < 16; ++d4) { const f32x4 t = *(const f32x4*)(ck + (size_t)key * 512 + d4 * 4); kr[d4 * 4] = t[0]; kr[d4 * 4 + 1] = t[1]; kr[d4 * 4 + 2] = t[2]; kr[d4 * 4 + 3] = t[3]; }
                for (int n = 0; n < 16; ++n) { float a = 0.f;
#pragma unroll
                    for (int d = 0; d < 64; ++d) a += q[n * 64 + d] * kr[d];
                    int rel = (512 + qh * 16 + n) - key; rel = rel > 256 ? 256 : rel;
                    sc[n * 544 + key] = a * 0.125f + bias[rel + 63]; } }
            { const int key = 512 + (tid & 31), n = tid >> 5; float kr[64];
#pragma unroll
                for (int d8 = 0; d8 < 8; ++d8) unpack8(*(const u32x4*)(Z + (size_t)(rb + key - 512) * ZW + AK + h * 64 + d8 * 8), kr + d8 * 8);
                float a = 0.f;
#pragma unroll
                for (int d = 0; d < 64; ++d) a += q[n * 64 + d] * kr[d];
                const int rel = (512 + qh * 16 + n) - key;
                sc[n * 544 + key] = a * 0.125f + bias[rel + 63]; }
            __syncthreads();
            for (int n = wave * 2; n < wave * 2 + 2; ++n) { float mx = -1e30f;
                for (int kx = lane; kx < 544; kx += 64) mx = fmaxf(mx, sc[n * 544 + kx]);
#pragma unroll
                for (int o = 1; o < 64; o <<= 1) mx = fmaxf(mx, __shfl_xor(mx, o));
                float sm = 0.f;
                for (int kx = lane; kx < 544; kx += 64) { const float p = __expf(sc[n * 544 + kx] - mx); sc[n * 544 + kx] = p; sm += p; }
                sm = wave_sum(sm); const float inv = 1.f / sm;
                for (int kx = lane; kx < 544; kx += 64) sc[n * 544 + kx] *= inv; }
            __syncthreads();
            { const int d = tid & 63, kg = tid >> 6; float a[16];
#pragma unroll
              for (int n = 0; n < 16; ++n) a[n] = 0.f;
              float vv[68];
#pragma unroll
              for (int i = 0; i < 68; ++i) { const int key = kg * 68 + i; vv[i] = key < 512 ? cv[(size_t)key * 512 + d] : bf2f(Z[(size_t)(rb + key - 512) * ZW + AV + h * 64 + d]); }
#pragma unroll
              for (int i = 0; i < 68; i += 4)
#pragma unroll
                  for (int n = 0; n < 16; ++n) { const f32x4 p4 = *(const LAS f32x4*)(sc + n * 544 + kg * 68 + i); a[n] += p4[0] * vv[i] + p4[1] * vv[i + 1] + p4[2] * vv[i + 2] + p4[3] * vv[i + 3]; }
#pragma unroll
              for (int n = 0; n < 16; ++n) red[(kg * 16 + n) * 64 + d] = a[n]; }
            __syncthreads();
            for (int e = tid; e < 1024; e += 512) { const int n = e >> 6, d = e & 63; float a = 0.f;
#pragma unroll
                for (int kg = 0; kg < 8; ++kg) a += red[(kg * 16 + n) * 64 + d];
                Z[(size_t)(rq + n) * ZW + AQ + h * 64 + d] = f2bf(a); }
            __syncthreads();
    }
}

__device__ __forceinline__ void p3_phase(const Params& P, int l, LAS unsigned char* lds) {
    const int tid = tid_opaque(), lane = tid & 63, wave = tid >> 6, fr = lane & 15, fq = lane >> 4;
    bf16_t* Z = (bf16_t*)(P.ws + WS_ZB);
    {
        const int qs = wave & 3, dh = wave >> 2;
        LAS bf16_t* SL = (LAS bf16_t*)lds;
        LAS bf16_t* KL = (LAS bf16_t*)(lds + 34816);
        LAS bf16_t* VL = (LAS bf16_t*)(lds + 52224);
        LAS float* XL = (LAS float*)(lds + 70656);
        u32x4 gs[4], gk[2], gv[2];
#define RT_LOAD(it_) do { const int h_ = (it_) & 3, c_ = ((it_) >> 2) & 255, b_ = (it_) >> 10; const size_t cb_ = (size_t)(b_ * SEQ + c_ * 64); \
        const bf16_t* St_ = (const bf16_t*)(P.ws + WS_XNB) + ((size_t)((b_ * 4 + h_) * 256 + (c_ > 0 ? c_ - 1 : 0))) * 16384; \
        _Pragma("unroll") for (int i_ = 0; i_ < 4; ++i_) { const int p_ = tid + 512 * i_; gs[i_] = *(const u32x4*)(St_ + (p_ >> 4) * 128 + (p_ & 15) * 8); } \
        _Pragma("unroll") for (int i_ = 0; i_ < 2; ++i_) { const int p_ = tid + 512 * i_, r_ = p_ >> 4, sg_ = p_ & 15; gk[i_] = *(const u32x4*)(Z + (cb_ + r_) * ZW + BK + h_ * 128 + sg_ * 8); gv[i_] = *(const u32x4*)(Z + (cb_ + r_) * ZW + BV + h_ * 128 + sg_ * 8); } } while (0)
#define RT_WRITE() do { _Pragma("unroll") for (int i_ = 0; i_ < 4; ++i_) { const int p_ = tid + 512 * i_; *(LAS u32x4*)(SL + (p_ >> 4) * 136 + (p_ & 15) * 8) = gs[i_]; } \
        _Pragma("unroll") for (int i_ = 0; i_ < 2; ++i_) { const int p_ = tid + 512 * i_, r_ = p_ >> 4, sg_ = p_ & 15; *(LAS u32x4*)(KL + r_ * 136 + sg_ * 8) = gk[i_]; *(LAS u32x4*)(VL + ((sg_ >> 3) * 64 + r_) * 72 + (sg_ & 7) * 8) = gv[i_]; } } while (0)
        int it = bid_opaque();
        if (it < 2048) RT_LOAD(it);
        for (; it < 2048; it += gridDim.x) {
            const int h = it & 3, c = (it >> 2) & 255, b = it >> 10;
            const int cb = b * SEQ + c * 64, qrow = cb + qs * 16 + fr; const float lg = gamma_l2(h);
            bf16x8 qf[4];
#pragma unroll
            for (int kk = 0; kk < 4; ++kk) qf[kk] = *(const bf16x8*)(Z + (size_t)qrow * ZW + BQ + h * 128 + 32 * kk + 8 * fq);
            RT_WRITE();
            __syncthreads();
            if (it + (int)gridDim.x < 2048) RT_LOAD(it + (int)gridDim.x);
            f32x4 acc[4];
#pragma unroll
            for (int dt = 0; dt < 4; ++dt) acc[dt] = (f32x4){0.f, 0.f, 0.f, 0.f};
            if (c > 0) {
#pragma unroll
                for (int dt = 0; dt < 4; ++dt)
#pragma unroll
                    for (int kk = 0; kk < 4; ++kk) acc[dt] = __builtin_amdgcn_mfma_f32_16x16x32_bf16(*(const LAS bf16x8*)(SL + (16 * (4 * dh + dt) + fr) * 136 + 32 * kk + 8 * fq), qf[kk], acc[dt], 0, 0, 0);
                const float dq = __builtin_amdgcn_exp2f(lg * (float)(qs * 16 + fr + 1));
#pragma unroll
                for (int dt = 0; dt < 4; ++dt) acc[dt] = acc[dt] * dq;
            }
            const int nu = (qs >> 1) + 1;
            for (int u = 0; u < nu; ++u) {
                unsigned pw[4];
#pragma unroll
                for (int t = 0; t < 2; ++t) { f32x4 sc_ = (f32x4){0.f, 0.f, 0.f, 0.f};
#pragma unroll
                    for (int kk = 0; kk < 4; ++kk) sc_ = __builtin_amdgcn_mfma_f32_16x16x32_bf16(*(const LAS bf16x8*)(KL + (32 * u + 16 * t + fr) * 136 + 32 * kk + 8 * fq), qf[kk], sc_, 0, 0, 0);
                    float pv[4];
#pragma unroll
                    for (int j = 0; j < 4; ++j) { const int n = qs * 16 + fr, m = 32 * u + 16 * t + 4 * fq + j; pv[j] = (m <= n) ? sc_[j] * __builtin_amdgcn_exp2f(lg * (float)(n - m)) : 0.f; }
                    pw[t * 2] = cvt_pk_bf16(pv[0], pv[1]); pw[t * 2 + 1] = cvt_pk_bf16(pv[2], pv[3]); }
                u32x4 w4; w4.x = pw[0]; w4.y = pw[1]; w4.z = pw[2]; w4.w = pw[3]; const bf16x8 pf = __builtin_bit_cast(bf16x8, w4);
#pragma unroll
                for (int dt = 0; dt < 4; ++dt) { const LAS bf16_t* vp = VL + (16 * (4 * dh + dt) + fr) * 72 + 32 * u + 4 * fq;
                    const u32x2 v0 = *(const LAS u32x2*)vp, v1 = *(const LAS u32x2*)(vp + 16); u32x4 w; w.x = v0.x; w.y = v0.y; w.z = v1.x; w.w = v1.y;
                    acc[dt] = __builtin_amdgcn_mfma_f32_16x16x32_bf16(__builtin_bit_cast(bf16x8, w), pf, acc[dt], 0, 0, 0); }
            }
            float ss = 0.f;
#pragma unroll
            for (int dt = 0; dt < 4; ++dt) ss += acc[dt][0] * acc[dt][0] + acc[dt][1] * acc[dt][1] + acc[dt][2] * acc[dt][2] + acc[dt][3] * acc[dt][3];
            ss += __shfl_xor(ss, 16); ss += __shfl_xor(ss, 32);
            if (fq == 0) XL[(qs * 2 + dh) * 16 + fr] = ss;
            __syncthreads();
            const float rs = rsqrtf((XL[(qs * 2) * 16 + fr] + XL[(qs * 2 + 1) * 16 + fr]) * (1.f / 128.f) + EPS);
#pragma unroll
            for (int dt = 0; dt < 4; ++dt) { const int dvc = 16 * (4 * dh + dt) + 4 * fq; const u32x2 gw = *(const u32x2*)(Z + (size_t)qrow * ZW + BG + h * 128 + dvc);
                const float g0 = bflo(gw.x), g1 = bfhi(gw.x), g2 = bflo(gw.y), g3 = bfhi(gw.y); u32x2 w;
                w.x = cvt_pk_bf16(acc[dt][0] * rs * g0 * sigmoidf_(g0), acc[dt][1] * rs * g1 * sigmoidf_(g1)); w.y = cvt_pk_bf16(acc[dt][2] * rs * g2 * sigmoidf_(g2), acc[dt][3] * rs * g3 * sigmoidf_(g3));
                *(u32x2*)(Z + (size_t)qrow * ZW + BQ + h * 128 + dvc) = w; }
        }
        __syncthreads();
    }
}

__device__ __forceinline__ void attn_item(const Params& P, int l, LAS unsigned char* lds, int it, int tid) {
    const int lane = tid & 63, wave = tid >> 6, fr = lane & 15, fq = lane >> 4;
    bf16_t* Z = (bf16_t*)(P.ws + WS_ZB);
    {

            const int ia = it - 1024, hp = ia & 3, c = (ia >> 2) & 255, b = ia >> 10, hsel = wave >> 2, h = hp * 2 + hsel, qs = wave & 3;
            const int sb = b * SEQ, qpos = c * 64 + qs * 16 + fr; const size_t qrow = (size_t)(sb + qpos);
            LAS bf16_t* KS = (LAS bf16_t*)lds;
            LAS bf16_t* VS = (LAS bf16_t*)(lds + 36864);
            LAS float* BL = (LAS float*)(lds + 73728);
            const bf16x8 q0 = *(const bf16x8*)(Z + qrow * ZW + AQ + h * 64 + 8 * fq), q1 = *(const bf16x8*)(Z + qrow * ZW + AQ + h * 64 + 32 + 8 * fq);
            f32x4 acc[4];
#pragma unroll
            for (int dt = 0; dt < 4; ++dt) acc[dt] = (f32x4){0.f, 0.f, 0.f, 0.f};
            float mrun = -1e30f, lrun = 0.f;
            const int jlo = c >= 8 ? 0 : 8 - c;
            u32x4 gk[2], gv[2];
#define AT_LOAD(j_) do { const size_t rb_ = (size_t)(sb + (c - 8 + (j_)) * 64); _Pragma("unroll") for (int i_ = 0; i_ < 2; ++i_) { const int p_ = tid + 512 * i_, hd_ = p_ >> 9, r_ = (p_ >> 3) & 63, sg_ = p_ & 7; \
        gk[i_] = *(const u32x4*)(Z + (rb_ + r_) * ZW + AK + (hp * 2 + hd_) * 64 + sg_ * 8); gv[i_] = *(const u32x4*)(Z + (rb_ + r_) * ZW + AV + (hp * 2 + hd_) * 64 + sg_ * 8); } } while (0)
#define AT_WRITE(st_) do { _Pragma("unroll") for (int i_ = 0; i_ < 2; ++i_) { const int p_ = tid + 512 * i_, hd_ = p_ >> 9, r_ = (p_ >> 3) & 63, sg_ = p_ & 7; \
        *(LAS u32x4*)(KS + ((st_) * 2 + hd_) * 4608 + r_ * 72 + sg_ * 8) = gk[i_]; *(LAS u32x4*)(VS + ((st_) * 2 + hd_) * 4608 + r_ * 72 + sg_ * 8) = gv[i_]; } } while (0)
            AT_LOAD(jlo);
            for (int e = tid; e < 640; e += 512) BL[e] = PIN(13)[(size_t)(l * 8 + hp * 2) * 320 + e] * 1.4426950408889634f;
            AT_WRITE(0);
            __syncthreads();
            for (int j = jlo; j < 9; ++j) {
                const int st = (j - jlo) & 1;
                if (j < 8) AT_LOAD(j + 1);
                const LAS bf16_t* ks = KS + (st * 2 + hsel) * 4608; const LAS bf16_t* vs = VS + (st * 2 + hsel) * 4608; const LAS float* bl = BL + hsel * 320;
#pragma unroll
                for (int u = 0; u < 2; ++u) {
                    const int kb = (c - 8 + j) * 64 + 32 * u;
                    float sv[8];
#pragma unroll
                    for (int t = 0; t < 2; ++t) { const LAS bf16_t* kp = ks + (32 * u + 16 * t + fr) * 72 + 8 * fq;
                        f32x4 sc_ = (f32x4){0.f, 0.f, 0.f, 0.f};
                        sc_ = __builtin_amdgcn_mfma_f32_16x16x32_bf16(*(const LAS bf16x8*)kp, q0, sc_, 0, 0, 0); sc_ = __builtin_amdgcn_mfma_f32_16x16x32_bf16(*(const LAS bf16x8*)(kp + 32), q1, sc_, 0, 0, 0);
                        if (j <= 3) {
                            const float bc = bl[319];
#pragma unroll
                            for (int jj = 0; jj < 4; ++jj) sv[t * 4 + jj] = sc_[jj] * 0.18033688011112042f + bc;
                        } else {
#pragma unroll
                            for (int jj = 0; jj < 4; ++jj) { int rel = qpos - (kb + 16 * t + 4 * fq + jj); rel = rel > 256 ? 256 : rel; sv[t * 4 + jj] = sc_[jj] * 0.18033688011112042f + bl[rel + 63]; }
                        } }
                    float mx = sv[0];
#pragma unroll
                    for (int e = 1; e < 8; ++e) mx = fmaxf(mx, sv[e]);
                    mx = fmaxf(mx, __shfl_xor(mx, 16)); mx = fmaxf(mx, __shfl_xor(mx, 32));
                    const float mnew = fmaxf(mrun, mx), alpha = __builtin_amdgcn_exp2f(mrun - mnew); mrun = mnew;
                    float ps = 0.f;
#pragma unroll
                    for (int e = 0; e < 8; ++e) { sv[e] = __builtin_amdgcn_exp2f(sv[e] - mnew); ps += sv[e]; }
                    lrun = lrun * alpha + ps;
                    u32x4 pw; pw.x = cvt_pk_bf16(sv[0], sv[1]); pw.y = cvt_pk_bf16(sv[2], sv[3]); pw.z = cvt_pk_bf16(sv[4], sv[5]); pw.w = cvt_pk_bf16(sv[6], sv[7]);
                    const bf16x8 pf = __builtin_bit_cast(bf16x8, pw);
#pragma unroll
                    for (int dt = 0; dt < 4; ++dt) { const LAS bf16_t* vp = vs + (16 * dt + fr) * 72 + 32 * u + 4 * fq;
                        const u32x2 v0 = *(const LAS u32x2*)vp, v1 = *(const LAS u32x2*)(vp + 16); u32x4 w; w.x = v0.x; w.y = v0.y; w.z = v1.x; w.w = v1.y;
                        acc[dt] = acc[dt] * alpha;
                        acc[dt] = __builtin_amdgcn_mfma_f32_16x16x32_bf16(__builtin_bit_cast(bf16x8, w), pf, acc[dt], 0, 0, 0); }
                }
                if (j < 8) AT_WRITE(st ^ 1);
                __syncthreads();
            }
            lrun += __shfl_xor(lrun, 16); lrun += __shfl_xor(lrun, 32);
            const float inv = 1.f / lrun;
#pragma unroll
            for (int dt = 0; dt < 4; ++dt) { u32x2 w; w.x = cvt_pk_bf16(acc[dt][0] * inv, acc[dt][1] * inv); w.y = cvt_pk_bf16(acc[dt][2] * inv, acc[dt][3] * inv);
                *(u32x2*)(Z + qrow * ZW + AQ + h * 64 + 16 * dt + 4 * fq) = w; }
    }
}

__device__ __forceinline__ void c2_phase(const Params& P, int l, LAS unsigned char* lds) {
    const int tid = tid_opaque(), tok = tid >> 3, sub = tid & 7;
    bf16_t* Z = (bf16_t*)(P.ws + WS_ZB); bf16_t* XW = (bf16_t*)(P.ws + WS_XNB);
    (void)lds;
    for (int it = bid_opaque(); it < 528 * 4; it += gridDim.x) {
        const int tile = it >> 2, hp = it & 3, r0 = tile * 64, row = r0 + tok; const bool prompt = tile < 512; const int sr = row - T_P;
        const bool sfirst = !prompt && (sr & 31) == 0; const float* sh = sfirst ? PIN(8) + ((size_t)l * 32 + (sr >> 5)) * 1792 : nullptr;
        const bool pzero = prompt && tok == 0 && (r0 & (SEQ - 1)) == 0;
        const bf16_t* prow = (tok > 0) ? Z + (size_t)(row - 1) * ZW + CR : (const bf16_t*)(P.ws + WS_CZB) + (size_t)(tile > 0 ? tile - 1 : 0) * 1536;
        u32x4 cu[2][3], pv_[2][3], wa[2][2];
#pragma unroll
        for (int q = 0; q < 2; ++q) { const int hc = (hp * 2 + q) * 64 + sub * 8;
#pragma unroll
            for (int part = 0; part < 3; ++part) { cu[q][part] = *(const u32x4*)(Z + (size_t)row * ZW + CR + part * 512 + hc); pv_[q][part] = *(const u32x4*)(prow + part * 512 + hc); }
            wa[q][0] = *(const u32x4*)(XW + (size_t)row * DM + hc); wa[q][1] = *(const u32x4*)(XW + (size_t)row * DM + 512 + hc); }
        asm volatile("s_waitcnt vmcnt(0)" ::: "memory");
        __syncthreads();
        const float* mu = PIN(14) + (size_t)l * 1792;
#pragma unroll
        for (int q = 0; q < 2; ++q) { const int h = hp * 2 + q, hc = h * 64 + sub * 8;
            float r[8], k[8], v[8], wr_[8], ar_[8], kk[8], pr[8], pk[8], pvv[8];
            unpack8(cu[q][0], r); unpack8(cu[q][1], k); unpack8(cu[q][2], v); unpack8(pv_[q][0], pr); unpack8(pv_[q][1], pk); unpack8(pv_[q][2], pvv); unpack8(wa[q][0], wr_); unpack8(wa[q][1], ar_);
#pragma unroll
            for (int e = 0; e < 8; ++e) { float a_ = pr[e], b_ = pk[e], c_ = pvv[e];
                if (sfirst) { a_ = sh[hc + e]; b_ = sh[512 + hc + e]; c_ = sh[1024 + hc + e]; } else if (pzero) { a_ = 0.f; b_ = 0.f; c_ = 0.f; }
                r[e] = r[e] + (a_ - r[e]) * mu[hc + e]; k[e] = k[e] + (b_ - k[e]) * mu[512 + hc + e]; v[e] = v[e] + (c_ - v[e]) * mu[1024 + hc + e]; }
            const float* w0 = PIN(15) + l * 512 + hc; const float* a0 = PIN(17) + l * 512 + hc; const float* kkw = PIN(20) + l * 512 + hc; const float* kaw = PIN(21) + l * 512 + hc; const float* rk = PIN(22) + l * 512 + hc;
            float ss = 0.f, bn = 0.f;
#pragma unroll
            for (int e = 0; e < 8; ++e) { kk[e] = k[e] * kkw[e]; ss += kk[e] * kk[e]; }
            const float rn = rsqrtf(fmaxf(sum8(ss), 1e-24f));
#pragma unroll
            for (int e = 0; e < 8; ++e) { const float a = sigmoidf_(a0[e] + ar_[e]); const float ew = 0.6065306597126334f * sigmoidf_(w0[e] + wr_[e]);
                kk[e] *= rn; k[e] = k[e] * (1.f + (a - 1.f) * kaw[e]); bn += r[e] * k[e] * rk[e]; wr_[e] = ew; ar_[e] = kk[e] * a; }
            bn = sum8(bn);
            *(u32x4*)(Z + (size_t)row * ZW + CR + hc) = pack8(r); *(u32x4*)(Z + (size_t)row * ZW + CK + hc) = pack8(k); *(u32x4*)(Z + (size_t)row * ZW + CV + hc) = pack8(v);
            *(u32x4*)(Z + (size_t)row * ZW + BV + hc) = pack8(kk); *(u32x4*)(XW + (size_t)row * DM + hc) = pack8(wr_); *(u32x4*)(XW + (size_t)row * DM + 512 + hc) = pack8(ar_);
            if (sub == 0) ((float*)(P.ws + WS_BONUS))[(size_t)row * 8 + h] = bn; }
        __syncthreads();
    }
}

__device__ __forceinline__ void scan_phase(const Params& P, int l, LAS unsigned char* lds) {
    const int tid = tid_opaque(), lane = tid & 63, wave = tid >> 6;
    bf16_t* Z = (bf16_t*)(P.ws + WS_ZB); const bf16_t* XW = (const bf16_t*)(P.ws + WS_XNB);
    LAS float* buf = (LAS float*)lds;
    LAS float* ybuf = (LAS float*)(lds + 86016);
    const int bid_ = bid_opaque(), nidle_ = (int)gridDim.x > 192 ? (int)gridDim.x - 192 : 0;
    for (int it = (bid_ < 192 || nidle_ == 0) ? bid_ : 192 + (bid_ - 192); it < 192 + 1024; it += (bid_ < 192 ? (nidle_ ? 100000 : (int)gridDim.x) : nidle_)) {
        int rowbase, nsteps, h, qt, part = 0; const float* S0 = nullptr; float* So; bf16_t* yout; size_t ypitch = ZW;
        if (it < 192) { const int chain = it / 12, sub12 = it % 12, b = chain >> 3; h = chain & 7; part = sub12 >> 2; qt = sub12 & 3; nsteps = SEQ / 2; rowbase = b * SEQ + (part ? SEQ / 2 : 0);
            So = (float*)(P.ws + (part == 0 ? WS_SMID : (part == 1 ? WS_SP1 : WS_PHI))) + (size_t)chain * 4096;
            if (part < 2) yout = Z + (size_t)rowbase * ZW + BK + h * 64 + qt * 16; else { yout = (bf16_t*)(P.ws + WS_YPHI) + (size_t)b * (SEQ / 2) * 512 + h * 64 + qt * 16; ypitch = 512; } }
        else { const int si = it - 192, s = si >> 5; h = (si >> 2) & 7; qt = si & 3; rowbase = T_P + s * 32; nsteps = 32; S0 = PIN(7) + ((size_t)((l * 32 + s) * 8 + h)) * 4096; So = P.out + O_RWS + ((size_t)((l * 32 + s) * 8 + h)) * 4096;
            yout = Z + (size_t)rowbase * ZW + BK + h * 64 + qt * 16; }
        const int i0 = qt * 16, nb = nsteps >> 5;
        const int lt = tid - 256, lstep = lt >> 3, lsub = lt & 7;
        const int rr = lane >> 4, jl = lane & 15, li = 4 * wave + rr;
        f32x2v Sa = {0.f, 0.f}, Sb = {0.f, 0.f};
        u32x4 g_ew = {0u,0u,0u,0u}, g_k = g_ew, g_kk = g_ew, g_ka = g_ew, g_r = g_ew, g_v = g_ew;
        if (wave < 4 && S0) { const f32x4 s4 = *(const f32x4*)(S0 + (size_t)(i0 + li) * 64 + 4 * jl); Sa = (f32x2v){s4[0], s4[1]}; Sb = (f32x2v){s4[2], s4[3]}; }
        if (part == 2) { const int d_ = i0 + li - 4 * jl; Sa = (f32x2v){d_ == 0 ? 1.f : 0.f, d_ == 1 ? 1.f : 0.f}; Sb = (f32x2v){d_ == 2 ? 1.f : 0.f, d_ == 3 ? 1.f : 0.f}; }
        for (int bb = -1; bb < nb; ++bb) {
            if (wave >= 4) {
#define SC_LOAD(bt) do { const size_t row_ = (size_t)(rowbase + (bt) * 32 + lstep); g_ew = *(const u32x4*)(XW + row_ * DM + h * 64 + lsub * 8); g_k = *(const u32x4*)(Z + row_ * ZW + CK + h * 64 + lsub * 8); \
        g_kk = *(const u32x4*)(Z + row_ * ZW + BV + h * 64 + lsub * 8); g_ka = *(const u32x4*)(XW + row_ * DM + 512 + h * 64 + lsub * 8); g_r = *(const u32x4*)(Z + row_ * ZW + CR + h * 64 + lsub * 8); \
        if (lsub < 2 && part != 2) g_v = *(const u32x4*)(Z + row_ * ZW + CV + h * 64 + i0 + lsub * 8); } while (0)
#define SC_WRITE(bt) do { LAS float* d = buf + ((bt) & 1) * 10752 + lstep * 336; float f[8]; unpack8(g_ew, f); \
        *(LAS f32x4*)(d + lsub * 8) = (f32x4){__expf(-f[0]), __expf(-f[1]), __expf(-f[2]), __expf(-f[3])}; *(LAS f32x4*)(d + lsub * 8 + 4) = (f32x4){__expf(-f[4]), __expf(-f[5]), __expf(-f[6]), __expf(-f[7])}; \
        unpack8(g_k, f); *(LAS f32x4*)(d + 64 + lsub * 8) = (f32x4){f[0], f[1], f[2], f[3]}; *(LAS f32x4*)(d + 64 + lsub * 8 + 4) = (f32x4){f[4], f[5], f[6], f[7]}; \
        unpack8(g_kk, f); *(LAS f32x4*)(d + 128 + lsub * 8) = (f32x4){f[0], f[1], f[2], f[3]}; *(LAS f32x4*)(d + 128 + lsub * 8 + 4) = (f32x4){f[4], f[5], f[6], f[7]}; \
        unpack8(g_ka, f); *(LAS f32x4*)(d + 192 + lsub * 8) = (f32x4){f[0], f[1], f[2], f[3]}; *(LAS f32x4*)(d + 192 + lsub * 8 + 4) = (f32x4){f[4], f[5], f[6], f[7]}; \
        unpack8(g_r, f); *(LAS f32x4*)(d + 256 + lsub * 8) = (f32x4){f[0], f[1], f[2], f[3]}; *(LAS f32x4*)(d + 256 + lsub * 8 + 4) = (f32x4){f[4], f[5], f[6], f[7]}; \
        if (lsub < 2) { unpack8(g_v, f); *(LAS f32x4*)(d + 320 + lsub * 8) = (f32x4){f[0], f[1], f[2], f[3]}; *(LAS f32x4*)(d + 320 + lsub * 8 + 4) = (f32x4){f[4], f[5], f[6], f[7]}; } } while (0)
                if (bb == -1) { SC_LOAD(0); SC_WRITE(0); if (nb > 1) SC_LOAD(1); }
                else { if (bb + 1 < nb) SC_WRITE(bb + 1); if (bb + 2 < nb) SC_LOAD(bb + 2); }
                if (bb >= 1 && lsub < 2) {
                    const LAS float* y = ybuf + ((bb - 1) & 1) * 512 + lstep * 16 + lsub * 8; float f[8];
#pragma unroll
                    for (int e = 0; e < 8; ++e) f[e] = y[e];
                    *(u32x4*)(yout + (size_t)((bb - 1) * 32 + lstep) * ypitch + lsub * 8) = pack8(f);
                }
            } else if (bb >= 0) {
                __builtin_amdgcn_s_setprio(3);
                const LAS float* bp = buf + (bb & 1) * 10752 + 4 * jl; const LAS float* vp_ = buf + (bb & 1) * 10752 + 320 + li; LAS float* yb = ybuf + (bb & 1) * 512;
                float ysel = 0.f, yprev = 0.f;
                f32x4 cw = *(const LAS f32x4*)(bp), ck_ = *(const LAS f32x4*)(bp + 64), ckk = *(const LAS f32x4*)(bp + 128), cka = *(const LAS f32x4*)(bp + 192), cr = *(const LAS f32x4*)(bp + 256); float cv = vp_[0];
                f32x2v m = Sa * (f32x2v){ckk[0], ckk[1]}; m = Sb * (f32x2v){ckk[2], ckk[3]} + m;
                float a = m.x + m.y;
#pragma unroll
                for (int st = 0; st < 32; ++st) {
                    const int sn = (st + 1 < 32) ? st + 1 : st;
                    const f32x4 nw = *(const LAS f32x4*)(bp + sn * 336), nk = *(const LAS f32x4*)(bp + sn * 336 + 64), nkk = *(const LAS f32x4*)(bp + sn * 336 + 128), nka = *(const LAS f32x4*)(bp + sn * 336 + 192), nr = *(const LAS f32x4*)(bp + sn * 336 + 256); const float nv = vp_[sn * 336];
                    float b = yprev;
                    a += dppf<0xB1>(a); b += dppf<0xB1>(b); a += dppf<0x4E>(a); b += dppf<0x4E>(b); a += dppf<0x141>(a); b += dppf<0x141>(b); a += dppf<0x140>(a); b += dppf<0x140>(b);
                    if (st > 0) { ysel = (jl == ((st - 1) & 3)) ? b : ysel; if (((st - 1) & 3) == 3 && jl < 4) yb[(st - 4 + jl) * 16 + li] = ysel; }
                    const float nsa = -a; const f32x2v vi2 = {cv, cv}, ns2 = {nsa, nsa};
                    const f32x2v ta = (f32x2v){cka[0], cka[1]} * ns2 + (f32x2v){ck_[0], ck_[1]} * vi2, tb = (f32x2v){cka[2], cka[3]} * ns2 + (f32x2v){ck_[2], ck_[3]} * vi2;
                    Sa = Sa * (f32x2v){cw[0], cw[1]} + ta; Sb = Sb * (f32x2v){cw[2], cw[3]} + tb;
                    f32x2v ym = Sa * (f32x2v){cr[0], cr[1]}; ym = Sb * (f32x2v){cr[2], cr[3]} + ym; yprev = ym.x + ym.y;
                    f32x2v mm = Sa * (f32x2v){nkk[0], nkk[1]}; mm = Sb * (f32x2v){nkk[2], nkk[3]} + mm; a = mm.x + mm.y;
                    cw = nw; ck_ = nk; ckk = nkk; cka = nka; cr = nr; cv = nv;
                }
                { float b = red16(yprev); ysel = (jl == 3) ? b : ysel; if (jl < 4) yb[(28 + jl) * 16 + li] = ysel; }
                __builtin_amdgcn_s_setprio(0);
            }
            __syncthreads();
        }
        if (wave >= 4 && lsub < 2) { const LAS float* y = ybuf + ((nb - 1) & 1) * 512 + lstep * 16 + lsub * 8; float f[8];
#pragma unroll
            for (int e = 0; e < 8; ++e) f[e] = y[e];
            *(u32x4*)(yout + (size_t)((nb - 1) * 32 + lstep) * ypitch + lsub * 8) = pack8(f); }
        if (wave < 4) *(f32x4*)(So + (size_t)(i0 + li) * 64 + 4 * jl) = (f32x4){Sa.x, Sa.y, Sb.x, Sb.y};
        __syncthreads();
    }
    {
        unsigned* ctr = (unsigned*)(P.ws + 14336) + l;
        LAS int* slot = (LAS int*)(lds + 131072 + 1024);
        int nxt = 0;
        if (tid == 0) nxt = (int)atomicAdd(ctr, 1u);
        for (;;) {
            __syncthreads();
            if (tid == 0) { slot[0] = nxt; nxt = (int)atomicAdd(ctr, 1u); }
            __syncthreads();
            const int idx = slot[0];
            if (idx >= 512 + 2048) break;
            if (idx < 512) sattn_item(P, l, lds, idx, tid); else attn_item(P, l, lds, 1024 + idx - 512, tid);
        }
    }
}

__device__ __forceinline__ void e2_phase(const Params& P, int l) {
    const int tid = tid_opaque(), tok = tid >> 3, sub = tid & 7;
    bf16_t* Z = (bf16_t*)(P.ws + WS_ZB);
    {
        const float* SM = (const float*)(P.ws + WS_SMID); const float* S1 = (const float*)(P.ws + WS_SP1); const float* PH = (const float*)(P.ws + WS_PHI);
        for (int e = bid_opaque() * 512 + tid; e < 16 * 4096; e += gridDim.x * 512) { const int chain = e >> 12, i = (e >> 6) & 63, j = e & 63; float a = S1[e];
#pragma unroll 16
            for (int m = 0; m < 64; ++m) a += SM[chain * 4096 + i * 64 + m] * PH[chain * 4096 + m * 64 + j];
            P.out[O_RWP + (size_t)(l * 16 + chain) * 4096 + i * 64 + j] = a; }
    }
    const int wave = tid >> 6, lane = tid & 63, fr = lane & 15, fq = lane >> 4, tt = wave & 3, ih = wave >> 2;
    for (int t_ = bid_opaque(); t_ < 528; t_ += gridDim.x) {
        const int tile = (t_ >= 256 && t_ < 512) ? 256 + ((t_ - 256) ^ 128) : t_;
        if (tile < 512 && (tile & 255) >= 128) {
            const int b = tile >> 8, tl = ((tile & 255) - 128) * 64 + tt * 16 + fr;
            for (int h = 0; h < 8; ++h) {
                const float* SM = (const float*)(P.ws + WS_SMID) + (size_t)(b * 8 + h) * 4096;
                const bf16_t* yp = (const bf16_t*)(P.ws + WS_YPHI) + ((size_t)b * (SEQ / 2) + tl) * 512 + h * 64;
                const bf16x8 yb0 = *(const bf16x8*)(yp + 8 * fq), yb1 = *(const bf16x8*)(yp + 32 + 8 * fq);
                bf16_t* yrow = Z + (size_t)(b * SEQ + SEQ / 2 + tl) * ZW + BK + h * 64;
#pragma unroll
                for (int q = 0; q < 2; ++q) { const int i = (ih * 2 + q) * 16 + fr; f32x4 acc = (f32x4){0.f, 0.f, 0.f, 0.f};
#pragma unroll
                    for (int kk = 0; kk < 2; ++kk) { const f32x4 s0 = *(const f32x4*)(SM + i * 64 + 32 * kk + 8 * fq), s1 = *(const f32x4*)(SM + i * 64 + 32 * kk + 8 * fq + 4);
                        u32x4 w; w.x = cvt_pk_bf16(s0[0], s0[1]); w.y = cvt_pk_bf16(s0[2], s0[3]); w.z = cvt_pk_bf16(s1[0], s1[1]); w.w = cvt_pk_bf16(s1[2], s1[3]);
                        acc = __builtin_amdgcn_mfma_f32_16x16x32_bf16(__builtin_bit_cast(bf16x8, w), kk ? yb1 : yb0, acc, 0, 0, 0); }
                    bf16_t* dp = yrow + (ih * 2 + q) * 16 + 4 * fq; const u32x2 o = *(const u32x2*)dp; u32x2 w;
                    w.x = cvt_pk_bf16(bflo(o.x) + acc[0], bfhi(o.x) + acc[1]); w.y = cvt_pk_bf16(bflo(o.y) + acc[2], bfhi(o.y) + acc[3]); *(u32x2*)dp = w; }
            }
            __syncthreads();
        }
        const size_t row = (size_t)tile * 64 + tok;
#pragma unroll
        for (int hq = 0; hq < 2; ++hq) {
            u32x4 ry[4], rv[4], rg[4]; float bnv[4];
#pragma unroll
            for (int q = 0; q < 4; ++q) { const int h = hq * 4 + q, hc = h * 64 + sub * 8; ry[q] = *(const u32x4*)(Z + row * ZW + BK + hc); rv[q] = *(const u32x4*)(Z + row * ZW + CV + hc); rg[q] = *(const u32x4*)(Z + row * ZW + BG + hc);
                bnv[q] = ((const float*)(P.ws + WS_BONUS))[row * 8 + h]; }
#pragma unroll
            for (int q = 0; q < 4; ++q) { const int h = hq * 4 + q, hc = h * 64 + sub * 8; float y[8], v[8], g[8], o[8];
                unpack8(ry[q], y); unpack8(rv[q], v); unpack8(rg[q], g);
                float s_ = 0.f;
#pragma unroll
                for (int e = 0; e < 8; ++e) s_ += y[e];
                const float mean = sum8(s_) * (1.f / 64.f); float q2 = 0.f;
#pragma unroll
                for (int e = 0; e < 8; ++e) { const float d = y[e] - mean; q2 += d * d; }
                const float rs = rsqrtf(sum8(q2) * (1.f / 64.f) + 64e-5f);
                const float bn = bnv[q];
                const float* lw = PIN(23) + l * 512 + hc; const float* lb = PIN(24) + l * 512 + hc;
#pragma unroll
                for (int e = 0; e < 8; ++e) o[e] = ((y[e] - mean) * rs * lw[e] + lb[e] + bn * v[e]) * g[e];
                *(u32x4*)(Z + row * ZW + CR + hc) = pack8(o); }
        }
    }
}

#define XB_TMO      128
#define XB_XCNT(j)  (256  + 64 * (j))
#define XB_XSUB(j)  (1280 + 64 * (j))
#define XB_XGEN(j)  (2304 + 64 * (j))
#define XB_TOP      3328
#define XB_TOPGEN   3392
#define XCD_BAR_WORDS 3456
#define XB_SPIN_CAP (1u << 22)
__device__ __forceinline__ unsigned xb_ld(unsigned* p)              { return __hip_atomic_load(p, __ATOMIC_RELAXED, __HIP_MEMORY_SCOPE_AGENT); }
__device__ __forceinline__ unsigned xb_add(unsigned* p, unsigned v) { return __hip_atomic_fetch_add(p, v, __ATOMIC_RELAXED, __HIP_MEMORY_SCOPE_AGENT); }
__device__ __forceinline__ unsigned xb_xcc_id() { return (unsigned)__builtin_amdgcn_s_getreg((3 << 11) | 20) & 0xFu; }
#define XB_SPIN(cond, bar) do { unsigned _sp = 0; while (cond) { __builtin_amdgcn_s_sleep(1); \
    if ((++_sp & 255u) == 0u) { if (xb_ld(&(bar)[XB_TMO])) break; if (_sp > XB_SPIN_CAP) { atomicAdd(&(bar)[XB_TMO], 1u); break; } } } } while (0)
struct XcdBarrier { unsigned* bar; unsigned x; volatile LAS unsigned* st; };
__device__ __forceinline__ XcdBarrier xcd_barrier_post(unsigned* bar, volatile LAS unsigned* st) {
    XcdBarrier b; b.bar = bar; b.x = xb_xcc_id(); b.st = st;
    if (threadIdx.x == 0) (void)xb_add(&bar[XB_XCNT(b.x)], 1u);
    return b;
}
__device__ __forceinline__ void xcd_barrier_complete(unsigned* bar, unsigned x, unsigned& nloc, unsigned& nx) {
    const unsigned G = gridDim.x * gridDim.y * gridDim.z;
    unsigned sum, cnt, mine, sp = 0u;
    for (;;) {
        sum = 0u; cnt = 0u; mine = 0u;
#pragma unroll
        for (unsigned j = 0; j < 16; ++j) { const unsigned c = xb_ld(&bar[XB_XCNT(j)]); sum += c; cnt += (c > 0u) ? 1u : 0u; mine = (j == x) ? c : mine; }
        if (sum == G) break;
        __builtin_amdgcn_s_sleep(1);
        if ((++sp & 255u) == 0u) { if (xb_ld(&bar[XB_TMO])) break; if (sp > XB_SPIN_CAP) { atomicAdd(&bar[XB_TMO], 1u); break; } }
    }
    nloc = mine > 0u ? mine : 1u; nx = cnt > 0u ? cnt : 1u;
}
__device__ __forceinline__ void xcd_barrier(const XcdBarrier& b) {
    asm volatile("s_waitcnt vmcnt(0)" ::: "memory");
    __syncthreads();
    if (threadIdx.x == 0) {
        unsigned* bar = b.bar;
        __builtin_amdgcn_s_waitcnt(0);
        unsigned nloc = b.st[0], nx = b.st[1];
        if (nloc == 0u) { xcd_barrier_complete(bar, b.x, nloc, nx); b.st[0] = nloc; b.st[1] = nx; }
        const unsigned old = xb_add(&bar[XB_XSUB(b.x)], 1u);
        const unsigned gen = old / nloc;
        if (old + 1u == (gen + 1u) * nloc) {
            __builtin_amdgcn_fence(__ATOMIC_RELEASE, "agent");
            asm volatile("s_waitcnt vmcnt(0)" ::: "memory");
            const unsigned og = xb_add(&bar[XB_TOP], 1u);
            const unsigned tg = og / nx;
            if (og + 1u == (tg + 1u) * nx) xb_add(&bar[XB_TOPGEN], 1u);
            else XB_SPIN(xb_ld(&bar[XB_TOPGEN]) == tg, bar);
            __builtin_amdgcn_fence(__ATOMIC_ACQUIRE, "agent");
            xb_add(&bar[XB_XGEN(b.x)], 1u);
            asm volatile("s_waitcnt vmcnt(0)" ::: "memory");
        } else {
            XB_SPIN(xb_ld(&bar[XB_XGEN(b.x)]) == gen, bar);
            __builtin_amdgcn_fence(__ATOMIC_ACQUIRE, "agent");
            asm volatile("s_waitcnt vmcnt(0)" ::: "memory");
        }
    }
    __syncthreads();
}

__global__ void __launch_bounds__(512, 2) mega_fwd(Params P) {
    extern __shared__ __attribute__((aligned(16))) unsigned char lds_raw[];
    LAS unsigned char* lds = (LAS unsigned char*)lds_raw;
    unsigned char* ws = P.ws;
    bf16_t* Z = (bf16_t*)(ws + WS_ZB); bf16_t* XNB = (bf16_t*)(ws + WS_XNB); bf16_t* LOB = (bf16_t*)(ws + WS_LOB); bf16_t* WT = (bf16_t*)(ws + WS_W);
    volatile LAS unsigned* bst = (volatile LAS unsigned*)(lds + 131072 + 512);
    if (threadIdx.x < 2) bst[threadIdx.x] = 0u;
    __syncthreads();
    XcdBarrier xbar = xcd_barrier_post((unsigned*)ws, bst);
    for (int ph = P.ph_lo; ph < P.ph_hi; ++ph) {
        if (ph == 0) { convert_weights(P, 0, lds); row_norm_pass(P, 0, 0); }
        else {
            const int l = (ph - 1) / NPH_LAYER, k = (ph - 1) % NPH_LAYER;
            GemmDesc g; g.sched = -1; g.lda = g.ldb = 1024; g.K = 1024; g.nM = 132; g.nN = 4; g.epi = 0; g.perm = 1; g.d0 = nullptr; g.ldc0 = 1024; g.d1 = nullptr; g.x = nullptr; g.z = Z; g.A = nullptr; g.B = nullptr; g.skip = 0; g.xs0 = nullptr; g.xs1 = nullptr;
            switch (k) {
            case 0: g.sched = 0; g.A = (const char*)XNB; g.B = (const char*)(WT + W_Z); g.nN = 21; g.d0 = Z; g.ldc0 = ZW; break;
            case 1: e1_phase(P, l, lds); break;
            case 2: p2_phase(P, l, lds); break;
            case 3: p3_phase(P, l, lds); break;
            case 4: g.sched = 0; g.A = (const char*)LOB; g.lda = 256; g.B = (const char*)(WT + W_BD); g.ldb = 256; g.K = 256; g.nN = 6; g.epi = 1; g.d0 = XNB; break;
            case 5: c2_phase(P, l, lds); break;
            case 6: scan_phase(P, l, lds); break;
            case 7: e2_phase(P, l); row_norm_pass(P, l, 1); break;
            case 8: g.sched = 0; g.A = (const char*)XNB; g.B = (const char*)(WT + W_GL); g.nN = 12; g.epi = 2; g.d0 = Z; g.ldc0 = ZW; break;
            case 9: g.sched = 1; g.A = (const char*)Z; g.lda = ZW; g.B = (const char*)(WT + W_B); g.ldb = 512; g.K = 512; g.epi = 3; g.d0 = XNB; break;
            case 10: g.sched = 0; g.A = (const char*)XNB; g.B = (const char*)(WT + W_O); g.epi = 4; g.perm = 0; g.x = P.out; if (l == 0) { g.xs0 = PIN(0); g.xs1 = PIN(1); } break;
            case 11: row_norm_pass(P, l, 2); break;
            case 12: g.sched = 0; g.A = (const char*)Z; g.B = (const char*)(WT + W_GU); g.nN = 22; g.epi = 5; g.d0 = (bf16_t*)(ws + WS_H); g.ldc0 = FF; break;
            case 13: g.sched = 0; g.A = (const char*)(ws + WS_H); g.lda = FF; g.B = (const char*)(WT + W_D); g.ldb = FF; g.K = FF; g.epi = 4; g.perm = 0; g.x = P.out; g.d1 = (bf16_t*)(ws + WS_XB); break;
            case 14: g.sched = 0; g.A = (const char*)(ws + WS_XB); g.B = (const char*)(WT + W_PG); g.d0 = Z; break;
            default: finish_pass(P, l); if (l == 0) convert_weights(P, 1, lds); break;
            }
            for (int rep = 0; rep < (k == 13 ? 2 : 1); ++rep) {
                if (rep == 1) { g.A = (const char*)LOB; g.lda = 256; g.B = (const char*)(WT + W_P); g.ldb = 256; g.K = 256; g.epi = 0; g.perm = 1; g.d0 = XNB; g.ldc0 = 1024; g.d1 = nullptr; g.x = nullptr;
                    g.skip = ((int)gridDim.x >= 128 && 528 > 2 * (int)gridDim.x && 528 < 3 * (int)gridDim.x) ? 528 - 2 * (int)gridDim.x : 0; }
                if (g.sched >= 0) gemm_phase(lds, g);
            }
#ifdef DBG_REP_MASK
            if ((DBG_REP_MASK >> k) & 1) { cg::this_grid().sync(); if (g.sched >= 0) gemm_phase(lds, g); else if (k == 6) scan_phase(P, l, lds); else if (k == 2) p2_phase(P, l, lds); }
#endif
        }
        if (ph + 1 < P.ph_hi) { if (P.ph_hi < 0) cg::this_grid().sync(); else xcd_barrier(xbar); }
#ifdef DBG_EXTRA_SYNC
        if (ph + 1 < P.ph_hi) { cg::this_grid().sync(); cg::this_grid().sync(); }
#endif
    }
#ifdef DBG_DUMP_Z
    cg::this_grid().sync();
    for (size_t e = (size_t)blockIdx.x * 512 + threadIdx.x; e < (size_t)T_ALL * 512; e += (size_t)gridDim.x * 512) {
        const size_t r = e >> 9; const int c = (int)(e & 511);
        P.out[e] = bf2f(XNB[e]); (void)r; (void)c;
    }
#endif
}

extern "C" void kernel_launch(void* const* d_in, const int* in_sizes, int n_in, void* d_out, int out_size, void* d_ws, size_t ws_size, hipStream_t stream) {
    static int grid = 0;
    if (grid == 0) {
        if (n_in != 34 || out_size != 45603840 || ws_size < WS_END2) { fprintf(stderr, "kernel_launch: unexpected shapes n_in %d out %d ws %zu\n", n_in, out_size, ws_size); grid = -1; return; }
        int dev = 0, cus = 0, per_cu = 0;
        hipGetDevice(&dev); hipDeviceGetAttribute(&cus, hipDeviceAttributeMultiprocessorCount, dev);
        hipFuncSetAttribute((const void*)mega_fwd, hipFuncAttributeMaxDynamicSharedMemorySize, LDS_BYTES);
        hipOccupancyMaxActiveBlocksPerMultiprocessor(&per_cu, (const void*)mega_fwd, 512, LDS_BYTES);
        if (per_cu < 1) { fprintf(stderr, "kernel_launch: occupancy query says %d blocks per CU\n", per_cu); per_cu = 1; }
        (void)hipGetLastError();
        grid = cus * per_cu;
        fprintf(stderr, "kernel_launch: grid %d (cus %d x %d)\n", grid, cus, per_cu);
    }
    if (grid < 0) return;
#ifdef DBG_POISON
    (void)hipMemsetAsync(d_ws, 0xFF, WS_END, stream);
#endif
    (void)hipMemsetAsync(d_ws, 0, 16384, stream);
    Params p{};
    for (int i = 0; i < 34; ++i) p.in[i] = (const float*)d_in[i];
    p.out = (float*)d_out; p.ws = (unsigned char*)d_ws;
#if MK_PER_PHASE
    for (int ph = 0; ph < NPHASES; ++ph) { p.ph_lo = ph; p.ph_hi = ph + 1; hipLaunchKernelGGL(mega_fwd, dim3(grid), dim3(512), LDS_BYTES, stream, p); }
#else
#ifdef DBG_PH_HI
    p.ph_lo = 0; p.ph_hi = DBG_PH_HI;
#else
    p.ph_lo = 0; p.ph_hi = NPHASES;
#endif
    void* args[] = {&p};
    hipError_t e = hipLaunchCooperativeKernel((const void*)mega_fwd, dim3(grid), dim3(512), args, LDS_BYTES, stream);
    if (e != hipSuccess) fprintf(stderr, "cooperative launch failed: %s (grid %d)\n", hipGetErrorString(e), grid);
#endif
}
```

```cpp
#include <hip/hip_runtime.h>
#include <hip/hip_cooperative_groups.h>
#include <cstdio>
#include <cstdint>
namespace cg = cooperative_groups;


#ifndef MK_PER_PHASE
#define MK_PER_PHASE 0
#endif

#define LAS __attribute__((address_space(3)))
typedef unsigned short bf16_t;
typedef short bf16x8 __attribute__((ext_vector_type(8)));
typedef float f32x4 __attribute__((ext_vector_type(4)));
typedef unsigned u32x4 __attribute__((ext_vector_type(4)));
typedef unsigned u32x2 __attribute__((ext_vector_type(2)));

constexpr int T_ALL = 33792, T_P = 32768, SEQ = 16384, DM = 1024, ZW = 5376, FF = 2816;
constexpr int AQ = 0, AK = 512, AV = 1024, BQ = 1536, BK = 2048, BV = 2560, BG = 3072, CR = 3584, CK = 4096, CV = 4608, CLO = 5120;
constexpr float EPS = 1e-6f;
constexpr int NPH_LAYER = 16, NPHASES = 1 + 2 * NPH_LAYER;
constexpr size_t O_YP = 0, O_AKP = 34603008, O_AVP = 35651584, O_RETP = 36700160, O_RWP = 36962304, O_SHP = 37093376,
                 O_AKS = 37100544, O_AVS = 38149120, O_RETS = 39197696, O_RWS = 43392000, O_SHS = 45489152;
constexpr size_t MiB = 1u << 20;
constexpr size_t WS_W = 1 * MiB, WS_XNB = 43 * MiB, WS_LOB = 109 * MiB, WS_ZB = 126 * MiB, WS_BONUS = 473 * MiB, WS_CZB = 475 * MiB, WS_END = 477 * MiB;
constexpr size_t WS_YPHI = 478 * MiB, WS_SMID = 495 * MiB, WS_SP1 = 496 * MiB, WS_PHI = 497 * MiB, WS_END2 = 498 * MiB;
constexpr size_t WS_H = WS_ZB + 66 * MiB, WS_XB = WS_ZB + 248 * MiB;
constexpr size_t W_Z = 0, W_GL = 5505024, W_BD = 8650752, W_B = 9043968, W_O = 10616832, W_GU = 11665408, W_D = 17432576, W_P = 20316160, W_PG = 20578304;
constexpr int LDS_BYTES = 147456;

struct Params { const float* in[34]; float* out; unsigned char* ws; int ph_lo, ph_hi; };

__device__ __forceinline__ const float* ld_in(const Params& P, int i) { asm volatile("" : "+s"(i)); return P.in[i]; }
#define PIN(i) ld_in(P, i)
__device__ __forceinline__ int tid_opaque() { int t = threadIdx.x; asm volatile("" : "+v"(t)); return t; }
__device__ __forceinline__ int bid_opaque() { int b = blockIdx.x; asm volatile("" : "+s"(b)); return b; }
typedef __bf16 bf16x2v __attribute__((ext_vector_type(2)));
typedef float f32x2v __attribute__((ext_vector_type(2)));
__device__ __forceinline__ unsigned cvt_pk_bf16(float lo, float hi) { f32x2v v = {lo, hi}; bf16x2v b = __builtin_convertvector(v, bf16x2v); return __builtin_bit_cast(unsigned, b); }
__device__ __forceinline__ float bflo(unsigned w) { return __uint_as_float(w << 16); }
__device__ __forceinline__ float bfhi(unsigned w) { return __uint_as_float(w & 0xffff0000u); }
__device__ __forceinline__ float bf2f(bf16_t b) { return __uint_as_float((unsigned)b << 16); }
__device__ __forceinline__ bf16_t f2bf(float f) { return (bf16_t)(cvt_pk_bf16(f, f) & 0xffffu); }
__device__ __forceinline__ void unpack8(u32x4 w, float* f) { f[0] = bflo(w.x); f[1] = bfhi(w.x); f[2] = bflo(w.y); f[3] = bfhi(w.y); f[4] = bflo(w.z); f[5] = bfhi(w.z); f[6] = bflo(w.w); f[7] = bfhi(w.w); }
__device__ __forceinline__ u32x4 pack8(const float* f) { u32x4 w; w.x = cvt_pk_bf16(f[0], f[1]); w.y = cvt_pk_bf16(f[2], f[3]); w.z = cvt_pk_bf16(f[4], f[5]); w.w = cvt_pk_bf16(f[6], f[7]); return w; }
__device__ __forceinline__ float sigmoidf_(float x) { return __builtin_amdgcn_rcpf(1.f + __builtin_amdgcn_exp2f(-1.4426950408889634f * x)); }
__device__ __forceinline__ float wave_sum(float v) {
#pragma unroll
    for (int o = 1; o < 64; o <<= 1) v += __shfl_xor(v, o);
    return v;
}
__device__ __forceinline__ float sum8(float v) { v += __shfl_xor(v, 1); v += __shfl_xor(v, 2); v += __shfl_xor(v, 4); return v; }
template <int CTRL> __device__ __forceinline__ float dppf(float x) { return __builtin_bit_cast(float, __builtin_amdgcn_update_dpp(0, __builtin_bit_cast(int, x), CTRL, 0xf, 0xf, false)); }
__device__ __forceinline__ float red16(float x) { x += dppf<0xB1>(x); x += dppf<0x4E>(x); x += dppf<0x141>(x); x += dppf<0x140>(x); return x; }
__device__ __forceinline__ float gamma_l2(int h) { return __log2f(1.f - __builtin_amdgcn_exp2f(-5.f - (float)h)); }
#define LDSW() asm volatile("s_waitcnt lgkmcnt(0)" ::: "memory")

constexpr int BM = 256, BKT = 64, HALF = 128, HTB = HALF * BKT * 2;
__device__ __forceinline__ int lds_byte(int r, int c) { const int st = (r >> 4) * 2 + (c >> 5), rr = r & 15, cc = c & 31, ob = rr * 64 + cc * 2; return st * 1024 + (ob ^ (((ob >> 9) & 1) << 5)); }
__device__ __forceinline__ void stage_rc(int b, int& R, int& C) { const int st = b / 1024, sb = b % 1024, swz = sb ^ (((sb >> 9) & 1) << 5); R = (st >> 1) * 16 + swz / 64; C = (st & 1) * 32 + (swz % 64) / 2; }
__device__ __forceinline__ int perm32(int rho) { const int n = rho >> 4, i = rho & 15; return 8 * (i >> 2) + 4 * n + (i & 3); }

struct Unit { const char* a; const char* b; int pm, pn, aux; };
struct GemmDesc {
    const char* A; const char* B; int lda, ldb, K, nM, nN, sched, epi, perm;
    bf16_t* d0; int ldc0; bf16_t* d1; float* x; bf16_t* z;
    const float* xs0; const float* xs1;
    int skip;
};
__device__ __forceinline__ void tile_map(int L, int nM, int nN, int& pm, int& pn) {
    const int nwg = nM * nN; int wgid = L;
    { const int q = nwg / 8, r = nwg % 8, xcd = wgid % 8, off = wgid / 8; wgid = (xcd < r ? xcd * (q + 1) : r * (q + 1) + (xcd - r) * q) + off; }
    const int nig = 8 * nN, gid = wgid / nig, fm = gid * 8, gsz = (nM - fm) < 8 ? (nM - fm) : 8;
    pm = fm + ((wgid % nig) % gsz); pn = (wgid % nig) / gsz;
}
__device__ __forceinline__ int gl_off(int b) { return b == 0 ? 512 : (b == 1 ? 2048 : 4096); }
__device__ __forceinline__ int br_off(int b) { return b == 0 ? AQ : (b == 1 ? BQ : CR); }
__device__ __forceinline__ bool unit_next(const GemmDesc& g, int i, int G, int c, Unit& u) {
    const int nwg = g.nM * g.nN;
    if (g.sched == 0) {
        if (c < g.skip) return false;
        const long L = (long)i * (G - g.skip) + (c - g.skip); if (L >= nwg) return false;
        tile_map((int)L, g.nM, g.nN, u.pm, u.pn); u.aux = 0;
        u.a = g.A + (size_t)u.pm * 256 * g.lda * 2; u.b = g.B + (size_t)u.pn * 256 * g.ldb * 2; return true;
    } else {
        const long L = (long)(i / 3) * G + c; if (L >= nwg) return false;
        const int b = i % 3; tile_map((int)L, g.nM, g.nN, u.pm, u.pn); u.aux = b;
        u.a = g.A + (size_t)u.pm * 256 * g.lda * 2 + br_off(b) * 2; u.b = g.B + (size_t)b * 1024 * 512 * 2 + (size_t)u.pn * 256 * g.ldb * 2; return true;
    }
}
__device__ __forceinline__ void gemm_epilogue(const GemmDesc& g, const f32x4 (&acc)[2][2][4][2], const Unit& u, int wr, int wc, int fr, int fq) {
    const int row0 = u.pm * BM + wr * 64 + fr;
    if (g.epi == 4) {
        const int col0 = u.pn * BM + wc * 32 + 4 * fq;
#pragma unroll
        for (int ai = 0; ai < 2; ++ai)
#pragma unroll
            for (int m = 0; m < 4; ++m) { const int row_ = row0 + ai * HALF + m * 16; const size_t ro = (size_t)row_ * DM + col0;
                const float* sp = g.xs0 ? (row_ < T_P ? g.xs0 + ro : g.xs1 + (ro - (size_t)T_P * DM)) : g.x + ro;
#pragma unroll
                for (int bj = 0; bj < 2; ++bj)
#pragma unroll
                    for (int n = 0; n < 2; ++n) { f32x4* p = (f32x4*)(g.x + ro + bj * HALF + n * 16); const f32x4 v = *(const f32x4*)(sp + bj * HALF + n * 16) + acc[ai][bj][m][n]; *p = v;
                        if (g.d1) { u32x2 w; w.x = cvt_pk_bf16(v[0], v[1]); w.y = cvt_pk_bf16(v[2], v[3]); *(u32x2*)(g.d1 + ro + bj * HALF + n * 16) = w; } } }
        return;
    }
    const int cl = wc * 32 + 8 * fq;
    if (g.epi == 5) {
#pragma unroll
        for (int ai = 0; ai < 2; ++ai)
#pragma unroll
            for (int m = 0; m < 4; ++m) { const size_t ro = (size_t)(row0 + ai * HALF + m * 16) * g.ldc0 + u.pn * 128 + cl; float h[8];
#pragma unroll
                for (int n = 0; n < 2; ++n)
#pragma unroll
                    for (int e = 0; e < 4; ++e) { const float gt = acc[ai][0][m][n][e], up = acc[ai][1][m][n][e]; h[n * 4 + e] = gt * sigmoidf_(gt) * up; }
                *(u32x4*)(g.d0 + ro) = pack8(h); }
        return;
    }
    bf16_t* base = g.d0; int ldc = g.ldc0, colt = u.pn * BM; bool sg = false;
    if (g.epi == 1) { if (u.pn >= 4) { base = g.z; ldc = ZW; colt = BG + (u.pn - 4) * BM; } }
    else if (g.epi == 2) { colt = gl_off(u.pn >> 2) + (u.pn & 3) * BM; sg = true; }
    const bool gated = (g.epi == 3); const int gcol = gated ? gl_off(u.aux) : 0;
#pragma unroll
    for (int ai = 0; ai < 2; ++ai)
#pragma unroll
        for (int m = 0; m < 4; ++m) { const int row = row0 + ai * HALF + m * 16;
#pragma unroll
            for (int bj = 0; bj < 2; ++bj) { float v[8];
#pragma unroll
                for (int n = 0; n < 2; ++n)
#pragma unroll
                    for (int e = 0; e < 4; ++e) v[n * 4 + e] = acc[ai][bj][m][n][e];
                bf16_t* dp = base + (size_t)row * ldc + colt + bj * HALF + cl;
                if (sg) {
#pragma unroll
                    for (int e = 0; e < 8; ++e) v[e] = sigmoidf_(v[e]);
                }
                if (gated) { float gt[8]; unpack8(*(const u32x4*)(g.z + (size_t)row * ZW + gcol + u.pn * BM + bj * HALF + cl), gt);
#pragma unroll
                    for (int e = 0; e < 8; ++e) v[e] *= gt[e];
                    if (u.aux > 0) { float pv[8]; unpack8(*(const u32x4*)dp, pv);
#pragma unroll
                        for (int e = 0; e < 8; ++e) v[e] += pv[e]; } }
                *(u32x4*)dp = pack8(v); } }
}

__device__ __forceinline__ void gemm_phase(LAS unsigned char* lds, const GemmDesc& g) {
    const int tid = tid_opaque(), wid = __builtin_amdgcn_readfirstlane(tid >> 6), lane = tid & 63, wr = wid >> 2, wc = wid & 3, fr = lane & 15, fq = lane >> 4;
    const int G = gridDim.x, cb = bid_opaque();
    const int K = g.K, nt = K / BKT;
    unsigned voffA[2], voffB[2];
#pragma unroll
    for (int i = 0; i < 2; ++i) { int R, C; stage_rc(tid * 16 + i * 8192, R, C); const int Rb = g.perm ? ((R & ~31) + perm32(R & 31)) : R;
        voffA[i] = (unsigned)(R * g.lda + C) * 2u; voffB[i] = (unsigned)(Rb * g.ldb + C) * 2u; }
    const size_t kstep = (size_t)(BKT * 2);
    const size_t hstepA = (size_t)HALF * g.lda * 2, hstepB = (size_t)HALF * g.ldb * 2;
    const unsigned ldsw = (unsigned)wid * 1024u;
    const int aoff = lds_byte(wr * 64 + fr, fq * 8), boff = lds_byte(wc * 32 + fr, fq * 8);
#define PG8_SA(b, h) (((b) * 2 + (h)) * HTB)
#define PG8_SB(b, h) ((4 + (b) * 2 + (h)) * HTB)
#define PG8_STAGE(bufoff, gbase, voff) do { _Pragma("unroll") for (int _i = 0; _i < 2; ++_i) \
        __builtin_amdgcn_global_load_lds((const unsigned*)((const char*)(gbase) + (voff)[_i]), (LAS unsigned*)(lds + (bufoff) + ldsw + _i * 8192), 16, 0, 0); } while (0)
#define PG8_LDA(dst, b, h) do { _Pragma("unroll") for (int m = 0; m < 4; ++m) _Pragma("unroll") for (int k = 0; k < 2; ++k) dst[m][k] = *(const LAS bf16x8*)(lds + PG8_SA(b, h) + aoff + m * 2048 + k * 1024); } while (0)
#define PG8_LDB(dst, b, h) do { _Pragma("unroll") for (int n = 0; n < 2; ++n) _Pragma("unroll") for (int k = 0; k < 2; ++k) dst[n][k] = *(const LAS bf16x8*)(lds + PG8_SB(b, h) + boff + n * 2048 + k * 1024); } while (0)
#define PG8_MMA(ai, bj, At, Bt) do { __builtin_amdgcn_s_setprio(1); _Pragma("unroll") for (int m = 0; m < 4; ++m) _Pragma("unroll") for (int n = 0; n < 2; ++n) _Pragma("unroll") for (int k = 0; k < 2; ++k) \
        acc[ai][bj][m][n] = __builtin_amdgcn_mfma_f32_16x16x32_bf16(Bt[n][k], At[m][k], acc[ai][bj][m][n], 0, 0, 0); __builtin_amdgcn_s_setprio(0); } while (0)
#define PG8_WAIT_V(n) asm volatile("s_waitcnt vmcnt(" #n ")" ::: "memory")
#define PG8_WAIT_L(n) asm volatile("s_waitcnt lgkmcnt(" #n ")" ::: "memory")
#define PG8_BAR __builtin_amdgcn_s_barrier()
#define PG8_SCHED __builtin_amdgcn_sched_barrier(0)
    Unit cur, nxt; int ui = 0;
    if (!unit_next(g, 0, G, cb, cur)) return;
    f32x4 acc[2][2][4][2];
#pragma unroll
    for (int a = 0; a < 2; ++a)
#pragma unroll
        for (int b = 0; b < 2; ++b)
#pragma unroll
            for (int m = 0; m < 4; ++m)
#pragma unroll
                for (int n = 0; n < 2; ++n) acc[a][b][m][n] = (f32x4){0.f, 0.f, 0.f, 0.f};
    bf16x8 At[4][2], B0[2][2], B1[2][2];
    const char* cA = cur.a; const char* cB = cur.b;
    PG8_STAGE(PG8_SB(0, 0), cB, voffB); PG8_STAGE(PG8_SB(0, 1), cB + hstepB, voffB); PG8_STAGE(PG8_SA(0, 0), cA, voffA); PG8_STAGE(PG8_SA(0, 1), cA + hstepA, voffA);
    if (wr == 1) PG8_BAR;
    PG8_WAIT_V(2); PG8_BAR;
    PG8_STAGE(PG8_SB(1, 0), cB + kstep, voffB); PG8_STAGE(PG8_SA(1, 0), cA + kstep, voffA); PG8_STAGE(PG8_SB(1, 1), cB + hstepB + kstep, voffB);
    PG8_WAIT_V(6); PG8_BAR;
    for (;;) {
        const bool has_next = unit_next(g, ui + 1, G, cb, nxt);
        const char* nA = has_next ? nxt.a : cA; const char* nB = has_next ? nxt.b : cB;
        for (int t = 0; t < nt; t += 2) {
            const bool last = (t == nt - 2);
            const char* a1 = cA + (size_t)(t + 1) * kstep;
            const char* a2 = last ? nA : cA + (size_t)(t + 2) * kstep; const char* b2 = last ? nB : cB + (size_t)(t + 2) * kstep;
            const char* a3 = a2 + kstep; const char* b3 = b2 + kstep;
            PG8_LDB(B0, 0, 0); PG8_LDB(B1, 0, 1); PG8_SCHED; PG8_LDA(At, 0, 0); PG8_STAGE(PG8_SA(1, 1), a1 + hstepA, voffA);
            PG8_WAIT_V(8); PG8_WAIT_L(0); PG8_BAR; PG8_MMA(0, 0, At, B0); PG8_MMA(0, 1, At, B1); PG8_BAR; PG8_SCHED;
            PG8_LDA(At, 0, 1); PG8_STAGE(PG8_SB(0, 0), b2, voffB); PG8_STAGE(PG8_SB(0, 1), b2 + hstepB, voffB); PG8_STAGE(PG8_SA(0, 0), a2, voffA);
            PG8_WAIT_V(8); PG8_WAIT_L(0); PG8_BAR; PG8_MMA(1, 0, At, B0); PG8_MMA(1, 1, At, B1); PG8_BAR; PG8_SCHED;
            PG8_LDB(B0, 1, 0); PG8_LDB(B1, 1, 1); PG8_SCHED; PG8_LDA(At, 1, 0); PG8_STAGE(PG8_SA(0, 1), a2 + hstepA, voffA);
            PG8_WAIT_V(8); PG8_WAIT_L(0); PG8_BAR; PG8_MMA(0, 0, At, B0); PG8_MMA(0, 1, At, B1); PG8_BAR; PG8_SCHED;
            PG8_LDA(At, 1, 1); PG8_STAGE(PG8_SB(1, 0), b3, voffB); PG8_STAGE(PG8_SB(1, 1), b3 + hstepB, voffB); PG8_STAGE(PG8_SA(1, 0), a3, voffA);
            PG8_WAIT_V(8); PG8_WAIT_L(0); PG8_BAR; PG8_MMA(1, 0, At, B0); PG8_MMA(1, 1, At, B1); PG8_BAR; PG8_SCHED;
        }
        if (wr == 0) PG8_BAR;
        gemm_epilogue(g, acc, cur, wr, wc, fr, fq);
        if (!has_next) break;
#pragma unroll
        for (int a = 0; a < 2; ++a)
#pragma unroll
            for (int b = 0; b < 2; ++b)
#pragma unroll
                for (int m = 0; m < 4; ++m)
#pragma unroll
                    for (int n = 0; n < 2; ++n) acc[a][b][m][n] = (f32x4){0.f, 0.f, 0.f, 0.f};
        cur = nxt; cA = nA; cB = nB; ++ui;
        if (wr == 1) PG8_BAR;
    }
    PG8_WAIT_V(0);
    PG8_BAR;
}

struct MatDesc { const float* W; int ldw, col0, K, N; bf16_t* T; int ldt, koff, rowmode, rowoff; };
__device__ __forceinline__ MatDesc get_mat(const Params& P, int l, int m) {
    bf16_t* wb = (bf16_t*)(P.ws + WS_W); MatDesc d; d.col0 = 0; d.koff = 0; d.rowmode = 0; d.rowoff = 0;
    switch (m) {
    case 0: d.W = PIN(10) + (size_t)l * 1024 * 8448; d.ldw = 8448; d.K = 1024; d.N = 5376; d.T = wb + W_Z; d.ldt = 1024; break;
    case 1: d.W = PIN(10) + (size_t)l * 1024 * 8448; d.ldw = 8448; d.col0 = 5376; d.K = 1024; d.N = 3072; d.T = wb + W_GL; d.ldt = 1024; break;
    case 2: d.W = PIN(16) + (size_t)l * 64 * 512; d.ldw = 512; d.K = 64; d.N = 512; d.T = wb + W_BD; d.ldt = 256; break;
    case 3: d.W = PIN(18) + (size_t)l * 64 * 512; d.ldw = 512; d.K = 64; d.N = 512; d.T = wb + W_BD; d.ldt = 256; d.koff = 64; d.rowoff = 512; break;
    case 4: d.W = PIN(19) + (size_t)l * 128 * 512; d.ldw = 512; d.K = 128; d.N = 512; d.T = wb + W_BD; d.ldt = 256; d.koff = 128; d.rowoff = 1024; break;
    case 5: case 6: case 7: d.W = PIN(25) + (size_t)(l * 3 + (m - 5)) * 512 * 1024; d.ldw = 1024; d.K = 512; d.N = 1024; d.T = wb + W_B + (size_t)(m - 5) * 1024 * 512; d.ldt = 512; break;
    case 8: d.W = PIN(26) + (size_t)l * 1024 * 1024; d.ldw = 1024; d.K = 1024; d.N = 1024; d.T = wb + W_O; d.ldt = 1024; break;
    case 9: d.W = PIN(28) + (size_t)l * 1024 * FF; d.ldw = FF; d.K = 1024; d.N = FF; d.T = wb + W_GU; d.ldt = 1024; d.rowmode = 1; break;
    case 10: d.W = PIN(29) + (size_t)l * 1024 * FF; d.ldw = FF; d.K = 1024; d.N = FF; d.T = wb + W_GU; d.ldt = 1024; d.rowmode = 1; d.rowoff = 128; break;
    case 11: d.W = PIN(30) + (size_t)l * FF * 1024; d.ldw = 1024; d.K = FF; d.N = 1024; d.T = wb + W_D; d.ldt = FF; break;
    case 12: d.W = PIN(31) + (size_t)l * 256 * 1024; d.ldw = 1024; d.K = 256; d.N = 1024; d.T = wb + W_P; d.ldt = 256; break;
    default: d.W = PIN(33) + (size_t)l * 1024 * 1024; d.ldw = 1024; d.K = 1024; d.N = 1024; d.T = wb + W_PG; d.ldt = 1024; break;
    }
    return d;
}
__device__ __forceinline__ void convert_weights(const Params& P, int l, LAS unsigned char* lds) {
    const int tid = tid_opaque(), lane = tid & 63, wave = tid >> 6;
    LAS float* scr = (LAS float*)(lds + wave * 8704);
    const int gw = bid_opaque() * 8 + wave, NGW = gridDim.x * 8;
    for (int m = 0; m < 14; ++m) {
        const MatDesc d = get_mat(P, l, m);
        const int nblk = d.N / 32, nit = (d.K / 64) * nblk;
        for (int it = gw; it < nit; it += NGW) {
            const int kb = it / nblk, nb = it % nblk, k0 = 64 * kb, n0 = 32 * nb;
#pragma unroll 8
            for (int i = 0; i < 32; ++i) { const int kk = 2 * i + (lane >> 5); scr[kk * 33 + (lane & 31)] = d.W[(size_t)(k0 + kk) * d.ldw + d.col0 + n0 + (lane & 31)]; }
            LDSW();
            const int c = lane & 7;
#pragma unroll
            for (int j = 0; j < 4; ++j) { const int n = (lane >> 3) + 8 * j; const LAS float* s = scr + (8 * c) * 33 + n;
                u32x4 o; o.x = cvt_pk_bf16(s[0 * 33], s[1 * 33]); o.y = cvt_pk_bf16(s[2 * 33], s[3 * 33]); o.z = cvt_pk_bf16(s[4 * 33], s[5 * 33]); o.w = cvt_pk_bf16(s[6 * 33], s[7 * 33]);
                const int ng = n0 + n; const int drow = d.rowoff + (d.rowmode ? (256 * (ng >> 7) + (ng & 127)) : ng);
                *(u32x4*)(d.T + (size_t)drow * d.ldt + d.koff + k0 + 8 * c) = o; }
            LDSW();
        }
    }
    bf16_t* bd = (bf16_t*)(P.ws + WS_W) + W_BD;
    for (int e = bid_opaque() * 512 + tid; e < 1536 * 32; e += gridDim.x * 512) {
        const int row = e >> 5, k8 = (e & 31) * 8; const int blk = row >> 9;
        const bool diag = (blk == 0) ? (k8 < 64) : (blk == 1 ? (k8 >= 64 && k8 < 128) : (k8 >= 128));
        if (!diag) *(u32x4*)(bd + (size_t)row * 256 + k8) = (u32x4){0u, 0u, 0u, 0u};
    }
}

__device__ __forceinline__ void row_norm_pass(const Params& P, int l, int mode, int skip = 0) {
    const int tid_ = tid_opaque(); const int lane = tid_ & 63, wave = tid_ >> 6;
    const int bsk_ = bid_opaque() - skip; if (bsk_ < 0) return;
    const int gw = bsk_ * 8 + wave, NGW = ((int)gridDim.x - skip) * 8;
    const float* gain = (mode == 2 ? PIN(27) : PIN(9)) + (size_t)l * DM;
    bf16_t* dst = (bf16_t*)(P.ws + (mode == 2 ? WS_ZB : WS_XNB));
    f32x4 gv[4];
#pragma unroll
    for (int j = 0; j < 4; ++j) gv[j] = *((const f32x4*)gain + lane + 64 * j);
    for (int r = gw; r < T_ALL; r += NGW) {
        const float* src = (mode == 0 || (mode == 1 && l == 0)) ? (r < T_P ? PIN(0) + (size_t)r * DM : PIN(1) + (size_t)(r - T_P) * DM) : P.out + (size_t)r * DM;
        f32x4 v[4]; float s = 0.f;
#pragma unroll
        for (int j = 0; j < 4; ++j) { v[j] = *((const f32x4*)src + lane + 64 * j); s += v[j][0] * v[j][0] + v[j][1] * v[j][1] + v[j][2] * v[j][2] + v[j][3] * v[j][3]; }
        const float rs = rsqrtf(wave_sum(s) * (1.f / DM) + EPS);
#pragma unroll
        for (int j = 0; j < 4; ++j) {
            const f32x4 o = v[j] * rs * gv[j]; u32x2 w; w.x = cvt_pk_bf16(o[0], o[1]); w.y = cvt_pk_bf16(o[2], o[3]);
            *((u32x2*)(dst + (size_t)r * DM) + lane + 64 * j) = w; }
        if (mode == 2) {
            const float* pr = (r < T_P) ? PIN(2) + ((size_t)l * T_P + r) * 256 : PIN(3) + ((size_t)l * 1024 + (r - T_P)) * 256;
            const f32x4 pv = *((const f32x4*)pr + lane); u32x2 w; w.x = cvt_pk_bf16(pv[0], pv[1]); w.y = cvt_pk_bf16(pv[2], pv[3]);
            *((u32x2*)((bf16_t*)(P.ws + WS_LOB) + (size_t)r * 256) + lane) = w;
        }
    }
}
__device__ __forceinline__ void finish_pass(const Params& P, int l) {
    const int tid_ = tid_opaque(); const int lane = tid_ & 63, wave = tid_ >> 6;
    const int gw = bid_opaque() * 8 + wave, NGW = gridDim.x * 8;
    const float* gp = PIN(32) + (size_t)l * DM; const float* gn = PIN(9) + (size_t)(l < 1 ? l + 1 : l) * DM;
    bf16_t* GR = (bf16_t*)(P.ws + WS_ZB); bf16_t* EB = (bf16_t*)(P.ws + WS_XNB);
    for (int r = gw; r < T_ALL; r += NGW) {
        f32x4 x[4], gr[4], e[4]; float sx = 0.f, se = 0.f;
#pragma unroll
        for (int j = 0; j < 4; ++j) { x[j] = *((const f32x4*)(P.out + (size_t)r * DM) + lane + 64 * j);
            const u32x2 a = *((const u32x2*)(GR + (size_t)r * DM) + lane + 64 * j), b = *((const u32x2*)(EB + (size_t)r * DM) + lane + 64 * j);
            gr[j] = (f32x4){bflo(a.x), bfhi(a.x), bflo(a.y), bfhi(a.y)}; e[j] = (f32x4){bflo(b.x), bfhi(b.x), bflo(b.y), bfhi(b.y)};
#pragma unroll
            for (int k = 0; k < 4; ++k) { sx += x[j][k] * x[j][k]; se += e[j][k] * e[j][k]; } }
        const float rx = rsqrtf(wave_sum(sx) * (1.f / DM) + EPS), re = rsqrtf(wave_sum(se) * (1.f / DM) + EPS);
        float s2 = 0.f;
#pragma unroll
        for (int j = 0; j < 4; ++j) { const f32x4 g4 = *((const f32x4*)gp + lane + 64 * j);
#pragma unroll
            for (int k = 0; k < 4; ++k) { const float xn = x[j][k] + sigmoidf_(gr[j][k] * rx) * (e[j][k] * re * g4[k]); x[j][k] = xn; s2 += xn * xn; }
            *((f32x4*)(P.out + (size_t)r * DM) + lane + 64 * j) = x[j]; }
        if (l < 1) {
            const float r2 = rsqrtf(wave_sum(s2) * (1.f / DM) + EPS);
#pragma unroll
            for (int j = 0; j < 4; ++j) { const f32x4 g4 = *((const f32x4*)gn + lane + 64 * j); const f32x4 o = x[j] * r2 * g4; u32x2 w; w.x = cvt_pk_bf16(o[0], o[1]); w.y = cvt_pk_bf16(o[2], o[3]);
                *((u32x2*)(EB + (size_t)r * DM) + lane + 64 * j) = w; }
        }
    }
}

__device__ __forceinline__ void e1_phase(const Params& P, int l, LAS unsigned char* lds) {
    const int tid = tid_opaque(), tok = tid >> 3, sub = tid & 7, wave = tid >> 6, lane = tid & 63, fr = lane & 15, fq = lane >> 4;
    bf16_t* Z = (bf16_t*)(P.ws + WS_ZB);
    LAS bf16_t* L0 = (LAS bf16_t*)lds;
    LAS bf16_t* L1 = (LAS bf16_t*)(lds + 18432);
    for (int it = bid_opaque(); it < 528 * 7; it += gridDim.x) {
        const int tile = it / 7, job = it % 7, r0 = tile * 64, row = r0 + tok;
        const bool prompt = tile < 512; const int sr = row - T_P;
        bf16_t* zr = Z + (size_t)row * ZW;
        if (job < 2) {
            u32x4 rq[4], rk[4], rv[4];
#pragma unroll
            for (int q = 0; q < 4; ++q) { const int hc = (job * 4 + q) * 64 + sub * 8; rq[q] = *(const u32x4*)(zr + AQ + hc); rk[q] = *(const u32x4*)(zr + AK + hc); rv[q] = *(const u32x4*)(zr + AV + hc); }
            const float* gq = PIN(11) + l * 64 + sub * 8; const float* gk = PIN(12) + l * 64 + sub * 8;
#pragma unroll
            for (int q = 0; q < 4; ++q) { const int h = job * 4 + q; float f[8], o[8];
                unpack8(rq[q], f);
                float ss = 0.f;
#pragma unroll
                for (int e = 0; e < 8; ++e) ss += f[e] * f[e];
                float rs = rsqrtf(sum8(ss) * (1.f / 64.f) + EPS);
#pragma unroll
                for (int e = 0; e < 8; ++e) o[e] = f[e] * rs * gq[e];
                *(u32x4*)(zr + AQ + h * 64 + sub * 8) = pack8(o);
                unpack8(rk[q], f);
                ss = 0.f;
#pragma unroll
                for (int e = 0; e < 8; ++e) ss += f[e] * f[e];
                rs = rsqrtf(sum8(ss) * (1.f / 64.f) + EPS);
#pragma unroll
                for (int e = 0; e < 8; ++e) o[e] = f[e] * rs * gk[e];
                *(u32x4*)(zr + AK + h * 64 + sub * 8) = pack8(o);
                float vv[8]; const u32x4 vraw = rv[q]; unpack8(vraw, vv);
                float* ok = nullptr; float* ov = nullptr;
                if (prompt) { const int b = row >> 14, t = row & (SEQ - 1); if (t >= SEQ - 512) { const size_t o_ = (((size_t)(l * 2 + b) * 512 + (t - (SEQ - 512))) * 512 + h * 64 + sub * 8); ok = P.out + O_AKP + o_; ov = P.out + O_AVP + o_; } }
                else { const size_t o_ = ((size_t)(l * 1024 + sr) * 512 + h * 64 + sub * 8); ok = P.out + O_AKS + o_; ov = P.out + O_AVS + o_; }
                if (ok) { *(f32x4*)ok = (f32x4){o[0], o[1], o[2], o[3]}; *(f32x4*)(ok + 4) = (f32x4){o[4], o[5], o[6], o[7]};
                          *(f32x4*)ov = (f32x4){vv[0], vv[1], vv[2], vv[3]}; *(f32x4*)(ov + 4) = (f32x4){vv[4], vv[5], vv[6], vv[7]}; }
                if (prompt) {
#pragma unroll
                    for (int e = 0; e < 8; ++e) L0[q * 4608 + (sub * 8 + e) * 72 + tok] = ((const unsigned short*)&vraw)[e];
                } }
            if (prompt) {
                __syncthreads();
#pragma unroll
                for (int q = 0; q < 4; ++q) { const u32x4 w = *(const LAS u32x4*)(L0 + q * 4608 + tok * 72 + sub * 8);
                    *(u32x4*)(Z + (size_t)(r0 + tok) * ZW + AV + (job * 4 + q) * 64 + sub * 8) = w; }
                __syncthreads();
            }
        } else if (job < 6) {
            const int h = job - 2; const int pos = prompt ? (row & (SEQ - 1)) : (2048 + (sr & 31));
            float cs[8], sn[8];
#pragma unroll
            for (int e = 0; e < 8; ++e) { const float inv = __builtin_amdgcn_exp2f(-(float)(sub * 8 + e) * (13.287712379549449f / 64.f)); const float ang = (float)pos * inv;
                const float n = rintf(ang * 0.15915494309189535f); float rr = fmaf(-n, 6.2831855f, ang); rr = fmaf(-n, -1.7484555e-7f, rr); cs[e] = __cosf(rr); sn[e] = __sinf(rr); }
            float x1[8], x2[8], o1[8], o2[8];
            unpack8(*(const u32x4*)(zr + BQ + h * 128 + sub * 8), x1); unpack8(*(const u32x4*)(zr + BQ + h * 128 + 64 + sub * 8), x2);
#pragma unroll
            for (int e = 0; e < 8; ++e) { o1[e] = x1[e] * cs[e] - x2[e] * sn[e]; o2[e] = x1[e] * sn[e] + x2[e] * cs[e]; }
            *(u32x4*)(zr + BQ + h * 128 + sub * 8) = pack8(o1); *(u32x4*)(zr + BQ + h * 128 + 64 + sub * 8) = pack8(o2);
            unpack8(*(const u32x4*)(zr + BK + h * 128 + sub * 8), x1); unpack8(*(const u32x4*)(zr + BK + h * 128 + 64 + sub * 8), x2);
#pragma unroll
            for (int e = 0; e < 8; ++e) { o1[e] = (x1[e] * cs[e] - x2[e] * sn[e]) * 0.08838834764831845f; o2[e] = (x1[e] * sn[e] + x2[e] * cs[e]) * 0.08838834764831845f; }
            *(u32x4*)(zr + BK + h * 128 + sub * 8) = pack8(o1); *(u32x4*)(zr + BK + h * 128 + 64 + sub * 8) = pack8(o2);
            if (prompt) {
                const float dk = __builtin_amdgcn_exp2f(gamma_l2(h) * (float)(63 - tok));
                const u32x4 va = *(const u32x4*)(zr + BV + h * 128 + sub * 8), vb = *(const u32x4*)(zr + BV + h * 128 + 64 + sub * 8);
#pragma unroll
                for (int e = 0; e < 8; ++e) { L0[(sub * 8 + e) * 72 + tok] = f2bf(o1[e] * dk); L0[(64 + sub * 8 + e) * 72 + tok] = f2bf(o2[e] * dk);
                    L1[(sub * 8 + e) * 72 + tok] = ((const unsigned short*)&va)[e]; L1[(64 + sub * 8 + e) * 72 + tok] = ((const unsigned short*)&vb)[e]; }
                __syncthreads();
                const int b = row >> 14, c = (r0 & (SEQ - 1)) >> 6;
                bf16_t* St = (bf16_t*)(P.ws + WS_XNB) + ((size_t)((b * 4 + h) * 256 + c)) * 16384;
                const bf16x8 vb0 = *(const LAS bf16x8*)(L1 + (16 * wave + fr) * 72 + 8 * fq), vb1 = *(const LAS bf16x8*)(L1 + (16 * wave + fr) * 72 + 32 + 8 * fq);
#pragma unroll
                for (int dkt = 0; dkt < 8; ++dkt) {
                    const bf16x8 ka0 = *(const LAS bf16x8*)(L0 + (16 * dkt + fr) * 72 + 8 * fq), ka1 = *(const LAS bf16x8*)(L0 + (16 * dkt + fr) * 72 + 32 + 8 * fq);
                    f32x4 a = (f32x4){0.f, 0.f, 0.f, 0.f};
                    a = __builtin_amdgcn_mfma_f32_16x16x32_bf16(ka0, vb0, a, 0, 0, 0); a = __builtin_amdgcn_mfma_f32_16x16x32_bf16(ka1, vb1, a, 0, 0, 0);
                    u32x2 w; w.x = cvt_pk_bf16(a[0], a[1]); w.y = cvt_pk_bf16(a[2], a[3]);
                    *(u32x2*)(St + (size_t)(16 * wave + fr) * 128 + 16 * dkt + 4 * fq) = w;
                }
#pragma unroll
                for (int q = 0; q < 2; ++q) { const int idx = tid + q * 512, i = idx >> 4, hh = (idx >> 3) & 1, pc = idx & 7;
                    const u32x4 w = *(const LAS u32x4*)(L1 + (64 * hh + i) * 72 + pc * 8);
                    *(u32x4*)(Z + (size_t)(r0 + i) * ZW + BV + h * 128 + hh * 64 + pc * 8) = w; }
                __syncthreads();
            }
        } else {
            bool first; const float* sh = nullptr;
            if (prompt) first = (row & (SEQ - 1)) == 0; else { first = (sr & 31) == 0; sh = PIN(8) + ((size_t)l * 32 + (sr >> 5)) * 1792; }
            const float* mu = PIN(14) + (size_t)l * 1792;
            bf16_t* LO = (bf16_t*)(P.ws + WS_LOB) + (size_t)row * 256;
#pragma unroll
            for (int ch = 0; ch < 4; ++ch) { const int lc = sub * 32 + ch * 8, cp = 1536 + lc; float cur[8], prv[8], o[8];
                unpack8(*(const u32x4*)(zr + CLO + lc), cur);
                if (!first) unpack8(*(const u32x4*)(zr - ZW + CLO + lc), prv);
                else {
#pragma unroll
                    for (int e = 0; e < 8; ++e) prv[e] = sh ? sh[cp + e] : 0.f; }
#pragma unroll
                for (int e = 0; e < 8; ++e) { const float c_ = cur[e] + (prv[e] - cur[e]) * mu[cp + e];
                    o[e] = (lc < 64) ? (1.f - 2.f * __builtin_amdgcn_rcpf(__expf(2.f * c_) + 1.f)) : (lc < 128 ? c_ : sigmoidf_(c_)); }
                *(u32x4*)(LO + lc) = pack8(o); }
            bool lastt; float* so;
            if (prompt) { lastt = (row & (SEQ - 1)) == SEQ - 1; so = P.out + O_SHP + (size_t)(l * 2 + (row >> 14)) * 1792; }
            else { lastt = (sr & 31) == 31; so = P.out + O_SHS + (size_t)(l * 32 + (sr >> 5)) * 1792; }
            if (lastt) { for (int q = 0; q < 28; ++q) { const int c0 = (sub * 28 + q) * 8; float f[8]; unpack8(*(const u32x4*)(zr + CR + c0), f);
                    *(f32x4*)(so + c0) = (f32x4){f[0], f[1], f[2], f[3]}; *(f32x4*)(so + c0 + 4) = (f32x4){f[4], f[5], f[6], f[7]}; } }
            if (tid < 192) *(u32x4*)((bf16_t*)(P.ws + WS_CZB) + (size_t)tile * 1536 + tid * 8) = *(const u32x4*)(Z + (size_t)(r0 + 63) * ZW + CR + tid * 8);
        }
    }
}

__device__ __forceinline__ void p2_phase(const Params& P, int l, LAS unsigned char* lds) {
    bf16_t* Z = (bf16_t*)(P.ws + WS_ZB);
    for (int it = bid_opaque(); it < 64 + 128; it += gridDim.x) {
        const int tid = tid_opaque(), lane = tid & 63, wave = tid >> 6;
#ifdef DBG_P2_SKIP_SAMPLE
        if (it >= 64) continue;
#endif
        if (it < 64) {
            const int e4 = it * 512 + tid, chain = e4 >> 12, idx = (e4 & 4095) * 4, h = chain & 3, b = chain >> 2;
            const float g64 = __builtin_amdgcn_exp2f(gamma_l2(h) * 64.f);
            bf16_t* St = (bf16_t*)(P.ws + WS_XNB) + (size_t)chain * 256 * 16384 + idx;
            float s0 = 0.f, s1 = 0.f, s2 = 0.f, s3 = 0.f;
#pragma unroll 16
            for (int c = 0; c < 256; ++c) { const u32x2 d = *(const u32x2*)(St + (size_t)c * 16384);
                s0 = s0 * g64 + bflo(d.x); s1 = s1 * g64 + bfhi(d.x); s2 = s2 * g64 + bflo(d.y); s3 = s3 * g64 + bfhi(d.y);
                u32x2 w; w.x = cvt_pk_bf16(s0, s1); w.y = cvt_pk_bf16(s2, s3); *(u32x2*)(St + (size_t)c * 16384) = w; }
            const int dv = idx >> 7, dk = idx & 127; float* o = P.out + O_RETP + ((size_t)((l * 2 + b) * 4 + h)) * 16384 + dv;
            o[(size_t)dk * 128] = s0; o[(size_t)(dk + 1) * 128] = s1; o[(size_t)(dk + 2) * 128] = s2; o[(size_t)(dk + 3) * 128] = s3;
        } else if (it < 192) {
            const int si = it - 64, s = si >> 2, h = si & 3, rb = T_P + s * 32;
            LAS float* q = (LAS float*)lds; LAS float* k = q + 4096; LAS float* v = k + 4096; LAS float* A = v + 4096; LAS float* ob = A + 1024;
            const float lg = gamma_l2(h);
            { const int n = tid >> 4, sg = tid & 15; const bf16_t* zr = Z + (size_t)(rb + n) * ZW + h * 128 + sg * 8; float f[8];
              const u32x4 wq = *(const u32x4*)(zr + BQ), wk = *(const u32x4*)(zr + BK), wv = *(const u32x4*)(zr + BV);
              unpack8(wq, f); *(LAS f32x4*)(q + n * 128 + sg * 8) = (f32x4){f[0], f[1], f[2], f[3]}; *(LAS f32x4*)(q + n * 128 + sg * 8 + 4) = (f32x4){f[4], f[5], f[6], f[7]};
              unpack8(wk, f); *(LAS f32x4*)(k + n * 128 + sg * 8) = (f32x4){f[0], f[1], f[2], f[3]}; *(LAS f32x4*)(k + n * 128 + sg * 8 + 4) = (f32x4){f[4], f[5], f[6], f[7]};
              unpack8(wv, f); *(LAS f32x4*)(v + n * 128 + sg * 8) = (f32x4){f[0], f[1], f[2], f[3]}; *(LAS f32x4*)(v + n * 128 + sg * 8 + 4) = (f32x4){f[4], f[5], f[6], f[7]}; }
            __syncthreads();
            for (int e = tid; e < 1024; e += 512) { const int n = e >> 5, m = e & 31; float a = 0.f;
                if (m <= n) {
#pragma unroll 8
                    for (int d = 0; d < 128; d += 4) { const f32x4 q4 = *(const LAS f32x4*)(q + n * 128 + d), k4 = *(const LAS f32x4*)(k + m * 128 + d); a += q4[0] * k4[0] + q4[1] * k4[1] + q4[2] * k4[2] + q4[3] * k4[3]; }
                    a *= __builtin_amdgcn_exp2f(lg * (float)(n - m)); }
                A[e] = a; }
            __syncthreads();
            const float* S0 = PIN(6) + ((size_t)((l * 32 + s) * 4 + h)) * 16384;
            { const int e = tid & 127, ng = tid >> 7; float acc[8];
#pragma unroll
              for (int i = 0; i < 8; ++i) acc[i] = 0.f;
#pragma unroll 4
              for (int d = 0; d < 128; d += 4) { const float s0 = S0[(size_t)d * 128 + e], s1 = S0[(size_t)(d + 1) * 128 + e], s2 = S0[(size_t)(d + 2) * 128 + e], s3 = S0[(size_t)(d + 3) * 128 + e];
#pragma unroll
                  for (int i = 0; i < 8; ++i) { const f32x4 q4 = *(const LAS f32x4*)(q + (ng * 8 + i) * 128 + d); acc[i] += q4[0] * s0 + q4[1] * s1 + q4[2] * s2 + q4[3] * s3; } }
#pragma unroll
              for (int i = 0; i < 8; ++i) { const int n = ng * 8 + i; float a = acc[i] * __builtin_amdgcn_exp2f(lg * (float)(n + 1));
                  for (int m = 0; m <= n; ++m) a += A[n * 32 + m] * v[m * 128 + e];
                  ob[n * 128 + e] = a; }
              const int dg = tid >> 7; float* so = P.out + O_RETS + ((size_t)((l * 32 + s) * 4 + h)) * 16384; const float g32 = __builtin_amdgcn_exp2f(lg * 32.f);
              float vd[32];
#pragma unroll
              for (int m = 0; m < 32; ++m) vd[m] = v[m * 128 + e] * __builtin_amdgcn_exp2f(lg * (float)(31 - m));
#pragma unroll 2
              for (int d = dg * 32; d < dg * 32 + 32; d += 4) { float a0 = g32 * S0[(size_t)d * 128 + e], a1 = g32 * S0[(size_t)(d + 1) * 128 + e], a2 = g32 * S0[(size_t)(d + 2) * 128 + e], a3 = g32 * S0[(size_t)(d + 3) * 128 + e];
#pragma unroll
                  for (int m = 0; m < 32; ++m) { const f32x4 k4 = *(const LAS f32x4*)(k + m * 128 + d); a0 += k4[0] * vd[m]; a1 += k4[1] * vd[m]; a2 += k4[2] * vd[m]; a3 += k4[3] * vd[m]; }
                  so[(size_t)d * 128 + e] = a0; so[(size_t)(d + 1) * 128 + e] = a1; so[(size_t)(d + 2) * 128 + e] = a2; so[(size_t)(d + 3) * 128 + e] = a3; }
            }
            __syncthreads();
            { const int e = tid & 127, ng = tid >> 7;
              for (int i = 0; i < 8; ++i) { const int n = ng * 8 + i; float ss = 0.f;
#pragma unroll 8
                  for (int d = 0; d < 128; d += 4) { const f32x4 o4 = *(const LAS f32x4*)(ob + n * 128 + d); ss += o4[0] * o4[0] + o4[1] * o4[1] + o4[2] * o4[2] + o4[3] * o4[3]; }
                  const float rs = rsqrtf(ss * (1.f / 128.f) + EPS); bf16_t* zr = Z + (size_t)(rb + n) * ZW + h * 128 + e; const float gt = bf2f(zr[BG]);
                  zr[BQ] = f2bf(ob[n * 128 + e] * rs * gt * sigmoidf_(gt)); } }
            __syncthreads();
        }
    }
}

__device__ __forceinline__ void sattn_item(const Params& P, int l, LAS unsigned char* lds, int si, int tid_in) {
    int tid = tid_in; asm volatile("" : "+v"(tid));
    const int lane = tid & 63, wave = tid >> 6;
    bf16_t* Z = (bf16_t*)(P.ws + WS_ZB);
    {
            const int s = si >> 4, h = (si >> 1) & 7, qh = si & 1, rb = T_P + s * 32, rq = rb + qh * 16;
            LAS float* q = (LAS float*)lds; LAS float* sc = q + 1024; LAS float* red = sc + 16 * 544;
            const float* ck = PIN(4) + ((size_t)(l * 32 + s) * 512) * 512 + h * 64; const float* cv = PIN(5) + ((size_t)(l * 32 + s) * 512) * 512 + h * 64;
            const float* bias = PIN(13) + (size_t)(l * 8 + h) * 320;
            for (int e = tid; e < 1024; e += 512) q[e] = bf2f(Z[(size_t)(rq + (e >> 6)) * ZW + AQ + h * 64 + (e & 63)]);
            __syncthreads();
            { const int key = tid; float kr[64];
#pragma unroll
                for (int d4 = 0; d4 < 16; ++d4) { const f32x4 t = *(const f32x4*)(ck + (size_t)key * 512 + d4 * 4); kr[d4 * 4] = t[0]; kr[d4 * 4 + 1] = t[1]; kr[d4 * 4 + 2] = t[2]; kr[d4 * 4 + 3] = t[3]; }
                for (int n = 0; n < 16; ++n) { float a = 0.f;
#pragma unroll
                    for (int d = 0; d < 64; ++d) a += q[n * 64 + d] * kr[d];
                    int rel = (512 + qh * 16 + n) - key; rel = rel > 256 ? 256 : rel;
                    sc[n * 544 + key] = a * 0.125f + bias[rel + 63]; } }
            { const int key = 512 + (tid & 31), n = tid >> 5; float kr[64];
#pragma unroll
                for (int d8 = 0; d8 < 8; ++d8) unpack8(*(const u32x4*)(Z + (size_t)(rb + key - 512) * ZW + AK + h * 64 + d8 * 8), kr + d8 * 8);
                float a = 0.f;
#pragma unroll
                for (int d = 0; d < 64; ++d) a += q[n * 64 + d] * kr[d];
                const int rel = (512 + qh * 16 + n) - key;
                sc[n * 544 + key] = a * 0.125f + bias[rel + 63]; }
            __syncthreads();
            for (int n = wave * 2; n < wave * 2 + 2; ++n) { float mx = -1e30f;
                for (int kx = lane; kx < 544; kx += 64) mx = fmaxf(mx, sc[n * 544 + kx]);
#pragma unroll
                for (int o = 1; o < 64; o <<= 1) mx = fmaxf(mx, __shfl_xor(mx, o));
                float sm = 0.f;
                for (int kx = lane; kx < 544; kx += 64) { const float p = __expf(sc[n * 544 + kx] - mx); sc[n * 544 + kx] = p; sm += p; }
                sm = wave_sum(sm); const float inv = 1.f / sm;
                for (int kx = lane; kx < 544; kx += 64) sc[n * 544 + kx] *= inv; }
            __syncthreads();
            { const int d = tid & 63, kg = tid >> 6; float a[16];
#pragma unroll
              for (int n = 0; n < 16; ++n) a[n] = 0.f;
              float vv[68];
#pragma unroll
              for (int i = 0; i < 68; ++i) { const int key = kg * 68 + i; vv[i] = key < 512 ? cv[(size_t)key * 512 + d] : bf2f(Z[(size_t)(rb + key - 512) * ZW + AV + h * 64 + d]); }
#pragma unroll
              for (int i = 0; i < 68; i += 4)
#pragma unroll
                  for (int n = 0; n < 16; ++n) { const f32x4 p4 = *(const LAS f32x4*)(sc + n * 544 + kg * 68 + i); a[n] += p4[0] * vv[i] + p4[1] * vv[i + 1] + p4[2] * vv[i + 2] + p4[3] * vv[i + 3]; }
#pragma unroll
              for (int n = 0; n < 16; ++n) red[(kg * 16 + n) * 64 + d] = a[n]; }
            __syncthreads();
            for (int e = tid; e < 1024; e += 512) { const int n = e >> 6, d = e & 63; float a = 0.f;
#pragma unroll
                for (int kg = 0; kg < 8; ++kg) a += red[(kg * 16 + n) * 64 + d];
                Z[(size_t)(rq + n) * ZW + AQ + h * 64 + d] = f2bf(a); }
            __syncthreads();
    }
}

__device__ __forceinline__ void p3_phase(const Params& P, int l, LAS unsigned char* lds) {
    const int tid = tid_opaque(), lane = tid & 63, wave = tid >> 6, fr = lane & 15, fq = lane >> 4;
    bf16_t* Z = (bf16_t*)(P.ws + WS_ZB);
    {
        const int qs = wave & 3, dh = wave >> 2;
        LAS bf16_t* SL = (LAS bf16_t*)lds;
        LAS bf16_t* KL = (LAS bf16_t*)(lds + 34816);
        LAS bf16_t* VL = (LAS bf16_t*)(lds + 52224);
        LAS float* XL = (LAS float*)(lds + 70656);
        u32x4 gs[4], gk[2], gv[2];
#define RT_LOAD(it_) do { const int h_ = (it_) & 3, c_ = ((it_) >> 2) & 255, b_ = (it_) >> 10; const size_t cb_ = (size_t)(b_ * SEQ + c_ * 64); \
        const bf16_t* St_ = (const bf16_t*)(P.ws + WS_XNB) + ((size_t)((b_ * 4 + h_) * 256 + (c_ > 0 ? c_ - 1 : 0))) * 16384; \
        _Pragma("unroll") for (int i_ = 0; i_ < 4; ++i_) { const int p_ = tid + 512 * i_; gs[i_] = *(const u32x4*)(St_ + (p_ >> 4) * 128 + (p_ & 15) * 8); } \
        _Pragma("unroll") for (int i_ = 0; i_ < 2; ++i_) { const int p_ = tid + 512 * i_, r_ = p_ >> 4, sg_ = p_ & 15; gk[i_] = *(const u32x4*)(Z + (cb_ + r_) * ZW + BK + h_ * 128 + sg_ * 8); gv[i_] = *(const u32x4*)(Z + (cb_ + r_) * ZW + BV + h_ * 128 + sg_ * 8); } } while (0)
#define RT_WRITE() do { _Pragma("unroll") for (int i_ = 0; i_ < 4; ++i_) { const int p_ = tid + 512 * i_; *(LAS u32x4*)(SL + (p_ >> 4) * 136 + (p_ & 15) * 8) = gs[i_]; } \
        _Pragma("unroll") for (int i_ = 0; i_ < 2; ++i_) { const int p_ = tid + 512 * i_, r_ = p_ >> 4, sg_ = p_ & 15; *(LAS u32x4*)(KL + r_ * 136 + sg_ * 8) = gk[i_]; *(LAS u32x4*)(VL + ((sg_ >> 3) * 64 + r_) * 72 + (sg_ & 7) * 8) = gv[i_]; } } while (0)
        int it = bid_opaque();
        if (it < 2048) RT_LOAD(it);
        for (; it < 2048; it += gridDim.x) {
            const int h = it & 3, c = (it >> 2) & 255, b = it >> 10;
            const int cb = b * SEQ + c * 64, qrow = cb + qs * 16 + fr; const float lg = gamma_l2(h);
            bf16x8 qf[4];
#pragma unroll
            for (int kk = 0; kk < 4; ++kk) qf[kk] = *(const bf16x8*)(Z + (size_t)qrow * ZW + BQ + h * 128 + 32 * kk + 8 * fq);
            RT_WRITE();
            __syncthreads();
            if (it + (int)gridDim.x < 2048) RT_LOAD(it + (int)gridDim.x);
            f32x4 acc[4];
#pragma unroll
            for (int dt = 0; dt < 4; ++dt) acc[dt] = (f32x4){0.f, 0.f, 0.f, 0.f};
            if (c > 0) {
#pragma unroll
                for (int dt = 0; dt < 4; ++dt)
#pragma unroll
                    for (int kk = 0; kk < 4; ++kk) acc[dt] = __builtin_amdgcn_mfma_f32_16x16x32_bf16(*(const LAS bf16x8*)(SL + (16 * (4 * dh + dt) + fr) * 136 + 32 * kk + 8 * fq), qf[kk], acc[dt], 0, 0, 0);
                const float dq = __builtin_amdgcn_exp2f(lg * (float)(qs * 16 + fr + 1));
#pragma unroll
                for (int dt = 0; dt < 4; ++dt) acc[dt] = acc[dt] * dq;
            }
            const int nu = (qs >> 1) + 1;
            for (int u = 0; u < nu; ++u) {
                unsigned pw[4];
#pragma unroll
                for (int t = 0; t < 2; ++t) { f32x4 sc_ = (f32x4){0.f, 0.f, 0.f, 0.f};
#pragma unroll
                    for (int kk = 0; kk < 4; ++kk) sc_ = __builtin_amdgcn_mfma_f32_16x16x32_bf16(*(const LAS bf16x8*)(KL + (32 * u + 16 * t + fr) * 136 + 32 * kk + 8 * fq), qf[kk], sc_, 0, 0, 0);
                    float pv[4];
#pragma unroll
                    for (int j = 0; j < 4; ++j) { const int n = qs * 16 + fr, m = 32 * u + 16 * t + 4 * fq + j; pv[j] = (m <= n) ? sc_[j] * __builtin_amdgcn_exp2f(lg * (float)(n - m)) : 0.f; }
                    pw[t * 2] = cvt_pk_bf16(pv[0], pv[1]); pw[t * 2 + 1] = cvt_pk_bf16(pv[2], pv[3]); }
                u32x4 w4; w4.x = pw[0]; w4.y = pw[1]; w4.z = pw[2]; w4.w = pw[3]; const bf16x8 pf = __builtin_bit_cast(bf16x8, w4);
#pragma unroll
                for (int dt = 0; dt < 4; ++dt) { const LAS bf16_t* vp = VL + (16 * (4 * dh + dt) + fr) * 72 + 32 * u + 4 * fq;
                    const u32x2 v0 = *(const LAS u32x2*)vp, v1 = *(const LAS u32x2*)(vp + 16); u32x4 w; w.x = v0.x; w.y = v0.y; w.z = v1.x; w.w = v1.y;
                    acc[dt] = __builtin_amdgcn_mfma_f32_16x16x32_bf16(__builtin_bit_cast(bf16x8, w), pf, acc[dt], 0, 0, 0); }
            }
            float ss = 0.f;
#pragma unroll
            for (int dt = 0; dt < 4; ++dt) ss += acc[dt][0] * acc[dt][0] + acc[dt][1] * acc[dt][1] + acc[dt][2] * acc[dt][2] + acc[dt][3] * acc[dt][3];
            ss += __shfl_xor(ss, 16); ss += __shfl_xor(ss, 32);
            if (fq == 0) XL[(qs * 2 + dh) * 16 + fr] = ss;
            __syncthreads();
            const float rs = rsqrtf((XL[(qs * 2) * 16 + fr] + XL[(qs * 2 + 1) * 16 + fr]) * (1.f / 128.f) + EPS);
#pragma unroll
            for (int dt = 0; dt < 4; ++dt) { const int dvc = 16 * (4 * dh + dt) + 4 * fq; const u32x2 gw = *(const u32x2*)(Z + (size_t)qrow * ZW + BG + h * 128 + dvc);
                const float g0 = bflo(gw.x), g1 = bfhi(gw.x), g2 = bflo(gw.y), g3 = bfhi(gw.y); u32x2 w;
                w.x = cvt_pk_bf16(acc[dt][0] * rs * g0 * sigmoidf_(g0), acc[dt][1] * rs * g1 * sigmoidf_(g1)); w.y = cvt_pk_bf16(acc[dt][2] * rs * g2 * sigmoidf_(g2), acc[dt][3] * rs * g3 * sigmoidf_(g3));
                *(u32x2*)(Z + (size_t)qrow * ZW + BQ + h * 128 + dvc) = w; }
        }
        __syncthreads();
    }
}

__device__ __forceinline__ void attn_item(const Params& P, int l, LAS unsigned char* lds, int it, int tid) {
    const int lane = tid & 63, wave = tid >> 6, fr = lane & 15, fq = lane >> 4;
    bf16_t* Z = (bf16_t*)(P.ws + WS_ZB);
    {

            const int ia = it - 1024, hp = ia & 3, c = (ia >> 2) & 255, b = ia >> 10, hsel = wave >> 2, h = hp * 2 + hsel, qs = wave & 3;
            const int sb = b * SEQ, qpos = c * 64 + qs * 16 + fr; const size_t qrow = (size_t)(sb + qpos);
            LAS bf16_t* KS = (LAS bf16_t*)lds;
            LAS bf16_t* VS = (LAS bf16_t*)(lds + 36864);
            LAS float* BL = (LAS float*)(lds + 73728);
            const bf16x8 q0 = *(const bf16x8*)(Z + qrow * ZW + AQ + h * 64 + 8 * fq), q1 = *(const bf16x8*)(Z + qrow * ZW + AQ + h * 64 + 32 + 8 * fq);
            f32x4 acc[4];
#pragma unroll
            for (int dt = 0; dt < 4; ++dt) acc[dt] = (f32x4){0.f, 0.f, 0.f, 0.f};
            float mrun = -1e30f, lrun = 0.f;
            const int jlo = c >= 8 ? 0 : 8 - c;
            u32x4 gk[2], gv[2];
#define AT_LOAD(j_) do { const size_t rb_ = (size_t)(sb + (c - 8 + (j_)) * 64); _Pragma("unroll") for (int i_ = 0; i_ < 2; ++i_) { const int p_ = tid + 512 * i_, hd_ = p_ >> 9, r_ = (p_ >> 3) & 63, sg_ = p_ & 7; \
        gk[i_] = *(const u32x4*)(Z + (rb_ + r_) * ZW + AK + (hp * 2 + hd_) * 64 + sg_ * 8); gv[i_] = *(const u32x4*)(Z + (rb_ + r_) * ZW + AV + (hp * 2 + hd_) * 64 + sg_ * 8); } } while (0)
#define AT_WRITE(st_) do { _Pragma("unroll") for (int i_ = 0; i_ < 2; ++i_) { const int p_ = tid + 512 * i_, hd_ = p_ >> 9, r_ = (p_ >> 3) & 63, sg_ = p_ & 7; \
        *(LAS u32x4*)(KS + ((st_) * 2 + hd_) * 4608 + r_ * 72 + sg_ * 8) = gk[i_]; *(LAS u32x4*)(VS + ((st_) * 2 + hd_) * 4608 + r_ * 72 + sg_ * 8) = gv[i_]; } } while (0)
            AT_LOAD(jlo);
            for (int e = tid; e < 640; e += 512) BL[e] = PIN(13)[(size_t)(l * 8 + hp * 2) * 320 + e] * 1.4426950408889634f;
            AT_WRITE(0);
            __syncthreads();
            for (int j = jlo; j < 9; ++j) {
                const int st = (j - jlo) & 1;
                if (j < 8) AT_LOAD(j + 1);
                const LAS bf16_t* ks = KS + (st * 2 + hsel) * 4608; const LAS bf16_t* vs = VS + (st * 2 + hsel) * 4608; const LAS float* bl = BL + hsel * 320;
#pragma unroll
                for (int u = 0; u < 2; ++u) {
                    const int kb = (c - 8 + j) * 64 + 32 * u;
                    float sv[8];
#pragma unroll
                    for (int t = 0; t < 2; ++t) { const LAS bf16_t* kp = ks + (32 * u + 16 * t + fr) * 72 + 8 * fq;
                        f32x4 sc_ = (f32x4){0.f, 0.f, 0.f, 0.f};
                        sc_ = __builtin_amdgcn_mfma_f32_16x16x32_bf16(*(const LAS bf16x8*)kp, q0, sc_, 0, 0, 0); sc_ = __builtin_amdgcn_mfma_f32_16x16x32_bf16(*(const LAS bf16x8*)(kp + 32), q1, sc_, 0, 0, 0);
                        if (j <= 3) {
                            const float bc = bl[319];
#pragma unroll
                            for (int jj = 0; jj < 4; ++jj) sv[t * 4 + jj] = sc_[jj] * 0.18033688011112042f + bc;
                        } else {
#pragma unroll
                            for (int jj = 0; jj < 4; ++jj) { int rel = qpos - (kb + 16 * t + 4 * fq + jj); rel = rel > 256 ? 256 : rel; sv[t * 4 + jj] = sc_[jj] * 0.18033688011112042f + bl[rel + 63]; }
                        } }
                    float mx = sv[0];
#pragma unroll
                    for (int e = 1; e < 8; ++e) mx = fmaxf(mx, sv[e]);
                    mx = fmaxf(mx, __shfl_xor(mx, 16)); mx = fmaxf(mx, __shfl_xor(mx, 32));
                    const float mnew = fmaxf(mrun, mx), alpha = __builtin_amdgcn_exp2f(mrun - mnew); mrun = mnew;
                    float ps = 0.f;
#pragma unroll
                    for (int e = 0; e < 8; ++e) { sv[e] = __builtin_amdgcn_exp2f(sv[e] - mnew); ps += sv[e]; }
                    lrun = lrun * alpha + ps;
                    u32x4 pw; pw.x = cvt_pk_bf16(sv[0], sv[1]); pw.y = cvt_pk_bf16(sv[2], sv[3]); pw.z = cvt_pk_bf16(sv[4], sv[5]); pw.w = cvt_pk_bf16(sv[6], sv[7]);
                    const bf16x8 pf = __builtin_bit_cast(bf16x8, pw);
#pragma unroll
                    for (int dt = 0; dt < 4; ++dt) { const LAS bf16_t* vp = vs + (16 * dt + fr) * 72 + 32 * u + 4 * fq;
                        const u32x2 v0 = *(const LAS u32x2*)vp, v1 = *(const LAS u32x2*)(vp + 16); u32x4 w; w.x = v0.x; w.y = v0.y; w.z = v1.x; w.w = v1.y;
                        acc[dt] = acc[dt] * alpha;
                        acc[dt] = __builtin_amdgcn_mfma_f32_16x16x32_bf16(__builtin_bit_cast(bf16x8, w), pf, acc[dt], 0, 0, 0); }
                }
                if (j < 8) AT_WRITE(st ^ 1);
                __syncthreads();
            }
            lrun += __shfl_xor(lrun, 16); lrun += __shfl_xor(lrun, 32);
            const float inv = 1.f / lrun;
#pragma unroll
            for (int dt = 0; dt < 4; ++dt) { u32x2 w; w.x = cvt_pk_bf16(acc[dt][0] * inv, acc[dt][1] * inv); w.y = cvt_pk_bf16(acc[dt][2] * inv, acc[dt][3] * inv);
                *(u32x2*)(Z + qrow * ZW + AQ + h * 64 + 16 * dt + 4 * fq) = w; }
    }
}

__device__ __forceinline__ void c2_phase(const Params& P, int l, LAS unsigned char* lds) {
    const int tid = tid_opaque(), tok = tid >> 3, sub = tid & 7;
    bf16_t* Z = (bf16_t*)(P.ws + WS_ZB); bf16_t* XW = (bf16_t*)(P.ws + WS_XNB);
    (void)lds;
    for (int it = bid_opaque(); it < 528 * 4; it += gridDim.x) {
        const int tile = it >> 2, hp = it & 3, r0 = tile * 64, row = r0 + tok; const bool prompt = tile < 512; const int sr = row - T_P;
        const bool sfirst = !prompt && (sr & 31) == 0; const float* sh = sfirst ? PIN(8) + ((size_t)l * 32 + (sr >> 5)) * 1792 : nullptr;
        const bool pzero = prompt && tok == 0 && (r0 & (SEQ - 1)) == 0;
        const bf16_t* prow = (tok > 0) ? Z + (size_t)(row - 1) * ZW + CR : (const bf16_t*)(P.ws + WS_CZB) + (size_t)(tile > 0 ? tile - 1 : 0) * 1536;
        u32x4 cu[2][3], pv_[2][3], wa[2][2];
#pragma unroll
        for (int q = 0; q < 2; ++q) { const int hc = (hp * 2 + q) * 64 + sub * 8;
#pragma unroll
            for (int part = 0; part < 3; ++part) { cu[q][part] = *(const u32x4*)(Z + (size_t)row * ZW + CR + part * 512 + hc); pv_[q][part] = *(const u32x4*)(prow + part * 512 + hc); }
            wa[q][0] = *(const u32x4*)(XW + (size_t)row * DM + hc); wa[q][1] = *(const u32x4*)(XW + (size_t)row * DM + 512 + hc); }
        asm volatile("s_waitcnt vmcnt(0)" ::: "memory");
        __syncthreads();
        const float* mu = PIN(14) + (size_t)l * 1792;
#pragma unroll
        for (int q = 0; q < 2; ++q) { const int h = hp * 2 + q, hc = h * 64 + sub * 8;
            float r[8], k[8], v[8], wr_[8], ar_[8], kk[8], pr[8], pk[8], pvv[8];
            unpack8(cu[q][0], r); unpack8(cu[q][1], k); unpack8(cu[q][2], v); unpack8(pv_[q][0], pr); unpack8(pv_[q][1], pk); unpack8(pv_[q][2], pvv); unpack8(wa[q][0], wr_); unpack8(wa[q][1], ar_);
#pragma unroll
            for (int e = 0; e < 8; ++e) { float a_ = pr[e], b_ = pk[e], c_ = pvv[e];
                if (sfirst) { a_ = sh[hc + e]; b_ = sh[512 + hc + e]; c_ = sh[1024 + hc + e]; } else if (pzero) { a_ = 0.f; b_ = 0.f; c_ = 0.f; }
                r[e] = r[e] + (a_ - r[e]) * mu[hc + e]; k[e] = k[e] + (b_ - k[e]) * mu[512 + hc + e]; v[e] = v[e] + (c_ - v[e]) * mu[1024 + hc + e]; }
            const float* w0 = PIN(15) + l * 512 + hc; const float* a0 = PIN(17) + l * 512 + hc; const float* kkw = PIN(20) + l * 512 + hc; const float* kaw = PIN(21) + l * 512 + hc; const float* rk = PIN(22) + l * 512 + hc;
            float ss = 0.f, bn = 0.f;
#pragma unroll
            for (int e = 0; e < 8; ++e) { kk[e] = k[e] * kkw[e]; ss += kk[e] * kk[e]; }
            const float rn = rsqrtf(fmaxf(sum8(ss), 1e-24f));
#pragma unroll
            for (int e = 0; e < 8; ++e) { const float a = sigmoidf_(a0[e] + ar_[e]); const float ew = 0.6065306597126334f * sigmoidf_(w0[e] + wr_[e]);
                kk[e] *= rn; k[e] = k[e] * (1.f + (a - 1.f) * kaw[e]); bn += r[e] * k[e] * rk[e]; wr_[e] = ew; ar_[e] = kk[e] * a; }
            bn = sum8(bn);
            *(u32x4*)(Z + (size_t)row * ZW + CR + hc) = pack8(r); *(u32x4*)(Z + (size_t)row * ZW + CK + hc) = pack8(k); *(u32x4*)(Z + (size_t)row * ZW + CV + hc) = pack8(v);
            *(u32x4*)(Z + (size_t)row * ZW + BV + hc) = pack8(kk); *(u32x4*)(XW + (size_t)row * DM + hc) = pack8(wr_); *(u32x4*)(XW + (size_t)row * DM + 512 + hc) = pack8(ar_);
            if (sub == 0) ((float*)(P.ws + WS_BONUS))[(size_t)row * 8 + h] = bn; }
        __syncthreads();
    }
}

__device__ __forceinline__ void scan_phase(const Params& P, int l, LAS unsigned char* lds) {
    const int tid = tid_opaque(), lane = tid & 63, wave = tid >> 6;
    bf16_t* Z = (bf16_t*)(P.ws + WS_ZB); const bf16_t* XW = (const bf16_t*)(P.ws + WS_XNB);
    LAS float* buf = (LAS float*)lds;
    LAS float* ybuf = (LAS float*)(lds + 86016);
    const int bid_ = bid_opaque(), nidle_ = (int)gridDim.x > 192 ? (int)gridDim.x - 192 : 0;
    for (int it = (bid_ < 192 || nidle_ == 0) ? bid_ : 192 + (bid_ - 192); it < 192 + 1024; it += (bid_ < 192 ? (nidle_ ? 100000 : (int)gridDim.x) : nidle_)) {
        int rowbase, nsteps, h, qt, part = 0; const float* S0 = nullptr; float* So; bf16_t* yout; size_t ypitch = ZW;
        if (it < 192) { const int chain = it / 12, sub12 = it % 12, b = chain >> 3; h = chain & 7; part = sub12 >> 2; qt = sub12 & 3; nsteps = SEQ / 2; rowbase = b * SEQ + (part ? SEQ / 2 : 0);
            So = (float*)(P.ws + (part == 0 ? WS_SMID : (part == 1 ? WS_SP1 : WS_PHI))) + (size_t)chain * 4096;
            if (part < 2) yout = Z + (size_t)rowbase * ZW + BK + h * 64 + qt * 16; else { yout = (bf16_t*)(P.ws + WS_YPHI) + (size_t)b * (SEQ / 2) * 512 + h * 64 + qt * 16; ypitch = 512; } }
        else { const int si = it - 192, s = si >> 5; h = (si >> 2) & 7; qt = si & 3; rowbase = T_P + s * 32; nsteps = 32; S0 = PIN(7) + ((size_t)((l * 32 + s) * 8 + h)) * 4096; So = P.out + O_RWS + ((size_t)((l * 32 + s) * 8 + h)) * 4096;
            yout = Z + (size_t)rowbase * ZW + BK + h * 64 + qt * 16; }
        const int i0 = qt * 16, nb = nsteps >> 5;
        const int lt = tid - 256, lstep = lt >> 3, lsub = lt & 7;
        const int rr = lane >> 4, jl = lane & 15, li = 4 * wave + rr;
        f32x2v Sa = {0.f, 0.f}, Sb = {0.f, 0.f};
        u32x4 g_ew = {0u,0u,0u,0u}, g_k = g_ew, g_kk = g_ew, g_ka = g_ew, g_r = g_ew, g_v = g_ew;
        if (wave < 4 && S0) { const f32x4 s4 = *(const f32x4*)(S0 + (size_t)(i0 + li) * 64 + 4 * jl); Sa = (f32x2v){s4[0], s4[1]}; Sb = (f32x2v){s4[2], s4[3]}; }
        if (part == 2) { const int d_ = i0 + li - 4 * jl; Sa = (f32x2v){d_ == 0 ? 1.f : 0.f, d_ == 1 ? 1.f : 0.f}; Sb = (f32x2v){d_ == 2 ? 1.f : 0.f, d_ == 3 ? 1.f : 0.f}; }
        for (int bb = -1; bb < nb; ++bb) {
            if (wave >= 4) {
#define SC_LOAD(bt) do { const size_t row_ = (size_t)(rowbase + (bt) * 32 + lstep); g_ew = *(const u32x4*)(XW + row_ * DM + h * 64 + lsub * 8); g_k = *(const u32x4*)(Z + row_ * ZW + CK + h * 64 + lsub * 8); \
        g_kk = *(const u32x4*)(Z + row_ * ZW + BV + h * 64 + lsub * 8); g_ka = *(const u32x4*)(XW + row_ * DM + 512 + h * 64 + lsub * 8); g_r = *(const u32x4*)(Z + row_ * ZW + CR + h * 64 + lsub * 8); \
        if (lsub < 2 && part != 2) g_v = *(const u32x4*)(Z + row_ * ZW + CV + h * 64 + i0 + lsub * 8); } while (0)
#define SC_WRITE(bt) do { LAS float* d = buf + ((bt) & 1) * 10752 + lstep * 336; float f[8]; unpack8(g_ew, f); \
        *(LAS f32x4*)(d + lsub * 8) = (f32x4){__expf(-f[0]), __expf(-f[1]), __expf(-f[2]), __expf(-f[3])}; *(LAS f32x4*)(d + lsub * 8 + 4) = (f32x4){__expf(-f[4]), __expf(-f[5]), __expf(-f[6]), __expf(-f[7])}; \
        unpack8(g_k, f); *(LAS f32x4*)(d + 64 + lsub * 8) = (f32x4){f[0], f[1], f[2], f[3]}; *(LAS f32x4*)(d + 64 + lsub * 8 + 4) = (f32x4){f[4], f[5], f[6], f[7]}; \
        unpack8(g_kk, f); *(LAS f32x4*)(d + 128 + lsub * 8) = (f32x4){f[0], f[1], f[2], f[3]}; *(LAS f32x4*)(d + 128 + lsub * 8 + 4) = (f32x4){f[4], f[5], f[6], f[7]}; \
        unpack8(g_ka, f); *(LAS f32x4*)(d + 192 + lsub * 8) = (f32x4){f[0], f[1], f[2], f[3]}; *(LAS f32x4*)(d + 192 + lsub * 8 + 4) = (f32x4){f[4], f[5], f[6], f[7]}; \
        unpack8(g_r, f); *(LAS f32x4*)(d + 256 + lsub * 8) = (f32x4){f[0], f[1], f[2], f[3]}; *(LAS f32x4*)(d + 256 + lsub * 8 + 4) = (f32x4){f[4], f[5], f[6], f[7]}; \
        if (lsub < 2) { unpack8(g_v, f); *(LAS f32x4*)(d + 320 + lsub * 8) = (f32x4){f[0], f[1], f[2], f[3]}; *(LAS f32x4*)(d + 320 + lsub * 8 + 4) = (f32x4){f[4], f[5], f[6], f[7]}; } } while (0)
                if (bb == -1) { SC_LOAD(0); SC_WRITE(0); if (nb > 1) SC_LOAD(1); }
                else { if (bb + 1 < nb) SC_WRITE(bb + 1); if (bb + 2 < nb) SC_LOAD(bb + 2); }
                if (bb >= 1 && lsub < 2) {
                    const LAS float* y = ybuf + ((bb - 1) & 1) * 512 + lstep * 16 + lsub * 8; float f[8];
#pragma unroll
                    for (int e = 0; e < 8; ++e) f[e] = y[e];
                    *(u32x4*)(yout + (size_t)((bb - 1) * 32 + lstep) * ypitch + lsub * 8) = pack8(f);
                }
            } else if (bb >= 0) {
                __builtin_amdgcn_s_setprio(3);
                const LAS float* bp = buf + (bb & 1) * 10752 + 4 * jl; const LAS float* vp_ = buf + (bb & 1) * 10752 + 320 + li; LAS float* yb = ybuf + (bb & 1) * 512;
                float ysel = 0.f, yprev = 0.f;
                f32x4 cw = *(const LAS f32x4*)(bp), ck_ = *(const LAS f32x4*)(bp + 64), ckk = *(const LAS f32x4*)(bp + 128), cka = *(const LAS f32x4*)(bp + 192), cr = *(const LAS f32x4*)(bp + 256); float cv = vp_[0];
                f32x2v m = Sa * (f32x2v){ckk[0], ckk[1]}; m = Sb * (f32x2v){ckk[2], ckk[3]} + m;
                float a = m.x + m.y;
#pragma unroll
                for (int st = 0; st < 32; ++st) {
                    const int sn = (st + 1 < 32) ? st + 1 : st;
                    const f32x4 nw = *(const LAS f32x4*)(bp + sn * 336), nk = *(const LAS f32x4*)(bp + sn * 336 + 64), nkk = *(const LAS f32x4*)(bp + sn * 336 + 128), nka = *(const LAS f32x4*)(bp + sn * 336 + 192), nr = *(const LAS f32x4*)(bp + sn * 336 + 256); const float nv = vp_[sn * 336];
                    float b = yprev;
                    a += dppf<0xB1>(a); b += dppf<0xB1>(b); a += dppf<0x4E>(a); b += dppf<0x4E>(b); a += dppf<0x141>(a); b += dppf<0x141>(b); a += dppf<0x140>(a); b += dppf<0x140>(b);
                    if (st > 0) { ysel = (jl == ((st - 1) & 3)) ? b : ysel; if (((st - 1) & 3) == 3 && jl < 4) yb[(st - 4 + jl) * 16 + li] = ysel; }
                    const float nsa = -a; const f32x2v vi2 = {cv, cv}, ns2 = {nsa, nsa};
                    const f32x2v ta = (f32x2v){cka[0], cka[1]} * ns2 + (f32x2v){ck_[0], ck_[1]} * vi2, tb = (f32x2v){cka[2], cka[3]} * ns2 + (f32x2v){ck_[2], ck_[3]} * vi2;
                    Sa = Sa * (f32x2v){cw[0], cw[1]} + ta; Sb = Sb * (f32x2v){cw[2], cw[3]} + tb;
                    f32x2v ym = Sa * (f32x2v){cr[0], cr[1]}; ym = Sb * (f32x2v){cr[2], cr[3]} + ym; yprev = ym.x + ym.y;
                    f32x2v mm = Sa * (f32x2v){nkk[0], nkk[1]}; mm = Sb * (f32x2v){nkk[2], nkk[3]} + mm; a = mm.x + mm.y;
                    cw = nw; ck_ = nk; ckk = nkk; cka = nka; cr = nr; cv = nv;
                }
                { float b = red16(yprev); ysel = (jl == 3) ? b : ysel; if (jl < 4) yb[(28 + jl) * 16 + li] = ysel; }
                __builtin_amdgcn_s_setprio(0);
            }
            __syncthreads();
        }
        if (wave >= 4 && lsub < 2) { const LAS float* y = ybuf + ((nb - 1) & 1) * 512 + lstep * 16 + lsub * 8; float f[8];
#pragma unroll
            for (int e = 0; e < 8; ++e) f[e] = y[e];
            *(u32x4*)(yout + (size_t)((nb - 1) * 32 + lstep) * ypitch + lsub * 8) = pack8(f); }
        if (wave < 4) *(f32x4*)(So + (size_t)(i0 + li) * 64 + 4 * jl) = (f32x4){Sa.x, Sa.y, Sb.x, Sb.y};
        __syncthreads();
    }
    {
        unsigned* ctr = (unsigned*)(P.ws + 14336) + l;
        LAS int* slot = (LAS int*)(lds + 131072 + 1024);
        int nxt = 0;
        if (tid == 0) nxt = (int)atomicAdd(ctr, 1u);
        for (;;) {
            __syncthreads();
            if (tid == 0) { slot[0] = nxt; nxt = (int)atomicAdd(ctr, 1u); }
            __syncthreads();
            const int idx = slot[0];
            if (idx >= 512 + 2048) break;
            if (idx < 512) sattn_item(P, l, lds, idx, tid); else attn_item(P, l, lds, 1024 + idx - 512, tid);
        }
    }
}

__device__ __forceinline__ void e2_phase(const Params& P, int l) {
    const int tid = tid_opaque(), tok = tid >> 3, sub = tid & 7;
    bf16_t* Z = (bf16_t*)(P.ws + WS_ZB);
    {
        const float* SM = (const float*)(P.ws + WS_SMID); const float* S1 = (const float*)(P.ws + WS_SP1); const float* PH = (const float*)(P.ws + WS_PHI);
        for (int e = bid_opaque() * 512 + tid; e < 16 * 4096; e += gridDim.x * 512) { const int chain = e >> 12, i = (e >> 6) & 63, j = e & 63; float a = S1[e];
#pragma unroll 16
            for (int m = 0; m < 64; ++m) a += SM[chain * 4096 + i * 64 + m] * PH[chain * 4096 + m * 64 + j];
            P.out[O_RWP + (size_t)(l * 16 + chain) * 4096 + i * 64 + j] = a; }
    }
    const int wave = tid >> 6, lane = tid & 63, fr = lane & 15, fq = lane >> 4, tt = wave & 3, ih = wave >> 2;
    for (int t_ = bid_opaque(); t_ < 528; t_ += gridDim.x) {
        const int tile = (t_ >= 256 && t_ < 512) ? 256 + ((t_ - 256) ^ 128) : t_;
        if (tile < 512 && (tile & 255) >= 128) {
            const int b = tile >> 8, tl = ((tile & 255) - 128) * 64 + tt * 16 + fr;
            for (int h = 0; h < 8; ++h) {
                const float* SM = (const float*)(P.ws + WS_SMID) + (size_t)(b * 8 + h) * 4096;
                const bf16_t* yp = (const bf16_t*)(P.ws + WS_YPHI) + ((size_t)b * (SEQ / 2) + tl) * 512 + h * 64;
                const bf16x8 yb0 = *(const bf16x8*)(yp + 8 * fq), yb1 = *(const bf16x8*)(yp + 32 + 8 * fq);
                bf16_t* yrow = Z + (size_t)(b * SEQ + SEQ / 2 + tl) * ZW + BK + h * 64;
#pragma unroll
                for (int q = 0; q < 2; ++q) { const int i = (ih * 2 + q) * 16 + fr; f32x4 acc = (f32x4){0.f, 0.f, 0.f, 0.f};
#pragma unroll
                    for (int kk = 0; kk < 2; ++kk) { const f32x4 s0 = *(const f32x4*)(SM + i * 64 + 32 * kk + 8 * fq), s1 = *(const f32x4*)(SM + i * 64 + 32 * kk + 8 * fq + 4);
                        u32x4 w; w.x = cvt_pk_bf16(s0[0], s0[1]); w.y = cvt_pk_bf16(s0[2], s0[3]); w.z = cvt_pk_bf16(s1[0], s1[1]); w.w = cvt_pk_bf16(s1[2], s1[3]);
                        acc = __builtin_amdgcn_mfma_f32_16x16x32_bf16(__builtin_bit_cast(bf16x8, w), kk ? yb1 : yb0, acc, 0, 0, 0); }
                    bf16_t* dp = yrow + (ih * 2 + q) * 16 + 4 * fq; const u32x2 o = *(const u32x2*)dp; u32x2 w;
                    w.x = cvt_pk_bf16(bflo(o.x) + acc[0], bfhi(o.x) + acc[1]); w.y = cvt_pk_bf16(bflo(o.y) + acc[2], bfhi(o.y) + acc[3]); *(u32x2*)dp = w; }
            }
            __syncthreads();
        }
        const size_t row = (size_t)tile * 64 + tok;
#pragma unroll
        for (int hq = 0; hq < 2; ++hq) {
            u32x4 ry[4], rv[4], rg[4]; float bnv[4];
#pragma unroll
            for (int q = 0; q < 4; ++q) { const int h = hq * 4 + q, hc = h * 64 + sub * 8; ry[q] = *(const u32x4*)(Z + row * ZW + BK + hc); rv[q] = *(const u32x4*)(Z + row * ZW + CV + hc); rg[q] = *(const u32x4*)(Z + row * ZW + BG + hc);
                bnv[q] = ((const float*)(P.ws + WS_BONUS))[row * 8 + h]; }
#pragma unroll
            for (int q = 0; q < 4; ++q) { const int h = hq * 4 + q, hc = h * 64 + sub * 8; float y[8], v[8], g[8], o[8];
                unpack8(ry[q], y); unpack8(rv[q], v); unpack8(rg[q], g);
                float s_ = 0.f;
#pragma unroll
                for (int e = 0; e < 8; ++e) s_ += y[e];
                const float mean = sum8(s_) * (1.f / 64.f); float q2 = 0.f;
#pragma unroll
                for (int e = 0; e < 8; ++e) { const float d = y[e] - mean; q2 += d * d; }
                const float rs = rsqrtf(sum8(q2) * (1.f / 64.f) + 64e-5f);
                const float bn = bnv[q];
                const float* lw = PIN(23) + l * 512 + hc; const float* lb = PIN(24) + l * 512 + hc;
#pragma unroll
                for (int e = 0; e < 8; ++e) o[e] = ((y[e] - mean) * rs * lw[e] + lb[e] + bn * v[e]) * g[e];
                *(u32x4*)(Z + row * ZW + CR + hc) = pack8(o); }
        }
    }
}

#define XB_TMO      128
#define XB_XCNT(j)  (256  + 64 * (j))
#define XB_XSUB(j)  (1280 + 64 * (j))
#define XB_XGEN(j)  (2304 + 64 * (j))
#define XB_TOP      3328
#define XB_TOPGEN   3392
#define XCD_BAR_WORDS 3456
#define XB_SPIN_CAP (1u << 22)
__device__ __forceinline__ unsigned xb_ld(unsigned* p)              { return __hip_atomic_load(p, __ATOMIC_RELAXED, __HIP_MEMORY_SCOPE_AGENT); }
__device__ __forceinline__ unsigned xb_add(unsigned* p, unsigned v) { return __hip_atomic_fetch_add(p, v, __ATOMIC_RELAXED, __HIP_MEMORY_SCOPE_AGENT); }
__device__ __forceinline__ unsigned xb_xcc_id() { return (unsigned)__builtin_amdgcn_s_getreg((3 << 11) | 20) & 0xFu; }
#define XB_SPIN(cond, bar) do { unsigned _sp = 0; while (cond) { __builtin_amdgcn_s_sleep(1); \
    if ((++_sp & 255u) == 0u) { if (xb_ld(&(bar)[XB_TMO])) break; if (_sp > XB_SPIN_CAP) { atomicAdd(&(bar)[XB_TMO], 1u); break; } } } } while (0)
struct XcdBarrier { unsigned* bar; unsigned x; volatile LAS unsigned* st; };
__device__ __forceinline__ XcdBarrier xcd_barrier_post(unsigned* bar, volatile LAS unsigned* st) {
    XcdBarrier b; b.bar = bar; b.x = xb_xcc_id(); b.st = st;
    if (threadIdx.x == 0) (void)xb_add(&bar[XB_XCNT(b.x)], 1u);
    return b;
}
__device__ __forceinline__ void xcd_barrier_complete(unsigned* bar, unsigned x, unsigned& nloc, unsigned& nx) {
    const unsigned G = gridDim.x * gridDim.y * gridDim.z;
    unsigned sum, cnt, mine, sp = 0u;
    for (;;) {
        sum = 0u; cnt = 0u; mine = 0u;
#pragma unroll
        for (unsigned j = 0; j < 16; ++j) { const unsigned c = xb_ld(&bar[XB_XCNT(j)]); sum += c; cnt += (c > 0u) ? 1u : 0u; mine = (j == x) ? c : mine; }
        if (sum == G) break;
        __builtin_amdgcn_s_sleep(1);
        if ((++sp & 255u) == 0u) { if (xb_ld(&bar[XB_TMO])) break; if (sp > XB_SPIN_CAP) { atomicAdd(&bar[XB_TMO], 1u); break; } }
    }
    nloc = mine > 0u ? mine : 1u; nx = cnt > 0u ? cnt : 1u;
}
__device__ __forceinline__ void xcd_barrier(const XcdBarrier& b) {
    asm volatile("s_waitcnt vmcnt(0)" ::: "memory");
    __syncthreads();
    if (threadIdx.x == 0) {
        unsigned* bar = b.bar;
        __builtin_amdgcn_s_waitcnt(0);
        unsigned nloc = b.st[0], nx = b.st[1];
        if (nloc == 0u) { xcd_barrier_complete(bar, b.x, nloc, nx); b.st[0] = nloc; b.st[1] = nx; }
        const unsigned old = xb_add(&bar[XB_XSUB(b.x)], 1u);
        const unsigned gen = old / nloc;
        if (old + 1u == (gen + 1u) * nloc) {
            __builtin_amdgcn_fence(__ATOMIC_RELEASE, "agent");
            asm volatile("s_waitcnt vmcnt(0)" ::: "memory");
            const unsigned og = xb_add(&bar[XB_TOP], 1u);
            const unsigned tg = og / nx;
            if (og + 1u == (tg + 1u) * nx) xb_add(&bar[XB_TOPGEN], 1u);
            else XB_SPIN(xb_ld(&bar[XB_TOPGEN]) == tg, bar);
            __builtin_amdgcn_fence(__ATOMIC_ACQUIRE, "agent");
            xb_add(&bar[XB_XGEN(b.x)], 1u);
            asm volatile("s_waitcnt vmcnt(0)" ::: "memory");
        } else {
            XB_SPIN(xb_ld(&bar[XB_XGEN(b.x)]) == gen, bar);
            __builtin_amdgcn_fence(__ATOMIC_ACQUIRE, "agent");
            asm volatile("s_waitcnt vmcnt(0)" ::: "memory");
        }
    }
    __syncthreads();
}

__global__ void __launch_bounds__(512, 2) mega_fwd(Params P) {
    extern __shared__ __attribute__((aligned(16))) unsigned char lds_raw[];
    LAS unsigned char* lds = (LAS unsigned char*)lds_raw;
    unsigned char* ws = P.ws;
    bf16_t* Z = (bf16_t*)(ws + WS_ZB); bf16_t* XNB = (bf16_t*)(ws + WS_XNB); bf16_t* LOB = (bf16_t*)(ws + WS_LOB); bf16_t* WT = (bf16_t*)(ws + WS_W);
    volatile LAS unsigned* bst = (volatile LAS unsigned*)(lds + 131072 + 512);
    if (threadIdx.x < 2) bst[threadIdx.x] = 0u;
    __syncthreads();
    XcdBarrier xbar = xcd_barrier_post((unsigned*)ws, bst);
    for (int ph = P.ph_lo; ph < P.ph_hi; ++ph) {
        if (ph == 0) { convert_weights(P, 0, lds); row_norm_pass(P, 0, 0); }
        else {
            const int l = (ph - 1) / NPH_LAYER, k = (ph - 1) % NPH_LAYER;
            GemmDesc g; g.sched = -1; g.lda = g.ldb = 1024; g.K = 1024; g.nM = 132; g.nN = 4; g.epi = 0; g.perm = 1; g.d0 = nullptr; g.ldc0 = 1024; g.d1 = nullptr; g.x = nullptr; g.z = Z; g.A = nullptr; g.B = nullptr; g.skip = 0; g.xs0 = nullptr; g.xs1 = nullptr;
            switch (k) {
            case 0: g.sched = 0; g.A = (const char*)XNB; g.B = (const char*)(WT + W_Z); g.nN = 21; g.d0 = Z; g.ldc0 = ZW; break;
            case 1: e1_phase(P, l, lds); break;
            case 2: p2_phase(P, l, lds); break;
            case 3: p3_phase(P, l, lds); break;
            case 4: g.sched = 0; g.A = (const char*)LOB; g.lda = 256; g.B = (const char*)(WT + W_BD); g.ldb = 256; g.K = 256; g.nN = 6; g.epi = 1; g.d0 = XNB; break;
            case 5: c2_phase(P, l, lds); break;
            case 6: scan_phase(P, l, lds); break;
            case 7: e2_phase(P, l); row_norm_pass(P, l, 1, ((int)gridDim.x >= 128 && 528 > 2 * (int)gridDim.x && 528 < 3 * (int)gridDim.x) ? 528 - 2 * (int)gridDim.x : 0); break;
            case 8: g.sched = 0; g.A = (const char*)XNB; g.B = (const char*)(WT + W_GL); g.nN = 12; g.epi = 2; g.d0 = Z; g.ldc0 = ZW; break;
            case 9: g.sched = 1; g.A = (const char*)Z; g.lda = ZW; g.B = (const char*)(WT + W_B); g.ldb = 512; g.K = 512; g.epi = 3; g.d0 = XNB; break;
            case 10: g.sched = 0; g.A = (const char*)XNB; g.B = (const char*)(WT + W_O); g.epi = 4; g.perm = 0; g.x = P.out; if (l == 0) { g.xs0 = PIN(0); g.xs1 = PIN(1); } break;
            case 11: row_norm_pass(P, l, 2); break;
            case 12: g.sched = 0; g.A = (const char*)Z; g.B = (const char*)(WT + W_GU); g.nN = 22; g.epi = 5; g.d0 = (bf16_t*)(ws + WS_H); g.ldc0 = FF; break;
            case 13: g.sched = 0; g.A = (const char*)(ws + WS_H); g.lda = FF; g.B = (const char*)(WT + W_D); g.ldb = FF; g.K = FF; g.epi = 4; g.perm = 0; g.x = P.out; g.d1 = (bf16_t*)(ws + WS_XB); break;
            case 14: g.sched = 0; g.A = (const char*)(ws + WS_XB); g.B = (const char*)(WT + W_PG); g.d0 = Z; break;
            default: finish_pass(P, l); if (l == 0) convert_weights(P, 1, lds); break;
            }
            for (int rep = 0; rep < (k == 13 ? 2 : 1); ++rep) {
                if (rep == 1) { g.A = (const char*)LOB; g.lda = 256; g.B = (const char*)(WT + W_P); g.ldb = 256; g.K = 256; g.epi = 0; g.perm = 1; g.d0 = XNB; g.ldc0 = 1024; g.d1 = nullptr; g.x = nullptr;
                    g.skip = ((int)gridDim.x >= 128 && 528 > 2 * (int)gridDim.x && 528 < 3 * (int)gridDim.x) ? 528 - 2 * (int)gridDim.x : 0; }
                if (g.sched >= 0) gemm_phase(lds, g);
            }
#ifdef DBG_REP_MASK
            if ((DBG_REP_MASK >> k) & 1) { cg::this_grid().sync(); if (g.sched >= 0) gemm_phase(lds, g); else if (k == 6) scan_phase(P, l, lds); else if (k == 2) p2_phase(P, l, lds); }
#endif
        }
        if (ph + 1 < P.ph_hi) { if (P.ph_hi < 0) cg::this_grid().sync(); else xcd_barrier(xbar); }
#ifdef DBG_EXTRA_SYNC
        if (ph + 1 < P.ph_hi) { cg::this_grid().sync(); cg::this_grid().sync(); }
#endif
    }
#ifdef DBG_DUMP_Z
    cg::this_grid().sync();
    for (size_t e = (size_t)blockIdx.x * 512 + threadIdx.x; e < (size_t)T_ALL * 512; e += (size_t)gridDim.x * 512) {
        const size_t r = e >> 9; const int c = (int)(e & 511);
        P.out[e] = bf2f(XNB[e]); (void)r; (void)c;
    }
#endif
}

extern "C" void kernel_launch(void* const* d_in, const int* in_sizes, int n_in, void* d_out, int out_size, void* d_ws, size_t ws_size, hipStream_t stream) {
    static int grid = 0;
    if (grid == 0) {
        if (n_in != 34 || out_size != 45603840 || ws_size < WS_END2) { fprintf(stderr, "kernel_launch: unexpected shapes n_in %d out %d ws %zu\n", n_in, out_size, ws_size); grid = -1; return; }
        int dev = 0, cus = 0, per_cu = 0;
        hipGetDevice(&dev); hipDeviceGetAttribute(&cus, hipDeviceAttributeMultiprocessorCount, dev);
        hipFuncSetAttribute((const void*)mega_fwd, hipFuncAttributeMaxDynamicSharedMemorySize, LDS_BYTES);
        hipOccupancyMaxActiveBlocksPerMultiprocessor(&per_cu, (const void*)mega_fwd, 512, LDS_BYTES);
        if (per_cu < 1) { fprintf(stderr, "kernel_launch: occupancy query says %d blocks per CU\n", per_cu); per_cu = 1; }
        (void)hipGetLastError();
        grid = cus * per_cu;
        fprintf(stderr, "kernel_launch: grid %d (cus %d x %d)\n", grid, cus, per_cu);
    }
    if (grid < 0) return;
#ifdef DBG_POISON
    (void)hipMemsetAsync(d_ws, 0xFF, WS_END, stream);
#endif
    (void)hipMemsetAsync(d_ws, 0, 16384, stream);
    Params p{};
    for (int i = 0; i < 34; ++i) p.in[i] = (const float*)d_in[i];
    p.out = (float*)d_out; p.ws = (unsigned char*)d_ws;
#if MK_PER_PHASE
    for (int ph = 0; ph < NPHASES; ++ph) { p.ph_lo = ph; p.ph_hi = ph + 1; hipLaunchKernelGGL(mega_fwd, dim3(grid), dim3(512), LDS_BYTES, stream, p); }
#else
#ifdef DBG_PH_HI
    p.ph_lo = 0; p.ph_hi = DBG_PH_HI;
#else
    p.ph_lo = 0; p.ph_hi = NPHASES;
#endif
    void* args[] = {&p};
    hipError_t e = hipLaunchCooperativeKernel((const void*)mega_fwd, dim3(grid), dim3(512), args, LDS_BYTES, stream);
    if (e != hipSuccess) fprintf(stderr, "cooperative launch failed: %s (grid %d)\n", hipGetErrorString(e), grid);
#endif
}
```

```cpp
#include <hip/hip_runtime.h>
#include <hip/hip_cooperative_groups.h>
#include <cstdio>
#include <cstdint>
namespace cg = cooperative_groups;


#ifndef MK_PER_PHASE
#define MK_PER_PHASE 0
#endif

#define LAS __attribute__((address_space(3)))
typedef unsigned short bf16_t;
typedef short bf16x8 __attribute__((ext_vector_type(8)));
typedef float f32x4 __attribute__((ext_vector_type(4)));
typedef unsigned u32x4 __attribute__((ext_vector_type(4)));
typedef unsigned u32x2 __attribute__((ext_vector_type(2)));

constexpr int T_ALL = 33792, T_P = 32768, SEQ = 16384, DM = 1024, ZW = 5376, FF = 2816;
constexpr int AQ = 0, AK = 512, AV = 1024, BQ = 1536, BK = 2048, BV = 2560, BG = 3072, CR = 3584, CK = 4096, CV = 4608, CLO = 5120;
constexpr float EPS = 1e-6f;
constexpr int NPH_LAYER = 16, NPHASES = 1 + 2 * NPH_LAYER;
constexpr size_t O_YP = 0, O_AKP = 34603008, O_AVP = 35651584, O_RETP = 36700160, O_RWP = 36962304, O_SHP = 37093376,
                 O_AKS = 37100544, O_AVS = 38149120, O_RETS = 39197696, O_RWS = 43392000, O_SHS = 45489152;
constexpr size_t MiB = 1u << 20;
constexpr size_t WS_W = 1 * MiB, WS_XNB = 43 * MiB, WS_LOB = 109 * MiB, WS_ZB = 126 * MiB, WS_BONUS = 473 * MiB, WS_CZB = 475 * MiB, WS_END = 477 * MiB;
constexpr size_t WS_YPHI = 478 * MiB, WS_SMID = 495 * MiB, WS_SP1 = 496 * MiB, WS_PHI = 497 * MiB, WS_END2 = 498 * MiB;
constexpr size_t WS_H = WS_ZB + 66 * MiB, WS_XB = WS_ZB + 248 * MiB;
constexpr size_t W_Z = 0, W_GL = 5505024, W_BD = 8650752, W_B = 9043968, W_O = 10616832, W_GU = 11665408, W_D = 17432576, W_P = 20316160, W_PG = 20578304;
constexpr int LDS_BYTES = 147456;

struct Params { const float* in[34]; float* out; unsigned char* ws; int ph_lo, ph_hi; };

__device__ __forceinline__ const float* ld_in(const Params& P, int i) { asm volatile("" : "+s"(i)); return P.in[i]; }
#define PIN(i) ld_in(P, i)
__device__ __forceinline__ int tid_opaque() { int t = threadIdx.x; asm volatile("" : "+v"(t)); return t; }
__device__ __forceinline__ int bid_opaque() { int b = blockIdx.x; asm volatile("" : "+s"(b)); return b; }
typedef __bf16 bf16x2v __attribute__((ext_vector_type(2)));
typedef float f32x2v __attribute__((ext_vector_type(2)));
__device__ __forceinline__ unsigned cvt_pk_bf16(float lo, float hi) { f32x2v v = {lo, hi}; bf16x2v b = __builtin_convertvector(v, bf16x2v); return __builtin_bit_cast(unsigned, b); }
__device__ __forceinline__ float bflo(unsigned w) { return __uint_as_float(w << 16); }
__device__ __forceinline__ float bfhi(unsigned w) { return __uint_as_float(w & 0xffff0000u); }
__device__ __forceinline__ float bf2f(bf16_t b) { return __uint_as_float((unsigned)b << 16); }
__device__ __forceinline__ bf16_t f2bf(float f) { return (bf16_t)(cvt_pk_bf16(f, f) & 0xffffu); }
__device__ __forceinline__ void unpack8(u32x4 w, float* f) { f[0] = bflo(w.x); f[1] = bfhi(w.x); f[2] = bflo(w.y); f[3] = bfhi(w.y); f[4] = bflo(w.z); f[5] = bfhi(w.z); f[6] = bflo(w.w); f[7] = bfhi(w.w); }
__device__ __forceinline__ u32x4 pack8(const float* f) { u32x4 w; w.x = cvt_pk_bf16(f[0], f[1]); w.y = cvt_pk_bf16(f[2], f[3]); w.z = cvt_pk_bf16(f[4], f[5]); w.w = cvt_pk_bf16(f[6], f[7]); return w; }
__device__ __forceinline__ float sigmoidf_(float x) { return __builtin_amdgcn_rcpf(1.f + __builtin_amdgcn_exp2f(-1.4426950408889634f * x)); }
__device__ __forceinline__ float wave_sum(float v) {
#pragma unroll
    for (int o = 1; o < 64; o <<= 1) v += __shfl_xor(v, o);
    return v;
}
__device__ __forceinline__ float sum8(float v) { v += __shfl_xor(v, 1); v += __shfl_xor(v, 2); v += __shfl_xor(v, 4); return v; }
template <int CTRL> __device__ __forceinline__ float dppf(float x) { return __builtin_bit_cast(float, __builtin_amdgcn_update_dpp(0, __builtin_bit_cast(int, x), CTRL, 0xf, 0xf, false)); }
__device__ __forceinline__ float red16(float x) { x += dppf<0xB1>(x); x += dppf<0x4E>(x); x += dppf<0x141>(x); x += dppf<0x140>(x); return x; }
__device__ __forceinline__ float gamma_l2(int h) { return __log2f(1.f - __builtin_amdgcn_exp2f(-5.f - (float)h)); }
#define LDSW() asm volatile("s_waitcnt lgkmcnt(0)" ::: "memory")

constexpr int BM = 256, BKT = 64, HALF = 128, HTB = HALF * BKT * 2;
__device__ __forceinline__ int lds_byte(int r, int c) { const int st = (r >> 4) * 2 + (c >> 5), rr = r & 15, cc = c & 31, ob = rr * 64 + cc * 2; return st * 1024 + (ob ^ (((ob >> 9) & 1) << 5)); }
__device__ __forceinline__ void stage_rc(int b, int& R, int& C) { const int st = b / 1024, sb = b % 1024, swz = sb ^ (((sb >> 9) & 1) << 5); R = (st >> 1) * 16 + swz / 64; C = (st & 1) * 32 + (swz % 64) / 2; }
__device__ __forceinline__ int perm32(int rho) { const int n = rho >> 4, i = rho & 15; return 8 * (i >> 2) + 4 * n + (i & 3); }

struct Unit { const char* a; const char* b; int pm, pn, aux; };
struct GemmDesc {
    const char* A; const char* B; int lda, ldb, K, nM, nN, sched, epi, perm;
    bf16_t* d0; int ldc0; bf16_t* d1; float* x; bf16_t* z;
    const float* xs0; const float* xs1;
    int skip;
};
__device__ __forceinline__ void tile_map(int L, int nM, int nN, int& pm, int& pn) {
    const int nwg = nM * nN; int wgid = L;
    { const int q = nwg / 8, r = nwg % 8, xcd = wgid % 8, off = wgid / 8; wgid = (xcd < r ? xcd * (q + 1) : r * (q + 1) + (xcd - r) * q) + off; }
    const int nig = 8 * nN, gid = wgid / nig, fm = gid * 8, gsz = (nM - fm) < 8 ? (nM - fm) : 8;
    pm = fm + ((wgid % nig) % gsz); pn = (wgid % nig) / gsz;
}
__device__ __forceinline__ int gl_off(int b) { return b == 0 ? 512 : (b == 1 ? 2048 : 4096); }
__device__ __forceinline__ int br_off(int b) { return b == 0 ? AQ : (b == 1 ? BQ : CR); }
__device__ __forceinline__ bool unit_next(const GemmDesc& g, int i, int G, int c, Unit& u) {
    const int nwg = g.nM * g.nN;
    if (g.sched == 0) {
        if (c < g.skip) return false;
        const long L = (long)i * (G - g.skip) + (c - g.skip); if (L >= nwg) return false;
        tile_map((int)L, g.nM, g.nN, u.pm, u.pn); u.aux = 0;
        u.a = g.A + (size_t)u.pm * 256 * g.lda * 2; u.b = g.B + (size_t)u.pn * 256 * g.ldb * 2; return true;
    } else {
        const long L = (long)(i / 3) * G + c; if (L >= nwg) return false;
        const int b = i % 3; tile_map((int)L, g.nM, g.nN, u.pm, u.pn); u.aux = b;
        u.a = g.A + (size_t)u.pm * 256 * g.lda * 2 + br_off(b) * 2; u.b = g.B + (size_t)b * 1024 * 512 * 2 + (size_t)u.pn * 256 * g.ldb * 2; return true;
    }
}
__device__ __forceinline__ void gemm_epilogue(const GemmDesc& g, const f32x4 (&acc)[2][2][4][2], const Unit& u, int wr, int wc, int fr, int fq) {
    const int row0 = u.pm * BM + wr * 64 + fr;
    if (g.epi == 4) {
        const int col0 = u.pn * BM + wc * 32 + 4 * fq;
#pragma unroll
        for (int ai = 0; ai < 2; ++ai)
#pragma unroll
            for (int m = 0; m < 4; ++m) { const int row_ = row0 + ai * HALF + m * 16; const size_t ro = (size_t)row_ * DM + col0;
                const float* sp = g.xs0 ? (row_ < T_P ? g.xs0 + ro : g.xs1 + (ro - (size_t)T_P * DM)) : g.x + ro;
#pragma unroll
                for (int bj = 0; bj < 2; ++bj)
#pragma unroll
                    for (int n = 0; n < 2; ++n) { f32x4* p = (f32x4*)(g.x + ro + bj * HALF + n * 16); const f32x4 v = *(const f32x4*)(sp + bj * HALF + n * 16) + acc[ai][bj][m][n]; *p = v;
                        if (g.d1) { u32x2 w; w.x = cvt_pk_bf16(v[0], v[1]); w.y = cvt_pk_bf16(v[2], v[3]); *(u32x2*)(g.d1 + ro + bj * HALF + n * 16) = w; } } }
        return;
    }
    const int cl = wc * 32 + 8 * fq;
    if (g.epi == 5) {
#pragma unroll
        for (int ai = 0; ai < 2; ++ai)
#pragma unroll
            for (int m = 0; m < 4; ++m) { const size_t ro = (size_t)(row0 + ai * HALF + m * 16) * g.ldc0 + u.pn * 128 + cl; float h[8];
#pragma unroll
                for (int n = 0; n < 2; ++n)
#pragma unroll
                    for (int e = 0; e < 4; ++e) { const float gt = acc[ai][0][m][n][e], up = acc[ai][1][m][n][e]; h[n * 4 + e] = gt * sigmoidf_(gt) * up; }
                *(u32x4*)(g.d0 + ro) = pack8(h); }
        return;
    }
    bf16_t* base = g.d0; int ldc = g.ldc0, colt = u.pn * BM; bool sg = false;
    if (g.epi == 1) { if (u.pn >= 4) { base = g.z; ldc = ZW; colt = BG + (u.pn - 4) * BM; } }
    else if (g.epi == 2) { colt = gl_off(u.pn >> 2) + (u.pn & 3) * BM; sg = true; }
    const bool gated = (g.epi == 3); const int gcol = gated ? gl_off(u.aux) : 0;
#pragma unroll
    for (int ai = 0; ai < 2; ++ai)
#pragma unroll
        for (int m = 0; m < 4; ++m) { const int row = row0 + ai * HALF + m * 16;
#pragma unroll
            for (int bj = 0; bj < 2; ++bj) { float v[8];
#pragma unroll
                for (int n = 0; n < 2; ++n)
#pragma unroll
                    for (int e = 0; e < 4; ++e) v[n * 4 + e] = acc[ai][bj][m][n][e];
                bf16_t* dp = base + (size_t)row * ldc + colt + bj * HALF + cl;
                if (sg) {
#pragma unroll
                    for (int e = 0; e < 8; ++e) v[e] = sigmoidf_(v[e]);
                }
                if (gated) { float gt[8]; unpack8(*(const u32x4*)(g.z + (size_t)row * ZW + gcol + u.pn * BM + bj * HALF + cl), gt);
#pragma unroll
                    for (int e = 0; e < 8; ++e) v[e] *= gt[e];
                    if (u.aux > 0) { float pv[8]; unpack8(*(const u32x4*)dp, pv);
#pragma unroll
                        for (int e = 0; e < 8; ++e) v[e] += pv[e]; } }
                *(u32x4*)dp = pack8(v); } }
}

__device__ __forceinline__ void gemm_phase(LAS unsigned char* lds, const GemmDesc& g) {
    const int tid = tid_opaque(), wid = __builtin_amdgcn_readfirstlane(tid >> 6), lane = tid & 63, wr = wid >> 2, wc = wid & 3, fr = lane & 15, fq = lane >> 4;
    const int G = gridDim.x, cb = bid_opaque();
    const int K = g.K, nt = K / BKT;
    unsigned voffA[2], voffB[2];
#pragma unroll
    for (int i = 0; i < 2; ++i) { int R, C; stage_rc(tid * 16 + i * 8192, R, C); const int Rb = g.perm ? ((R & ~31) + perm32(R & 31)) : R;
        voffA[i] = (unsigned)(R * g.lda + C) * 2u; voffB[i] = (unsigned)(Rb * g.ldb + C) * 2u; }
    const size_t kstep = (size_t)(BKT * 2);
    const size_t hstepA = (size_t)HALF * g.lda * 2, hstepB = (size_t)HALF * g.ldb * 2;
    const unsigned ldsw = (unsigned)wid * 1024u;
    const int aoff = lds_byte(wr * 64 + fr, fq * 8), boff = lds_byte(wc * 32 + fr, fq * 8);
#define PG8_SA(b, h) (((b) * 2 + (h)) * HTB)
#define PG8_SB(b, h) ((4 + (b) * 2 + (h)) * HTB)
#define PG8_STAGE(bufoff, gbase, voff) do { _Pragma("unroll") for (int _i = 0; _i < 2; ++_i) \
        __builtin_amdgcn_global_load_lds((const unsigned*)((const char*)(gbase) + (voff)[_i]), (LAS unsigned*)(lds + (bufoff) + ldsw + _i * 8192), 16, 0, 0); } while (0)
#define PG8_LDA(dst, b, h) do { _Pragma("unroll") for (int m = 0; m < 4; ++m) _Pragma("unroll") for (int k = 0; k < 2; ++k) dst[m][k] = *(const LAS bf16x8*)(lds + PG8_SA(b, h) + aoff + m * 2048 + k * 1024); } while (0)
#define PG8_LDB(dst, b, h) do { _Pragma("unroll") for (int n = 0; n < 2; ++n) _Pragma("unroll") for (int k = 0; k < 2; ++k) dst[n][k] = *(const LAS bf16x8*)(lds + PG8_SB(b, h) + boff + n * 2048 + k * 1024); } while (0)
#define PG8_MMA(ai, bj, At, Bt) do { __builtin_amdgcn_s_setprio(1); _Pragma("unroll") for (int m = 0; m < 4; ++m) _Pragma("unroll") for (int n = 0; n < 2; ++n) _Pragma("unroll") for (int k = 0; k < 2; ++k) \
        acc[ai][bj][m][n] = __builtin_amdgcn_mfma_f32_16x16x32_bf16(Bt[n][k], At[m][k], acc[ai][bj][m][n], 0, 0, 0); __builtin_amdgcn_s_setprio(0); } while (0)
#define PG8_WAIT_V(n) asm volatile("s_waitcnt vmcnt(" #n ")" ::: "memory")
#define PG8_WAIT_L(n) asm volatile("s_waitcnt lgkmcnt(" #n ")" ::: "memory")
#define PG8_BAR __builtin_amdgcn_s_barrier()
#define PG8_SCHED __builtin_amdgcn_sched_barrier(0)
    Unit cur, nxt; int ui = 0;
    if (!unit_next(g, 0, G, cb, cur)) return;
    f32x4 acc[2][2][4][2];
#pragma unroll
    for (int a = 0; a < 2; ++a)
#pragma unroll
        for (int b = 0; b < 2; ++b)
#pragma unroll
            for (int m = 0; m < 4; ++m)
#pragma unroll
                for (int n = 0; n < 2; ++n) acc[a][b][m][n] = (f32x4){0.f, 0.f, 0.f, 0.f};
    bf16x8 At[4][2], B0[2][2], B1[2][2];
    const char* cA = cur.a; const char* cB = cur.b;
    PG8_STAGE(PG8_SB(0, 0), cB, voffB); PG8_STAGE(PG8_SB(0, 1), cB + hstepB, voffB); PG8_STAGE(PG8_SA(0, 0), cA, voffA); PG8_STAGE(PG8_SA(0, 1), cA + hstepA, voffA);
    if (wr == 1) PG8_BAR;
    PG8_WAIT_V(2); PG8_BAR;
    PG8_STAGE(PG8_SB(1, 0), cB + kstep, voffB); PG8_STAGE(PG8_SA(1, 0), cA + kstep, voffA); PG8_STAGE(PG8_SB(1, 1), cB + hstepB + kstep, voffB);
    PG8_WAIT_V(6); PG8_BAR;
    for (;;) {
        const bool has_next = unit_next(g, ui + 1, G, cb, nxt);
        const char* nA = has_next ? nxt.a : cA; const char* nB = has_next ? nxt.b : cB;
        for (int t = 0; t < nt; t += 2) {
            const bool last = (t == nt - 2);
            const char* a1 = cA + (size_t)(t + 1) * kstep;
            const char* a2 = last ? nA : cA + (size_t)(t + 2) * kstep; const char* b2 = last ? nB : cB + (size_t)(t + 2) * kstep;
            const char* a3 = a2 + kstep; const char* b3 = b2 + kstep;
            PG8_LDB(B0, 0, 0); PG8_LDB(B1, 0, 1); PG8_SCHED; PG8_LDA(At, 0, 0); PG8_STAGE(PG8_SA(1, 1), a1 + hstepA, voffA);
            PG8_WAIT_V(8); PG8_WAIT_L(0); PG8_BAR; PG8_MMA(0, 0, At, B0); PG8_MMA(0, 1, At, B1); PG8_BAR; PG8_SCHED;
            PG8_LDA(At, 0, 1); PG8_STAGE(PG8_SB(0, 0), b2, voffB); PG8_STAGE(PG8_SB(0, 1), b2 + hstepB, voffB); PG8_STAGE(PG8_SA(0, 0), a2, voffA);
            PG8_WAIT_V(8); PG8_WAIT_L(0); PG8_BAR; PG8_MMA(1, 0, At, B0); PG8_MMA(1, 1, At, B1); PG8_BAR; PG8_SCHED;
            PG8_LDB(B0, 1, 0); PG8_LDB(B1, 1, 1); PG8_SCHED; PG8_LDA(At, 1, 0); PG8_STAGE(PG8_SA(0, 1), a2 + hstepA, voffA);
            PG8_WAIT_V(8); PG8_WAIT_L(0); PG8_BAR; PG8_MMA(0, 0, At, B0); PG8_MMA(0, 1, At, B1); PG8_BAR; PG8_SCHED;
            PG8_LDA(At, 1, 1); PG8_STAGE(PG8_SB(1, 0), b3, voffB); PG8_STAGE(PG8_SB(1, 1), b3 + hstepB, voffB); PG8_STAGE(PG8_SA(1, 0), a3, voffA);
            PG8_WAIT_V(8); PG8_WAIT_L(0); PG8_BAR; PG8_MMA(1, 0, At, B0); PG8_MMA(1, 1, At, B1); PG8_BAR; PG8_SCHED;
        }
        if (wr == 0) PG8_BAR;
        gemm_epilogue(g, acc, cur, wr, wc, fr, fq);
        if (!has_next) break;
#pragma unroll
        for (int a = 0; a < 2; ++a)
#pragma unroll
            for (int b = 0; b < 2; ++b)
#pragma unroll
                for (int m = 0; m < 4; ++m)
#pragma unroll
                    for (int n = 0; n < 2; ++n) acc[a][b][m][n] = (f32x4){0.f, 0.f, 0.f, 0.f};
        cur = nxt; cA = nA; cB = nB; ++ui;
        if (wr == 1) PG8_BAR;
    }
    PG8_WAIT_V(0);
    PG8_BAR;
}

struct MatDesc { const float* W; int ldw, col0, K, N; bf16_t* T; int ldt, koff, rowmode, rowoff; };
__device__ __forceinline__ MatDesc get_mat(const Params& P, int l, int m) {
    bf16_t* wb = (bf16_t*)(P.ws + WS_W); MatDesc d; d.col0 = 0; d.koff = 0; d.rowmode = 0; d.rowoff = 0;
    switch (m) {
    case 0: d.W = PIN(10) + (size_t)l * 1024 * 8448; d.ldw = 8448; d.K = 1024; d.N = 5376; d.T = wb + W_Z; d.ldt = 1024; break;
    case 1: d.W = PIN(10) + (size_t)l * 1024 * 8448; d.ldw = 8448; d.col0 = 5376; d.K = 1024; d.N = 3072; d.T = wb + W_GL; d.ldt = 1024; break;
    case 2: d.W = PIN(16) + (size_t)l * 64 * 512; d.ldw = 512; d.K = 64; d.N = 512; d.T = wb + W_BD; d.ldt = 256; break;
    case 3: d.W = PIN(18) + (size_t)l * 64 * 512; d.ldw = 512; d.K = 64; d.N = 512; d.T = wb + W_BD; d.ldt = 256; d.koff = 64; d.rowoff = 512; break;
    case 4: d.W = PIN(19) + (size_t)l * 128 * 512; d.ldw = 512; d.K = 128; d.N = 512; d.T = wb + W_BD; d.ldt = 256; d.koff = 128; d.rowoff = 1024; break;
    case 5: case 6: case 7: d.W = PIN(25) + (size_t)(l * 3 + (m - 5)) * 512 * 1024; d.ldw = 1024; d.K = 512; d.N = 1024; d.T = wb + W_B + (size_t)(m - 5) * 1024 * 512; d.ldt = 512; break;
    case 8: d.W = PIN(26) + (size_t)l * 1024 * 1024; d.ldw = 1024; d.K = 1024; d.N = 1024; d.T = wb + W_O; d.ldt = 1024; break;
    case 9: d.W = PIN(28) + (size_t)l * 1024 * FF; d.ldw = FF; d.K = 1024; d.N = FF; d.T = wb + W_GU; d.ldt = 1024; d.rowmode = 1; break;
    case 10: d.W = PIN(29) + (size_t)l * 1024 * FF; d.ldw = FF; d.K = 1024; d.N = FF; d.T = wb + W_GU; d.ldt = 1024; d.rowmode = 1; d.rowoff = 128; break;
    case 11: d.W = PIN(30) + (size_t)l * FF * 1024; d.ldw = 1024; d.K = FF; d.N = 1024; d.T = wb + W_D; d.ldt = FF; break;
    case 12: d.W = PIN(31) + (size_t)l * 256 * 1024; d.ldw = 1024; d.K = 256; d.N = 1024; d.T = wb + W_P; d.ldt = 256; break;
    default: d.W = PIN(33) + (size_t)l * 1024 * 1024; d.ldw = 1024; d.K = 1024; d.N = 1024; d.T = wb + W_PG; d.ldt = 1024; break;
    }
    return d;
}
__device__ __forceinline__ void convert_weights(const Params& P, int l, LAS unsigned char* lds) {
    const int tid = tid_opaque(), lane = tid & 63, wave = tid >> 6;
    LAS float* scr = (LAS float*)(lds + wave * 8704);
    const int gw = bid_opaque() * 8 + wave, NGW = gridDim.x * 8;
    for (int m = 0; m < 14; ++m) {
        const MatDesc d = get_mat(P, l, m);
        const int nblk = d.N / 32, nit = (d.K / 64) * nblk;
        for (int it = gw; it < nit; it += NGW) {
            const int kb = it / nblk, nb = it % nblk, k0 = 64 * kb, n0 = 32 * nb;
#pragma unroll 8
            for (int i = 0; i < 32; ++i) { const int kk = 2 * i + (lane >> 5); scr[kk * 33 + (lane & 31)] = d.W[(size_t)(k0 + kk) * d.ldw + d.col0 + n0 + (lane & 31)]; }
            LDSW();
            const int c = lane & 7;
#pragma unroll
            for (int j = 0; j < 4; ++j) { const int n = (lane >> 3) + 8 * j; const LAS float* s = scr + (8 * c) * 33 + n;
                u32x4 o; o.x = cvt_pk_bf16(s[0 * 33], s[1 * 33]); o.y = cvt_pk_bf16(s[2 * 33], s[3 * 33]); o.z = cvt_pk_bf16(s[4 * 33], s[5 * 33]); o.w = cvt_pk_bf16(s[6 * 33], s[7 * 33]);
                const int ng = n0 + n; const int drow = d.rowoff + (d.rowmode ? (256 * (ng >> 7) + (ng & 127)) : ng);
                *(u32x4*)(d.T + (size_t)drow * d.ldt + d.koff + k0 + 8 * c) = o; }
            LDSW();
        }
    }
    bf16_t* bd = (bf16_t*)(P.ws + WS_W) + W_BD;
    for (int e = bid_opaque() * 512 + tid; e < 1536 * 32; e += gridDim.x * 512) {
        const int row = e >> 5, k8 = (e & 31) * 8; const int blk = row >> 9;
        const bool diag = (blk == 0) ? (k8 < 64) : (blk == 1 ? (k8 >= 64 && k8 < 128) : (k8 >= 128));
        if (!diag) *(u32x4*)(bd + (size_t)row * 256 + k8) = (u32x4){0u, 0u, 0u, 0u};
    }
}

__device__ __forceinline__ void row_norm_pass(const Params& P, int l, int mode, int skip = 0) {
    const int tid_ = tid_opaque(); const int lane = tid_ & 63, wave = tid_ >> 6;
    const int bsk_ = bid_opaque() - skip; if (bsk_ < 0) return;
    const int gw = bsk_ * 8 + wave, NGW = ((int)gridDim.x - skip) * 8;
    const float* gain = (mode == 2 ? PIN(27) : PIN(9)) + (size_t)l * DM;
    bf16_t* dst = (bf16_t*)(P.ws + (mode == 2 ? WS_ZB : WS_XNB));
    f32x4 gv[4];
#pragma unroll
    for (int j = 0; j < 4; ++j) gv[j] = *((const f32x4*)gain + lane + 64 * j);
    for (int r = gw; r < T_ALL; r += NGW) {
        const float* src = (mode == 0 || (mode == 1 && l == 0)) ? (r < T_P ? PIN(0) + (size_t)r * DM : PIN(1) + (size_t)(r - T_P) * DM) : P.out + (size_t)r * DM;
        f32x4 v[4]; float s = 0.f;
#pragma unroll
        for (int j = 0; j < 4; ++j) { v[j] = *((const f32x4*)src + lane + 64 * j); s += v[j][0] * v[j][0] + v[j][1] * v[j][1] + v[j][2] * v[j][2] + v[j][3] * v[j][3]; }
        const float rs = rsqrtf(wave_sum(s) * (1.f / DM) + EPS);
#pragma unroll
        for (int j = 0; j < 4; ++j) {
            const f32x4 o = v[j] * rs * gv[j]; u32x2 w; w.x = cvt_pk_bf16(o[0], o[1]); w.y = cvt_pk_bf16(o[2], o[3]);
            *((u32x2*)(dst + (size_t)r * DM) + lane + 64 * j) = w; }
        if (mode == 2) {
            const float* pr = (r < T_P) ? PIN(2) + ((size_t)l * T_P + r) * 256 : PIN(3) + ((size_t)l * 1024 + (r - T_P)) * 256;
            const f32x4 pv = *((const f32x4*)pr + lane); u32x2 w; w.x = cvt_pk_bf16(pv[0], pv[1]); w.y = cvt_pk_bf16(pv[2], pv[3]);
            *((u32x2*)((bf16_t*)(P.ws + WS_LOB) + (size_t)r * 256) + lane) = w;
        }
    }
}
__device__ __forceinline__ void finish_pass(const Params& P, int l) {
    const int tid_ = tid_opaque(); const int lane = tid_ & 63, wave = tid_ >> 6;
    const int gw = bid_opaque() * 8 + wave, NGW = gridDim.x * 8;
    const float* gp = PIN(32) + (size_t)l * DM; const float* gn = PIN(9) + (size_t)(l < 1 ? l + 1 : l) * DM;
    bf16_t* GR = (bf16_t*)(P.ws + WS_ZB); bf16_t* EB = (bf16_t*)(P.ws + WS_XNB);
    for (int r = gw; r < T_ALL; r += NGW) {
        f32x4 x[4], gr[4], e[4]; float sx = 0.f, se = 0.f;
#pragma unroll
        for (int j = 0; j < 4; ++j) { x[j] = *((const f32x4*)(P.out + (size_t)r * DM) + lane + 64 * j);
            const u32x2 a = *((const u32x2*)(GR + (size_t)r * DM) + lane + 64 * j), b = *((const u32x2*)(EB + (size_t)r * DM) + lane + 64 * j);
            gr[j] = (f32x4){bflo(a.x), bfhi(a.x), bflo(a.y), bfhi(a.y)}; e[j] = (f32x4){bflo(b.x), bfhi(b.x), bflo(b.y), bfhi(b.y)};
#pragma unroll
            for (int k = 0; k < 4; ++k) { sx += x[j][k] * x[j][k]; se += e[j][k] * e[j][k]; } }
        const float rx = rsqrtf(wave_sum(sx) * (1.f / DM) + EPS), re = rsqrtf(wave_sum(se) * (1.f / DM) + EPS);
        float s2 = 0.f;
#pragma unroll
        for (int j = 0; j < 4; ++j) { const f32x4 g4 = *((const f32x4*)gp + lane + 64 * j);
#pragma unroll
            for (int k = 0; k < 4; ++k) { const float xn = x[j][k] + sigmoidf_(gr[j][k] * rx) * (e[j][k] * re * g4[k]); x[j][k] = xn; s2 += xn * xn; }
            *((f32x4*)(P.out + (size_t)r * DM) + lane + 64 * j) = x[j]; }
        if (l < 1) {
            const float r2 = rsqrtf(wave_sum(s2) * (1.f / DM) + EPS);
#pragma unroll
            for (int j = 0; j < 4; ++j) { const f32x4 g4 = *((const f32x4*)gn + lane + 64 * j); const f32x4 o = x[j] * r2 * g4; u32x2 w; w.x = cvt_pk_bf16(o[0], o[1]); w.y = cvt_pk_bf16(o[2], o[3]);
                *((u32x2*)(EB + (size_t)r * DM) + lane + 64 * j) = w; }
        }
    }
}

__device__ __forceinline__ void e1_phase(const Params& P, int l, LAS unsigned char* lds) {
    const int tid = tid_opaque(), tok = tid >> 3, sub = tid & 7, wave = tid >> 6, lane = tid & 63, fr = lane & 15, fq = lane >> 4;
    bf16_t* Z = (bf16_t*)(P.ws + WS_ZB);
    LAS bf16_t* L0 = (LAS bf16_t*)lds;
    LAS bf16_t* L1 = (LAS bf16_t*)(lds + 18432);
    for (int it = bid_opaque(); it < 528 * 7; it += gridDim.x) {
        const int tile = it / 7, job = it % 7, r0 = tile * 64, row = r0 + tok;
        const bool prompt = tile < 512; const int sr = row - T_P;
        bf16_t* zr = Z + (size_t)row * ZW;
        if (job < 2) {
            u32x4 rq[4], rk[4], rv[4];
#pragma unroll
            for (int q = 0; q < 4; ++q) { const int hc = (job * 4 + q) * 64 + sub * 8; rq[q] = *(const u32x4*)(zr + AQ + hc); rk[q] = *(const u32x4*)(zr + AK + hc); rv[q] = *(const u32x4*)(zr + AV + hc); }
            const float* gq = PIN(11) + l * 64 + sub * 8; const float* gk = PIN(12) + l * 64 + sub * 8;
#pragma unroll
            for (int q = 0; q < 4; ++q) { const int h = job * 4 + q; float f[8], o[8];
                unpack8(rq[q], f);
                float ss = 0.f;
#pragma unroll
                for (int e = 0; e < 8; ++e) ss += f[e] * f[e];
                float rs = rsqrtf(sum8(ss) * (1.f / 64.f) + EPS);
#pragma unroll
                for (int e = 0; e < 8; ++e) o[e] = f[e] * rs * gq[e];
                *(u32x4*)(zr + AQ + h * 64 + sub * 8) = pack8(o);
                unpack8(rk[q], f);
                ss = 0.f;
#pragma unroll
                for (int e = 0; e < 8; ++e) ss += f[e] * f[e];
                rs = rsqrtf(sum8(ss) * (1.f / 64.f) + EPS);
#pragma unroll
                for (int e = 0; e < 8; ++e) o[e] = f[e] * rs * gk[e];
                *(u32x4*)(zr + AK + h * 64 + sub * 8) = pack8(o);
                float vv[8]; const u32x4 vraw = rv[q]; unpack8(vraw, vv);
                float* ok = nullptr; float* ov = nullptr;
                if (prompt) { const int b = row >> 14, t = row & (SEQ - 1); if (t >= SEQ - 512) { const size_t o_ = (((size_t)(l * 2 + b) * 512 + (t - (SEQ - 512))) * 512 + h * 64 + sub * 8); ok = P.out + O_AKP + o_; ov = P.out + O_AVP + o_; } }
                else { const size_t o_ = ((size_t)(l * 1024 + sr) * 512 + h * 64 + sub * 8); ok = P.out + O_AKS + o_; ov = P.out + O_AVS + o_; }
                if (ok) { *(f32x4*)ok = (f32x4){o[0], o[1], o[2], o[3]}; *(f32x4*)(ok + 4) = (f32x4){o[4], o[5], o[6], o[7]};
                          *(f32x4*)ov = (f32x4){vv[0], vv[1], vv[2], vv[3]}; *(f32x4*)(ov + 4) = (f32x4){vv[4], vv[5], vv[6], vv[7]}; }
                if (prompt) {
#pragma unroll
                    for (int e = 0; e < 8; ++e) L0[q * 4608 + (sub * 8 + e) * 72 + tok] = ((const unsigned short*)&vraw)[e];
                } }
            if (prompt) {
                __syncthreads();
#pragma unroll
                for (int q = 0; q < 4; ++q) { const u32x4 w = *(const LAS u32x4*)(L0 + q * 4608 + tok * 72 + sub * 8);
                    *(u32x4*)(Z + (size_t)(r0 + tok) * ZW + AV + (job * 4 + q) * 64 + sub * 8) = w; }
                __syncthreads();
            }
        } else if (job < 6) {
            const int h = job - 2; const int pos = prompt ? (row & (SEQ - 1)) : (2048 + (sr & 31));
            float cs[8], sn[8];
#pragma unroll
            for (int e = 0; e < 8; ++e) { const float inv = __builtin_amdgcn_exp2f(-(float)(sub * 8 + e) * (13.287712379549449f / 64.f)); const float ang = (float)pos * inv;
                const float n = rintf(ang * 0.15915494309189535f); float rr = fmaf(-n, 6.2831855f, ang); rr = fmaf(-n, -1.7484555e-7f, rr); cs[e] = __cosf(rr); sn[e] = __sinf(rr); }
            float x1[8], x2[8], o1[8], o2[8];
            unpack8(*(const u32x4*)(zr + BQ + h * 128 + sub * 8), x1); unpack8(*(const u32x4*)(zr + BQ + h * 128 + 64 + sub * 8), x2);
#pragma unroll
            for (int e = 0; e < 8; ++e) { o1[e] = x1[e] * cs[e] - x2[e] * sn[e]; o2[e] = x1[e] * sn[e] + x2[e] * cs[e]; }
            *(u32x4*)(zr + BQ + h * 128 + sub * 8) = pack8(o1); *(u32x4*)(zr + BQ + h * 128 + 64 + sub * 8) = pack8(o2);
            unpack8(*(const u32x4*)(zr + BK + h * 128 + sub * 8), x1); unpack8(*(const u32x4*)(zr + BK + h * 128 + 64 + sub * 8), x2);
#pragma unroll
            for (int e = 0; e < 8; ++e) { o1[e] = (x1[e] * cs[e] - x2[e] * sn[e]) * 0.08838834764831845f; o2[e] = (x1[e] * sn[e] + x2[e] * cs[e]) * 0.08838834764831845f; }
            *(u32x4*)(zr + BK + h * 128 + sub * 8) = pack8(o1); *(u32x4*)(zr + BK + h * 128 + 64 + sub * 8) = pack8(o2);
            if (prompt) {
                const float dk = __builtin_amdgcn_exp2f(gamma_l2(h) * (float)(63 - tok));
                const u32x4 va = *(const u32x4*)(zr + BV + h * 128 + sub * 8), vb = *(const u32x4*)(zr + BV + h * 128 + 64 + sub * 8);
#pragma unroll
                for (int e = 0; e < 8; ++e) { L0[(sub * 8 + e) * 72 + tok] = f2bf(o1[e] * dk); L0[(64 + sub * 8 + e) * 72 + tok] = f2bf(o2[e] * dk);
                    L1[(sub * 8 + e) * 72 + tok] = ((const unsigned short*)&va)[e]; L1[(64 + sub * 8 + e) * 72 + tok] = ((const unsigned short*)&vb)[e]; }
                __syncthreads();
                const int b = row >> 14, c = (r0 & (SEQ - 1)) >> 6;
                bf16_t* St = (bf16_t*)(P.ws + WS_XNB) + ((size_t)((b * 4 + h) * 256 + c)) * 16384;
                const bf16x8 vb0 = *(const LAS bf16x8*)(L1 + (16 * wave + fr) * 72 + 8 * fq), vb1 = *(const LAS bf16x8*)(L1 + (16 * wave + fr) * 72 + 32 + 8 * fq);
#pragma unroll
                for (int dkt = 0; dkt < 8; ++dkt) {
                    const bf16x8 ka0 = *(const LAS bf16x8*)(L0 + (16 * dkt + fr) * 72 + 8 * fq), ka1 = *(const LAS bf16x8*)(L0 + (16 * dkt + fr) * 72 + 32 + 8 * fq);
                    f32x4 a = (f32x4){0.f, 0.f, 0.f, 0.f};
                    a = __builtin_amdgcn_mfma_f32_16x16x32_bf16(ka0, vb0, a, 0, 0, 0); a = __builtin_amdgcn_mfma_f32_16x16x32_bf16(ka1, vb1, a, 0, 0, 0);
                    u32x2 w; w.x = cvt_pk_bf16(a[0], a[1]); w.y = cvt_pk_bf16(a[2], a[3]);
                    *(u32x2*)(St + (size_t)(16 * wave + fr) * 128 + 16 * dkt + 4 * fq) = w;
                }
#pragma unroll
                for (int q = 0; q < 2; ++q) { const int idx = tid + q * 512, i = idx >> 4, hh = (idx >> 3) & 1, pc = idx & 7;
                    const u32x4 w = *(const LAS u32x4*)(L1 + (64 * hh + i) * 72 + pc * 8);
                    *(u32x4*)(Z + (size_t)(r0 + i) * ZW + BV + h * 128 + hh * 64 + pc * 8) = w; }
                __syncthreads();
            }
        } else {
            bool first; const float* sh = nullptr;
            if (prompt) first = (row & (SEQ - 1)) == 0; else { first = (sr & 31) == 0; sh = PIN(8) + ((size_t)l * 32 + (sr >> 5)) * 1792; }
            const float* mu = PIN(14) + (size_t)l * 1792;
            bf16_t* LO = (bf16_t*)(P.ws + WS_LOB) + (size_t)row * 256;
#pragma unroll
            for (int ch = 0; ch < 4; ++ch) { const int lc = sub * 32 + ch * 8, cp = 1536 + lc; float cur[8], prv[8], o[8];
                unpack8(*(const u32x4*)(zr + CLO + lc), cur);
                if (!first) unpack8(*(const u32x4*)(zr - ZW + CLO + lc), prv);
                else {
#pragma unroll
                    for (int e = 0; e < 8; ++e) prv[e] = sh ? sh[cp + e] : 0.f; }
#pragma unroll
                for (int e = 0; e < 8; ++e) { const float c_ = cur[e] + (prv[e] - cur[e]) * mu[cp + e];
                    o[e] = (lc < 64) ? (1.f - 2.f * __builtin_amdgcn_rcpf(__expf(2.f * c_) + 1.f)) : (lc < 128 ? c_ : sigmoidf_(c_)); }
                *(u32x4*)(LO + lc) = pack8(o); }
            bool lastt; float* so;
            if (prompt) { lastt = (row & (SEQ - 1)) == SEQ - 1; so = P.out + O_SHP + (size_t)(l * 2 + (row >> 14)) * 1792; }
            else { lastt = (sr & 31) == 31; so = P.out + O_SHS + (size_t)(l * 32 + (sr >> 5)) * 1792; }
            if (lastt) { for (int q = 0; q < 28; ++q) { const int c0 = (sub * 28 + q) * 8; float f[8]; unpack8(*(const u32x4*)(zr + CR + c0), f);
                    *(f32x4*)(so + c0) = (f32x4){f[0], f[1], f[2], f[3]}; *(f32x4*)(so + c0 + 4) = (f32x4){f[4], f[5], f[6], f[7]}; } }
            if (tid < 192) *(u32x4*)((bf16_t*)(P.ws + WS_CZB) + (size_t)tile * 1536 + tid * 8) = *(const u32x4*)(Z + (size_t)(r0 + 63) * ZW + CR + tid * 8);
        }
    }
}

__device__ __forceinline__ void p2_phase(const Params& P, int l, LAS unsigned char* lds) {
    bf16_t* Z = (bf16_t*)(P.ws + WS_ZB);
    for (int it = bid_opaque(); it < 64 + 128; it += gridDim.x) {
        const int tid = tid_opaque(), lane = tid & 63, wave = tid >> 6;
#ifdef DBG_P2_SKIP_SAMPLE
        if (it >= 64) continue;
#endif
        if (it < 64) {
            const int e4 = it * 512 + tid, chain = e4 >> 12, idx = (e4 & 4095) * 4, h = chain & 3, b = chain >> 2;
            const float g64 = __builtin_amdgcn_exp2f(gamma_l2(h) * 64.f);
            bf16_t* St = (bf16_t*)(P.ws + WS_XNB) + (size_t)chain * 256 * 16384 + idx;
            float s0 = 0.f, s1 = 0.f, s2 = 0.f, s3 = 0.f;
#pragma unroll 16
            for (int c = 0; c < 256; ++c) { const u32x2 d = *(const u32x2*)(St + (size_t)c * 16384);
                s0 = s0 * g64 + bflo(d.x); s1 = s1 * g64 + bfhi(d.x); s2 = s2 * g64 + bflo(d.y); s3 = s3 * g64 + bfhi(d.y);
                u32x2 w; w.x = cvt_pk_bf16(s0, s1); w.y = cvt_pk_bf16(s2, s3); *(u32x2*)(St + (size_t)c * 16384) = w; }
            const int dv = idx >> 7, dk = idx & 127; float* o = P.out + O_RETP + ((size_t)((l * 2 + b) * 4 + h)) * 16384 + dv;
            o[(size_t)dk * 128] = s0; o[(size_t)(dk + 1) * 128] = s1; o[(size_t)(dk + 2) * 128] = s2; o[(size_t)(dk + 3) * 128] = s3;
        } else if (it < 192) {
            const int si = it - 64, s = si >> 2, h = si & 3, rb = T_P + s * 32;
            LAS float* q = (LAS float*)lds; LAS float* k = q + 4096; LAS float* v = k + 4096; LAS float* A = v + 4096; LAS float* ob = A + 1024;
            const float lg = gamma_l2(h);
            { const int n = tid >> 4, sg = tid & 15; const bf16_t* zr = Z + (size_t)(rb + n) * ZW + h * 128 + sg * 8; float f[8];
              const u32x4 wq = *(const u32x4*)(zr + BQ), wk = *(const u32x4*)(zr + BK), wv = *(const u32x4*)(zr + BV);
              unpack8(wq, f); *(LAS f32x4*)(q + n * 128 + sg * 8) = (f32x4){f[0], f[1], f[2], f[3]}; *(LAS f32x4*)(q + n * 128 + sg * 8 + 4) = (f32x4){f[4], f[5], f[6], f[7]};
              unpack8(wk, f); *(LAS f32x4*)(k + n * 128 + sg * 8) = (f32x4){f[0], f[1], f[2], f[3]}; *(LAS f32x4*)(k + n * 128 + sg * 8 + 4) = (f32x4){f[4], f[5], f[6], f[7]};
              unpack8(wv, f); *(LAS f32x4*)(v + n * 128 + sg * 8) = (f32x4){f[0], f[1], f[2], f[3]}; *(LAS f32x4*)(v + n * 128 + sg * 8 + 4) = (f32x4){f[4], f[5], f[6], f[7]}; }
            __syncthreads();
            for (int e = tid; e < 1024; e += 512) { const int n = e >> 5, m = e & 31; float a = 0.f;
                if (m <= n) {
#pragma unroll 8
                    for (int d = 0; d < 128; d += 4) { const f32x4 q4 = *(const LAS f32x4*)(q + n * 128 + d), k4 = *(const LAS f32x4*)(k + m * 128 + d); a += q4[0] * k4[0] + q4[1] * k4[1] + q4[2] * k4[2] + q4[3] * k4[3]; }
                    a *= __builtin_amdgcn_exp2f(lg * (float)(n - m)); }
                A[e] = a; }
            __syncthreads();
            const float* S0 = PIN(6) + ((size_t)((l * 32 + s) * 4 + h)) * 16384;
            { const int e = tid & 127, ng = tid >> 7; float acc[8];
#pragma unroll
              for (int i = 0; i < 8; ++i) acc[i] = 0.f;
#pragma unroll 4
              for (int d = 0; d < 128; d += 4) { const float s0 = S0[(size_t)d * 128 + e], s1 = S0[(size_t)(d + 1) * 128 + e], s2 = S0[(size_t)(d + 2) * 128 + e], s3 = S0[(size_t)(d + 3) * 128 + e];
#pragma unroll
                  for (int i = 0; i < 8; ++i) { const f32x4 q4 = *(const LAS f32x4*)(q + (ng * 8 + i) * 128 + d); acc[i] += q4[0] * s0 + q4[1] * s1 + q4[2] * s2 + q4[3] * s3; } }
#pragma unroll
              for (int i = 0; i < 8; ++i) { const int n = ng * 8 + i; float a = acc[i] * __builtin_amdgcn_exp2f(lg * (float)(n + 1));
                  for (int m = 0; m <= n; ++m) a += A[n * 32 + m] * v[m * 128 + e];
                  ob[n * 128 + e] = a; }
              const int dg = tid >> 7; float* so = P.out + O_RETS + ((size_t)((l * 32 + s) * 4 + h)) * 16384; const float g32 = __builtin_amdgcn_exp2f(lg * 32.f);
              float vd[32];
#pragma unroll
              for (int m = 0; m < 32; ++m) vd[m] = v[m * 128 + e] * __builtin_amdgcn_exp2f(lg * (float)(31 - m));
#pragma unroll 2
              for (int d = dg * 32; d < dg * 32 + 32; d += 4) { float a0 = g32 * S0[(size_t)d * 128 + e], a1 = g32 * S0[(size_t)(d + 1) * 128 + e], a2 = g32 * S0[(size_t)(d + 2) * 128 + e], a3 = g32 * S0[(size_t)(d + 3) * 128 + e];
#pragma unroll
                  for (int m = 0; m < 32; ++m) { const f32x4 k4 = *(const LAS f32x4*)(k + m * 128 + d); a0 += k4[0] * vd[m]; a1 += k4[1] * vd[m]; a2 += k4[2] * vd[m]; a3 += k4[3] * vd[m]; }
                  so[(size_t)d * 128 + e] = a0; so[(size_t)(d + 1) * 128 + e] = a1; so[(size_t)(d + 2) * 128 + e] = a2; so[(size_t)(d + 3) * 128 + e] = a3; }
            }
            __syncthreads();
            { const int e = tid & 127, ng = tid >> 7;
              for (int i = 0; i < 8; ++i) { const int n = ng * 8 + i; float ss = 0.f;
#pragma unroll 8
                  for (int d = 0; d < 128; d += 4) { const f32x4 o4 = *(const LAS f32x4*)(ob + n * 128 + d); ss += o4[0] * o4[0] + o4[1] * o4[1] + o4[2] * o4[2] + o4[3] * o4[3]; }
                  const float rs = rsqrtf(ss * (1.f / 128.f) + EPS); bf16_t* zr = Z + (size_t)(rb + n) * ZW + h * 128 + e; const float gt = bf2f(zr[BG]);
                  zr[BQ] = f2bf(ob[n * 128 + e] * rs * gt * sigmoidf_(gt)); } }
            __syncthreads();
        }
    }
}

__device__ __forceinline__ void sattn_item(const Params& P, int l, LAS unsigned char* lds, int si, int tid_in) {
    int tid = tid_in; asm volatile("" : "+v"(tid));
    const int lane = tid & 63, wave = tid >> 6;
    bf16_t* Z = (bf16_t*)(P.ws + WS_ZB);
    {
            const int s = si >> 4, h = (si >> 1) & 7, qh = si & 1, rb = T_P + s * 32, rq = rb + qh * 16;
            LAS float* q = (LAS float*)lds; LAS float* sc = q + 1024; LAS float* red = sc + 16 * 544;
            const float* ck = PIN(4) + ((size_t)(l * 32 + s) * 512) * 512 + h * 64; const float* cv = PIN(5) + ((size_t)(l * 32 + s) * 512) * 512 + h * 64;
            const float* bias = PIN(13) + (size_t)(l * 8 + h) * 320;
            for (int e = tid; e < 1024; e += 512) q[e] = bf2f(Z[(size_t)(rq + (e >> 6)) * ZW + AQ + h * 64 + (e & 63)]);
            __syncthreads();
            { const int key = tid; float kr[64];
#pragma unroll
                for (int d4 = 0; d4 < 16; ++d4) { const f32x4 t = *(const f32x4*)(ck + (size_t)key * 512 + d4 * 4); kr[d4 * 4] = t[0]; kr[d4 * 4 + 1] = t[1]; kr[d4 * 4 + 2] = t[2]; kr[d4 * 4 + 3] = t[3]; }
                for (int n = 0; n < 16; ++n) { float a = 0.f;
#pragma unroll
                    for (int d = 0; d < 64; ++d) a += q[n * 64 + d] * kr[d];
                    int rel = (512 + qh * 16 + n) - key; rel = rel > 256 ? 256 : rel;
                    sc[n * 544 + key] = a * 0.125f + bias[rel + 63]; } }
            { const int key = 512 + (tid & 31), n = tid >> 5; float kr[64];
#pragma unroll
                for (int d8 = 0; d8 < 8; ++d8) unpack8(*(const u32x4*)(Z + (size_t)(rb + key - 512) * ZW + AK + h * 64 + d8 * 8), kr + d8 * 8);
                float a = 0.f;
#pragma unroll
                for (int d = 0; d < 64; ++d) a += q[n * 64 + d] * kr[d];
                const int rel = (512 + qh * 16 + n) - key;
                sc[n * 544 + key] = a * 0.125f + bias[rel + 63]; }
            __syncthreads();
            for (int n = wave * 2; n < wave * 2 + 2; ++n) { float mx = -1e30f;
                for (int kx = lane; kx < 544; kx += 64) mx = fmaxf(mx, sc[n * 544 + kx]);
#pragma unroll
                for (int o = 1; o < 64; o <<= 1) mx = fmaxf(mx, __shfl_xor(mx, o));
                float sm = 0.f;
                for (int kx = lane; kx < 544; kx += 64) { const float p = __expf(sc[n * 544 + kx] - mx); sc[n * 544 + kx] = p; sm += p; }
                sm = wave_sum(sm); const float inv = 1.f / sm;
                for (int kx = lane; kx < 544; kx += 64) sc[n * 544 + kx] *= inv; }
            __syncthreads();
            { const int d = tid & 63, kg = tid >> 6; float a[16];
#pragma unroll
              for (int n = 0; n < 16; ++n) a[n] = 0.f;
              float vv[68];
#pragma unroll
              for (int i = 0; i < 68; ++i) { const int key = kg * 68 + i; vv[i] = key < 512 ? cv[(size_t)key * 512 + d] : bf2f(Z[(size_t)(rb + key - 512) * ZW + AV + h * 64 + d]); }
#pragma unroll
              for (int i = 0; i < 68; i += 4)
#pragma unroll
                  for (int n = 0; n < 16; ++n) { const f32x4 p4 = *(const LAS f32x4*)(sc + n * 544 + kg * 68 + i); a[n] += p4[0] * vv[i] + p4[1] * vv[i + 1] + p4[2] * vv[i + 2] + p4[3] * vv[i + 3]; }
#pragma unroll
              for (int n = 0; n < 16; ++n) red[(kg * 16 + n) * 64 + d] = a[n]; }
            __syncthreads();
            for (int e = tid; e < 1024; e += 512) { const int n = e >> 6, d = e & 63; float a = 0.f;
#pragma unroll
                for (int kg = 0; kg < 8; ++kg) a += red[(kg * 16 + n) * 64 + d];
                Z[(size_t)(rq + n) * ZW + AQ + h * 64 + d] = f2bf(a); }
            __syncthreads();
    }
}

__device__ __forceinline__ void p3_phase(const Params& P, int l, LAS unsigned char* lds) {
    const int tid = tid_opaque(), lane = tid & 63, wave = tid >> 6, fr = lane & 15, fq = lane >> 4;
    bf16_t* Z = (bf16_t*)(P.ws + WS_ZB);
    {
        const int qs = wave & 3, dh = wave >> 2;
        LAS bf16_t* SL = (LAS bf16_t*)lds;
        LAS bf16_t* KL = (LAS bf16_t*)(lds + 34816);
        LAS bf16_t* VL = (LAS bf16_t*)(lds + 52224);
        LAS float* XL = (LAS float*)(lds + 70656);
        u32x4 gs[4], gk[2], gv[2];
#define RT_LOAD(it_) do { const int h_ = (it_) & 3, c_ = ((it_) >> 2) & 255, b_ = (it_) >> 10; const size_t cb_ = (size_t)(b_ * SEQ + c_ * 64); \
        const bf16_t* St_ = (const bf16_t*)(P.ws + WS_XNB) + ((size_t)((b_ * 4 + h_) * 256 + (c_ > 0 ? c_ - 1 : 0))) * 16384; \
        _Pragma("unroll") for (int i_ = 0; i_ < 4; ++i_) { const int p_ = tid + 512 * i_; gs[i_] = *(const u32x4*)(St_ + (p_ >> 4) * 128 + (p_ & 15) * 8); } \
        _Pragma("unroll") for (int i_ = 0; i_ < 2; ++i_) { const int p_ = tid + 512 * i_, r_ = p_ >> 4, sg_ = p_ & 15; gk[i_] = *(const u32x4*)(Z + (cb_ + r_) * ZW + BK + h_ * 128 + sg_ * 8); gv[i_] = *(const u32x4*)(Z + (cb_ + r_) * ZW + BV + h_ * 128 + sg_ * 8); } } while (0)
#define RT_WRITE() do { _Pragma("unroll") for (int i_ = 0; i_ < 4; ++i_) { const int p_ = tid + 512 * i_; *(LAS u32x4*)(SL + (p_ >> 4) * 136 + (p_ & 15) * 8) = gs[i_]; } \
        _Pragma("unroll") for (int i_ = 0; i_ < 2; ++i_) { const int p_ = tid + 512 * i_, r_ = p_ >> 4, sg_ = p_ & 15; *(LAS u32x4*)(KL + r_ * 136 + sg_ * 8) = gk[i_]; *(LAS u32x4*)(VL + ((sg_ >> 3) * 64 + r_) * 72 + (sg_ & 7) * 8) = gv[i_]; } } while (0)
        int it = bid_opaque();
        if (it < 2048) RT_LOAD(it);
        for (; it < 2048; it += gridDim.x) {
            const int h = it & 3, c = (it >> 2) & 255, b = it >> 10;
            const int cb = b * SEQ + c * 64, qrow = cb + qs * 16 + fr; const float lg = gamma_l2(h);
            bf16x8 qf[4];
#pragma unroll
            for (int kk = 0; kk < 4; ++kk) qf[kk] = *(const bf16x8*)(Z + (size_t)qrow * ZW + BQ + h * 128 + 32 * kk + 8 * fq);
            RT_WRITE();
            __syncthreads();
            if (it + (int)gridDim.x < 2048) RT_LOAD(it + (int)gridDim.x);
            f32x4 acc[4];
#pragma unroll
            for (int dt = 0; dt < 4; ++dt) acc[dt] = (f32x4){0.f, 0.f, 0.f, 0.f};
            if (c > 0) {
#pragma unroll
                for (int dt = 0; dt < 4; ++dt)
#pragma unroll
                    for (int kk = 0; kk < 4; ++kk) acc[dt] = __builtin_amdgcn_mfma_f32_16x16x32_bf16(*(const LAS bf16x8*)(SL + (16 * (4 * dh + dt) + fr) * 136 + 32 * kk + 8 * fq), qf[kk], acc[dt], 0, 0, 0);
                const float dq = __builtin_amdgcn_exp2f(lg * (float)(qs * 16 + fr + 1));
#pragma unroll
                for (int dt = 0; dt < 4; ++dt) acc[dt] = acc[dt] * dq;
            }
            const int nu = (qs >> 1) + 1;
            for (int u = 0; u < nu; ++u) {
                unsigned pw[4];
#pragma unroll
                for (int t = 0; t < 2; ++t) { f32x4 sc_ = (f32x4){0.f, 0.f, 0.f, 0.f};
#pragma unroll
                    for (int kk = 0; kk < 4; ++kk) sc_ = __builtin_amdgcn_mfma_f32_16x16x32_bf16(*(const LAS bf16x8*)(KL + (32 * u + 16 * t + fr) * 136 + 32 * kk + 8 * fq), qf[kk], sc_, 0, 0, 0);
                    float pv[4];
#pragma unroll
                    for (int j = 0; j < 4; ++j) { const int n = qs * 16 + fr, m = 32 * u + 16 * t + 4 * fq + j; pv[j] = (m <= n) ? sc_[j] * __builtin_amdgcn_exp2f(lg * (float)(n - m)) : 0.f; }
                    pw[t * 2] = cvt_pk_bf16(pv[0], pv[1]); pw[t * 2 + 1] = cvt_pk_bf16(pv[2], pv[3]); }
                u32x4 w4; w4.x = pw[0]; w4.y = pw[1]; w4.z = pw[2]; w4.w = pw[3]; const bf16x8 pf = __builtin_bit_cast(bf16x8, w4);
#pragma unroll
                for (int dt = 0; dt < 4; ++dt) { const LAS bf16_t* vp = VL + (16 * (4 * dh + dt) + fr) * 72 + 32 * u + 4 * fq;
                    const u32x2 v0 = *(const LAS u32x2*)vp, v1 = *(const LAS u32x2*)(vp + 16); u32x4 w; w.x = v0.x; w.y = v0.y; w.z = v1.x; w.w = v1.y;
                    acc[dt] = __builtin_amdgcn_mfma_f32_16x16x32_bf16(__builtin_bit_cast(bf16x8, w), pf, acc[dt], 0, 0, 0); }
            }
            float ss = 0.f;
#pragma unroll
            for (int dt = 0; dt < 4; ++dt) ss += acc[dt][0] * acc[dt][0] + acc[dt][1] * acc[dt][1] + acc[dt][2] * acc[dt][2] + acc[dt][3] * acc[dt][3];
            ss += __shfl_xor(ss, 16); ss += __shfl_xor(ss, 32);
            if (fq == 0) XL[(qs * 2 + dh) * 16 + fr] = ss;
            __syncthreads();
            const float rs = rsqrtf((XL[(qs * 2) * 16 + fr] + XL[(qs * 2 + 1) * 16 + fr]) * (1.f / 128.f) + EPS);
#pragma unroll
            for (int dt = 0; dt < 4; ++dt) { const int dvc = 16 * (4 * dh + dt) + 4 * fq; const u32x2 gw = *(const u32x2*)(Z + (size_t)qrow * ZW + BG + h * 128 + dvc);
                const float g0 = bflo(gw.x), g1 = bfhi(gw.x), g2 = bflo(gw.y), g3 = bfhi(gw.y); u32x2 w;
                w.x = cvt_pk_bf16(acc[dt][0] * rs * g0 * sigmoidf_(g0), acc[dt][1] * rs * g1 * sigmoidf_(g1)); w.y = cvt_pk_bf16(acc[dt][2] * rs * g2 * sigmoidf_(g2), acc[dt][3] * rs * g3 * sigmoidf_(g3));
                *(u32x2*)(Z + (size_t)qrow * ZW + BQ + h * 128 + dvc) = w; }
        }
        __syncthreads();
    }
}

__device__ __forceinline__ void attn_item(const Params& P, int l, LAS unsigned char* lds, int it, int tid) {
    const int lane = tid & 63, wave = tid >> 6, fr = lane & 15, fq = lane >> 4;
    bf16_t* Z = (bf16_t*)(P.ws + WS_ZB);
    {

            const int ia = it - 1024, hp = ia & 3, c = (ia >> 2) & 255, b = ia >> 10, hsel = wave >> 2, h = hp * 2 + hsel, qs = wave & 3;
            const int sb = b * SEQ, qpos = c * 64 + qs * 16 + fr; const size_t qrow = (size_t)(sb + qpos);
            LAS bf16_t* KS = (LAS bf16_t*)lds;
            LAS bf16_t* VS = (LAS bf16_t*)(lds + 36864);
            LAS float* BL = (LAS float*)(lds + 73728);
            const bf16x8 q0 = *(const bf16x8*)(Z + qrow * ZW + AQ + h * 64 + 8 * fq), q1 = *(const bf16x8*)(Z + qrow * ZW + AQ + h * 64 + 32 + 8 * fq);
            f32x4 acc[4];
#pragma unroll
            for (int dt = 0; dt < 4; ++dt) acc[dt] = (f32x4){0.f, 0.f, 0.f, 0.f};
            float mrun = -1e30f, lrun = 0.f;
            const int jlo = c >= 8 ? 0 : 8 - c;
            u32x4 gk[2], gv[2];
#define AT_LOAD(j_) do { const size_t rb_ = (size_t)(sb + (c - 8 + (j_)) * 64); _Pragma("unroll") for (int i_ = 0; i_ < 2; ++i_) { const int p_ = tid + 512 * i_, hd_ = p_ >> 9, r_ = (p_ >> 3) & 63, sg_ = p_ & 7; \
        gk[i_] = *(const u32x4*)(Z + (rb_ + r_) * ZW + AK + (hp * 2 + hd_) * 64 + sg_ * 8); gv[i_] = *(const u32x4*)(Z + (rb_ + r_) * ZW + AV + (hp * 2 + hd_) * 64 + sg_ * 8); } } while (0)
#define AT_WRITE(st_) do { _Pragma("unroll") for (int i_ = 0; i_ < 2; ++i_) { const int p_ = tid + 512 * i_, hd_ = p_ >> 9, r_ = (p_ >> 3) & 63, sg_ = p_ & 7; \
        *(LAS u32x4*)(KS + ((st_) * 2 + hd_) * 4608 + r_ * 72 + sg_ * 8) = gk[i_]; *(LAS u32x4*)(VS + ((st_) * 2 + hd_) * 4608 + r_ * 72 + sg_ * 8) = gv[i_]; } } while (0)
            AT_LOAD(jlo);
            for (int e = tid; e < 640; e += 512) BL[e] = PIN(13)[(size_t)(l * 8 + hp * 2) * 320 + e] * 1.4426950408889634f;
            AT_WRITE(0);
            __syncthreads();
            for (int j = jlo; j < 9; ++j) {
                const int st = (j - jlo) & 1;
                if (j < 8) AT_LOAD(j + 1);
                const LAS bf16_t* ks = KS + (st * 2 + hsel) * 4608; const LAS bf16_t* vs = VS + (st * 2 + hsel) * 4608; const LAS float* bl = BL + hsel * 320;
#pragma unroll
                for (int u = 0; u < 2; ++u) {
                    const int kb = (c - 8 + j) * 64 + 32 * u;
                    float sv[8];
#pragma unroll
                    for (int t = 0; t < 2; ++t) { const LAS bf16_t* kp = ks + (32 * u + 16 * t + fr) * 72 + 8 * fq;
                        f32x4 sc_ = (f32x4){0.f, 0.f, 0.f, 0.f};
                        sc_ = __builtin_amdgcn_mfma_f32_16x16x32_bf16(*(const LAS bf16x8*)kp, q0, sc_, 0, 0, 0); sc_ = __builtin_amdgcn_mfma_f32_16x16x32_bf16(*(const LAS bf16x8*)(kp + 32), q1, sc_, 0, 0, 0);
                        if (j <= 3) {
                            const float bc = bl[319];
#pragma unroll
                            for (int jj = 0; jj < 4; ++jj) sv[t * 4 + jj] = sc_[jj] * 0.18033688011112042f + bc;
                        } else {
#pragma unroll
                            for (int jj = 0; jj < 4; ++jj) { int rel = qpos - (kb + 16 * t + 4 * fq + jj); rel = rel > 256 ? 256 : rel; sv[t * 4 + jj] = sc_[jj] * 0.18033688011112042f + bl[rel + 63]; }
                        } }
                    float mx = sv[0];
#pragma unroll
                    for (int e = 1; e < 8; ++e) mx = fmaxf(mx, sv[e]);
                    mx = fmaxf(mx, __shfl_xor(mx, 16)); mx = fmaxf(mx, __shfl_xor(mx, 32));
                    const float mnew = fmaxf(mrun, mx), alpha = __builtin_amdgcn_exp2f(mrun - mnew); mrun = mnew;
                    float ps = 0.f;
#pragma unroll
                    for (int e = 0; e < 8; ++e) { sv[e] = __builtin_amdgcn_exp2f(sv[e] - mnew); ps += sv[e]; }
                    lrun = lrun * alpha + ps;
                    u32x4 pw; pw.x = cvt_pk_bf16(sv[0], sv[1]); pw.y = cvt_pk_bf16(sv[2], sv[3]); pw.z = cvt_pk_bf16(sv[4], sv[5]); pw.w = cvt_pk_bf16(sv[6], sv[7]);
                    const bf16x8 pf = __builtin_bit_cast(bf16x8, pw);
#pragma unroll
                    for (int dt = 0; dt < 4; ++dt) { const LAS bf16_t* vp = vs + (16 * dt + fr) * 72 + 32 * u + 4 * fq;
                        const u32x2 v0 = *(const LAS u32x2*)vp, v1 = *(const LAS u32x2*)(vp + 16); u32x4 w; w.x = v0.x; w.y = v0.y; w.z = v1.x; w.w = v1.y;
                        acc[dt] = acc[dt] * alpha;
                        acc[dt] = __builtin_amdgcn_mfma_f32_16x16x32_bf16(__builtin_bit_cast(bf16x8, w), pf, acc[dt], 0, 0, 0); }
                }
                if (j < 8) AT_WRITE(st ^ 1);
                __syncthreads();
            }
            lrun += __shfl_xor(lrun, 16); lrun += __shfl_xor(lrun, 32);
            const float inv = 1.f / lrun;
#pragma unroll
            for (int dt = 0; dt < 4; ++dt) { u32x2 w; w.x = cvt_pk_bf16(acc[dt][0] * inv, acc[dt][1] * inv); w.y = cvt_pk_bf16(acc[dt][2] * inv, acc[dt][3] * inv);
                *(u32x2*)(Z + qrow * ZW + AQ + h * 64 + 16 * dt + 4 * fq) = w; }
    }
}

__device__ __forceinline__ void c2_phase(const Params& P, int l, LAS unsigned char* lds) {
    const int tid = tid_opaque(), tok = tid >> 3, sub = tid & 7;
    bf16_t* Z = (bf16_t*)(P.ws + WS_ZB); bf16_t* XW = (bf16_t*)(P.ws + WS_XNB);
    (void)lds;
    for (int it = bid_opaque(); it < 528 * 4; it += gridDim.x) {
        const int tile = it >> 2, hp = it & 3, r0 = tile * 64, row = r0 + tok; const bool prompt = tile < 512; const int sr = row - T_P;
        const bool sfirst = !prompt && (sr & 31) == 0; const float* sh = sfirst ? PIN(8) + ((size_t)l * 32 + (sr >> 5)) * 1792 : nullptr;
        const bool pzero = prompt && tok == 0 && (r0 & (SEQ - 1)) == 0;
        const bf16_t* prow = (tok > 0) ? Z + (size_t)(row - 1) * ZW + CR : (const bf16_t*)(P.ws + WS_CZB) + (size_t)(tile > 0 ? tile - 1 : 0) * 1536;
        u32x4 cu[2][3], pv_[2][3], wa[2][2];
#pragma unroll
        for (int q = 0; q < 2; ++q) { const int hc = (hp * 2 + q) * 64 + sub * 8;
#pragma unroll
            for (int part = 0; part < 3; ++part) { cu[q][part] = *(const u32x4*)(Z + (size_t)row * ZW + CR + part * 512 + hc); pv_[q][part] = *(const u32x4*)(prow + part * 512 + hc); }
            wa[q][0] = *(const u32x4*)(XW + (size_t)row * DM + hc); wa[q][1] = *(const u32x4*)(XW + (size_t)row * DM + 512 + hc); }
        asm volatile("s_waitcnt vmcnt(0)" ::: "memory");
        __syncthreads();
        const float* mu = PIN(14) + (size_t)l * 1792;
#pragma unroll
        for (int q = 0; q < 2; ++q) { const int h = hp * 2 + q, hc = h * 64 + sub * 8;
            float r[8], k[8], v[8], wr_[8], ar_[8], kk[8], pr[8], pk[8], pvv[8];
            unpack8(cu[q][0], r); unpack8(cu[q][1], k); unpack8(cu[q][2], v); unpack8(pv_[q][0], pr); unpack8(pv_[q][1], pk); unpack8(pv_[q][2], pvv); unpack8(wa[q][0], wr_); unpack8(wa[q][1], ar_);
#pragma unroll
            for (int e = 0; e < 8; ++e) { float a_ = pr[e], b_ = pk[e], c_ = pvv[e];
                if (sfirst) { a_ = sh[hc + e]; b_ = sh[512 + hc + e]; c_ = sh[1024 + hc + e]; } else if (pzero) { a_ = 0.f; b_ = 0.f; c_ = 0.f; }
                r[e] = r[e] + (a_ - r[e]) * mu[hc + e]; k[e] = k[e] + (b_ - k[e]) * mu[512 + hc + e]; v[e] = v[e] + (c_ - v[e]) * mu[1024 + hc + e]; }
            const float* w0 = PIN(15) + l * 512 + hc; const float* a0 = PIN(17) + l * 512 + hc; const float* kkw = PIN(20) + l * 512 + hc; const float* kaw = PIN(21) + l * 512 + hc; const float* rk = PIN(22) + l * 512 + hc;
            float ss = 0.f, bn = 0.f;
#pragma unroll
            for (int e = 0; e < 8; ++e) { kk[e] = k[e] * kkw[e]; ss += kk[e] * kk[e]; }
            const float rn = rsqrtf(fmaxf(sum8(ss), 1e-24f));
#pragma unroll
            for (int e = 0; e < 8; ++e) { const float a = sigmoidf_(a0[e] + ar_[e]); const float ew = 0.6065306597126334f * sigmoidf_(w0[e] + wr_[e]);
                kk[e] *= rn; k[e] = k[e] * (1.f + (a - 1.f) * kaw[e]); bn += r[e] * k[e] * rk[e]; wr_[e] = ew; ar_[e] = kk[e] * a; }
            bn = sum8(bn);
            *(u32x4*)(Z + (size_t)row * ZW + CR + hc) = pack8(r); *(u32x4*)(Z + (size_t)row * ZW + CK + hc) = pack8(k); *(u32x4*)(Z + (size_t)row * ZW + CV + hc) = pack8(v);
            *(u32x4*)(Z + (size_t)row * ZW + BV + hc) = pack8(kk); *(u32x4*)(XW + (size_t)row * DM + hc) = pack8(wr_); *(u32x4*)(XW + (size_t)row * DM + 512 + hc) = pack8(ar_);
            if (sub == 0) ((float*)(P.ws + WS_BONUS))[(size_t)row * 8 + h] = bn; }
        __syncthreads();
    }
}

__device__ __forceinline__ void scan_phase(const Params& P, int l, LAS unsigned char* lds) {
    const int tid = tid_opaque(), lane = tid & 63, wave = tid >> 6;
    bf16_t* Z = (bf16_t*)(P.ws + WS_ZB); const bf16_t* XW = (const bf16_t*)(P.ws + WS_XNB);
    LAS float* buf = (LAS float*)lds;
    LAS float* ybuf = (LAS float*)(lds + 86016);
    const int bid_ = bid_opaque(), nidle_ = (int)gridDim.x > 192 ? (int)gridDim.x - 192 : 0;
    for (int it = (bid_ < 192 || nidle_ == 0) ? bid_ : 192 + (bid_ - 192); it < 192 + 1024; it += (bid_ < 192 ? (nidle_ ? 100000 : (int)gridDim.x) : nidle_)) {
        int rowbase, nsteps, h, qt, part = 0; const float* S0 = nullptr; float* So; bf16_t* yout; size_t ypitch = ZW;
        if (it < 192) { const int chain = it / 12, sub12 = it % 12, b = chain >> 3; h = chain & 7; part = sub12 >> 2; qt = sub12 & 3; nsteps = SEQ / 2; rowbase = b * SEQ + (part ? SEQ / 2 : 0);
            So = (float*)(P.ws + (part == 0 ? WS_SMID : (part == 1 ? WS_SP1 : WS_PHI))) + (size_t)chain * 4096;
            if (part < 2) yout = Z + (size_t)rowbase * ZW + BK + h * 64 + qt * 16; else { yout = (bf16_t*)(P.ws + WS_YPHI) + (size_t)b * (SEQ / 2) * 512 + h * 64 + qt * 16; ypitch = 512; } }
        else { const int si = it - 192, s = si >> 5; h = (si >> 2) & 7; qt = si & 3; rowbase = T_P + s * 32; nsteps = 32; S0 = PIN(7) + ((size_t)((l * 32 + s) * 8 + h)) * 4096; So = P.out + O_RWS + ((size_t)((l * 32 + s) * 8 + h)) * 4096;
            yout = Z + (size_t)rowbase * ZW + BK + h * 64 + qt * 16; }
        const int i0 = qt * 16, nb = nsteps >> 5;
        const int lt = tid - 256, lstep = lt >> 3, lsub = lt & 7;
        const int rr = lane >> 4, jl = lane & 15, li = 4 * wave + rr;
        f32x2v Sa = {0.f, 0.f}, Sb = {0.f, 0.f};
        u32x4 g_ew = {0u,0u,0u,0u}, g_k = g_ew, g_kk = g_ew, g_ka = g_ew, g_r = g_ew, g_v = g_ew;
        if (wave < 4 && S0) { const f32x4 s4 = *(const f32x4*)(S0 + (size_t)(i0 + li) * 64 + 4 * jl); Sa = (f32x2v){s4[0], s4[1]}; Sb = (f32x2v){s4[2], s4[3]}; }
        if (part == 2) { const int d_ = i0 + li - 4 * jl; Sa = (f32x2v){d_ == 0 ? 1.f : 0.f, d_ == 1 ? 1.f : 0.f}; Sb = (f32x2v){d_ == 2 ? 1.f : 0.f, d_ == 3 ? 1.f : 0.f}; }
        for (int bb = -1; bb < nb; ++bb) {
            if (wave >= 4) {
#define SC_LOAD(bt) do { const size_t row_ = (size_t)(rowbase + (bt) * 32 + lstep); g_ew = *(const u32x4*)(XW + row_ * DM + h * 64 + lsub * 8); g_k = *(const u32x4*)(Z + row_ * ZW + CK + h * 64 + lsub * 8); \
        g_kk = *(const u32x4*)(Z + row_ * ZW + BV + h * 64 + lsub * 8); g_ka = *(const u32x4*)(XW + row_ * DM + 512 + h * 64 + lsub * 8); g_r = *(const u32x4*)(Z + row_ * ZW + CR + h * 64 + lsub * 8); \
        if (lsub < 2 && part != 2) g_v = *(const u32x4*)(Z + row_ * ZW + CV + h * 64 + i0 + lsub * 8); } while (0)
#define SC_WRITE(bt) do { LAS float* d = buf + ((bt) & 1) * 10752 + lstep * 336; float f[8]; unpack8(g_ew, f); \
        *(LAS f32x4*)(d + lsub * 8) = (f32x4){__expf(-f[0]), __expf(-f[1]), __expf(-f[2]), __expf(-f[3])}; *(LAS f32x4*)(d + lsub * 8 + 4) = (f32x4){__expf(-f[4]), __expf(-f[5]), __expf(-f[6]), __expf(-f[7])}; \
        unpack8(g_k, f); *(LAS f32x4*)(d + 64 + lsub * 8) = (f32x4){f[0], f[1], f[2], f[3]}; *(LAS f32x4*)(d + 64 + lsub * 8 + 4) = (f32x4){f[4], f[5], f[6], f[7]}; \
        unpack8(g_kk, f); *(LAS f32x4*)(d + 128 + lsub * 8) = (f32x4){f[0], f[1], f[2], f[3]}; *(LAS f32x4*)(d + 128 + lsub * 8 + 4) = (f32x4){f[4], f[5], f[6], f[7]}; \
        unpack8(g_ka, f); *(LAS f32x4*)(d + 192 + lsub * 8) = (f32x4){f[0], f[1], f[2], f[3]}; *(LAS f32x4*)(d + 192 + lsub * 8 + 4) = (f32x4){f[4], f[5], f[6], f[7]}; \
        unpack8(g_r, f); *(LAS f32x4*)(d + 256 + lsub * 8) = (f32x4){f[0], f[1], f[2], f[3]}; *(LAS f32x4*)(d + 256 + lsub * 8 + 4) = (f32x4){f[4], f[5], f[6], f[7]}; \
        if (lsub < 2) { unpack8(g_v, f); *(LAS f32x4*)(d + 320 + lsub * 8) = (f32x4){f[0], f[1], f[2], f[3]}; *(LAS f32x4*)(d + 320 + lsub * 8 + 4) = (f32x4){f[4], f[5], f[6], f[7]}; } } while (0)
                if (bb == -1) { SC_LOAD(0); SC_WRITE(0); if (nb > 1) SC_LOAD(1); }
                else { if (bb + 1 < nb) SC_WRITE(bb + 1); if (bb + 2 < nb) SC_LOAD(bb + 2); }
                if (bb >= 1 && lsub < 2) {
                    const LAS float* y = ybuf + ((bb - 1) & 1) * 512 + lstep * 16 + lsub * 8; float f[8];
#pragma unroll
                    for (int e = 0; e < 8; ++e) f[e] = y[e];
                    *(u32x4*)(yout + (size_t)((bb - 1) * 32 + lstep) * ypitch + lsub * 8) = pack8(f);
                }
            } else if (bb >= 0) {
                __builtin_amdgcn_s_setprio(3);
                const LAS float* bp = buf + (bb & 1) * 10752 + 4 * jl; const LAS float* vp_ = buf + (bb & 1) * 10752 + 320 + li; LAS float* yb = ybuf + (bb & 1) * 512;
                float ysel = 0.f, yprev = 0.f;
                f32x4 cw = *(const LAS f32x4*)(bp), ck_ = *(const LAS f32x4*)(bp + 64), ckk = *(const LAS f32x4*)(bp + 128), cka = *(const LAS f32x4*)(bp + 192), cr = *(const LAS f32x4*)(bp + 256); float cv = vp_[0];
                f32x2v m = Sa * (f32x2v){ckk[0], ckk[1]}; m = Sb * (f32x2v){ckk[2], ckk[3]} + m;
                float a = m.x + m.y;
#pragma unroll
                for (int st = 0; st < 32; ++st) {
                    const int sn = (st + 1 < 32) ? st + 1 : st;
                    const f32x4 nw = *(const LAS f32x4*)(bp + sn * 336), nk = *(const LAS f32x4*)(bp + sn * 336 + 64), nkk = *(const LAS f32x4*)(bp + sn * 336 + 128), nka = *(const LAS f32x4*)(bp + sn * 336 + 192), nr = *(const LAS f32x4*)(bp + sn * 336 + 256); const float nv = vp_[sn * 336];
                    float b = yprev;
                    a += dppf<0xB1>(a); b += dppf<0xB1>(b); a += dppf<0x4E>(a); b += dppf<0x4E>(b); a += dppf<0x141>(a); b += dppf<0x141>(b); a += dppf<0x140>(a); b += dppf<0x140>(b);
                    if (st > 0) { ysel = (jl == ((st - 1) & 3)) ? b : ysel; if (((st - 1) & 3) == 3 && jl < 4) yb[(st - 4 + jl) * 16 + li] = ysel; }
                    const float nsa = -a; const f32x2v vi2 = {cv, cv}, ns2 = {nsa, nsa};
                    const f32x2v ta = (f32x2v){cka[0], cka[1]} * ns2 + (f32x2v){ck_[0], ck_[1]} * vi2, tb = (f32x2v){cka[2], cka[3]} * ns2 + (f32x2v){ck_[2], ck_[3]} * vi2;
                    Sa = Sa * (f32x2v){cw[0], cw[1]} + ta; Sb = Sb * (f32x2v){cw[2], cw[3]} + tb;
                    f32x2v ym = Sa * (f32x2v){cr[0], cr[1]}; ym = Sb * (f32x2v){cr[2], cr[3]} + ym; yprev = ym.x + ym.y;
                    f32x2v mm = Sa * (f32x2v){nkk[0], nkk[1]}; mm = Sb * (f32x2v){nkk[2], nkk[3]} + mm; a = mm.x + mm.y;
                    cw = nw; ck_ = nk; ckk = nkk; cka = nka; cr = nr; cv = nv;
                }
                { float b = red16(yprev); ysel = (jl == 3) ? b : ysel; if (jl < 4) yb[(28 + jl) * 16 + li] = ysel; }
                __builtin_amdgcn_s_setprio(0);
            }
            __syncthreads();
        }
        if (wave >= 4 && lsub < 2) { const LAS float* y = ybuf + ((nb - 1) & 1) * 512 + lstep * 16 + lsub * 8; float f[8];
#pragma unroll
            for (int e = 0; e < 8; ++e) f[e] = y[e];
            *(u32x4*)(yout + (size_t)((nb - 1) * 32 + lstep) * ypitch + lsub * 8) = pack8(f); }
        if (wave < 4) *(f32x4*)(So + (size_t)(i0 + li) * 64 + 4 * jl) = (f32x4){Sa.x, Sa.y, Sb.x, Sb.y};
        __syncthreads();
    }
    {
        unsigned* ctr = (unsigned*)(P.ws + 14336) + l;
        LAS int* slot = (LAS int*)(lds + 131072 + 1024);
        int nxt = 0;
        if (tid == 0) nxt = (int)atomicAdd(ctr, 1u);
        for (;;) {
            __syncthreads();
            if (tid == 0) { slot[0] = nxt; nxt = (int)atomicAdd(ctr, 1u); }
            __syncthreads();
            const int idx = slot[0];
            if (idx >= 512 + 2048) break;
            if (idx < 512) sattn_item(P, l, lds, idx, tid); else attn_item(P, l, lds, 1024 + idx - 512, tid);
        }
    }
}

__device__ __forceinline__ void e2_phase(const Params& P, int l) {
    const int tid = tid_opaque(), tok = tid >> 3, sub = tid & 7;
    bf16_t* Z = (bf16_t*)(P.ws + WS_ZB);
    {
        const float* SM = (const float*)(P.ws + WS_SMID); const float* S1 = (const float*)(P.ws + WS_SP1); const float* PH = (const float*)(P.ws + WS_PHI);
        const int hb_ = (int)gridDim.x >= 256 ? 128 : 0;
        for (int e = (bid_opaque() - hb_) * 512 + tid; e >= 0 && e < 16 * 4096; e += ((int)gridDim.x - hb_) * 512) { const int chain = e >> 12, i = (e >> 6) & 63, j = e & 63; float a = S1[e];
#pragma unroll 16
            for (int m = 0; m < 64; ++m) a += SM[chain * 4096 + i * 64 + m] * PH[chain * 4096 + m * 64 + j];
            P.out[O_RWP + (size_t)(l * 16 + chain) * 4096 + i * 64 + j] = a; }
    }
    const int wave = tid >> 6, lane = tid & 63, fr = lane & 15, fq = lane >> 4, tt = wave & 3, ih = wave >> 2;
    for (int t_ = bid_opaque(); t_ < 528; t_ += gridDim.x) {
        const int tile = (t_ >= 256 && t_ < 512) ? 256 + ((t_ - 256) ^ 128) : t_;
        if (tile < 512 && (tile & 255) >= 128) {
            const int b = tile >> 8, tl = ((tile & 255) - 128) * 64 + tt * 16 + fr;
            for (int h = 0; h < 8; ++h) {
                const float* SM = (const float*)(P.ws + WS_SMID) + (size_t)(b * 8 + h) * 4096;
                const bf16_t* yp = (const bf16_t*)(P.ws + WS_YPHI) + ((size_t)b * (SEQ / 2) + tl) * 512 + h * 64;
                const bf16x8 yb0 = *(const bf16x8*)(yp + 8 * fq), yb1 = *(const bf16x8*)(yp + 32 + 8 * fq);
                bf16_t* yrow = Z + (size_t)(b * SEQ + SEQ / 2 + tl) * ZW + BK + h * 64;
#pragma unroll
                for (int q = 0; q < 2; ++q) { const int i = (ih * 2 + q) * 16 + fr; f32x4 acc = (f32x4){0.f, 0.f, 0.f, 0.f};
#pragma unroll
                    for (int kk = 0; kk < 2; ++kk) { const f32x4 s0 = *(const f32x4*)(SM + i * 64 + 32 * kk + 8 * fq), s1 = *(const f32x4*)(SM + i * 64 + 32 * kk + 8 * fq + 4);
                        u32x4 w; w.x = cvt_pk_bf16(s0[0], s0[1]); w.y = cvt_pk_bf16(s0[2], s0[3]); w.z = cvt_pk_bf16(s1[0], s1[1]); w.w = cvt_pk_bf16(s1[2], s1[3]);
                        acc = __builtin_amdgcn_mfma_f32_16x16x32_bf16(__builtin_bit_cast(bf16x8, w), kk ? yb1 : yb0, acc, 0, 0, 0); }
                    bf16_t* dp = yrow + (ih * 2 + q) * 16 + 4 * fq; const u32x2 o = *(const u32x2*)dp; u32x2 w;
                    w.x = cvt_pk_bf16(bflo(o.x) + acc[0], bfhi(o.x) + acc[1]); w.y = cvt_pk_bf16(bflo(o.y) + acc[2], bfhi(o.y) + acc[3]); *(u32x2*)dp = w; }
            }
            __syncthreads();
        }
        const size_t row = (size_t)tile * 64 + tok;
#pragma unroll
        for (int hq = 0; hq < 2; ++hq) {
            u32x4 ry[4], rv[4], rg[4]; float bnv[4];
#pragma unroll
            for (int q = 0; q < 4; ++q) { const int h = hq * 4 + q, hc = h * 64 + sub * 8; ry[q] = *(const u32x4*)(Z + row * ZW + BK + hc); rv[q] = *(const u32x4*)(Z + row * ZW + CV + hc); rg[q] = *(const u32x4*)(Z + row * ZW + BG + hc);
                bnv[q] = ((const float*)(P.ws + WS_BONUS))[row * 8 + h]; }
#pragma unroll
            for (int q = 0; q < 4; ++q) { const int h = hq * 4 + q, hc = h * 64 + sub * 8; float y[8], v[8], g[8], o[8];
                unpack8(ry[q], y); unpack8(rv[q], v); unpack8(rg[q], g);
                float s_ = 0.f;
#pragma unroll
                for (int e = 0; e < 8; ++e) s_ += y[e];
                const float mean = sum8(s_) * (1.f / 64.f); float q2 = 0.f;
#pragma unroll
                for (int e = 0; e < 8; ++e) { const float d = y[e] - mean; q2 += d * d; }
                const float rs = rsqrtf(sum8(q2) * (1.f / 64.f) + 64e-5f);
                const float bn = bnv[q];
                const float* lw = PIN(23) + l * 512 + hc; const float* lb = PIN(24) + l * 512 + hc;
#pragma unroll
                for (int e = 0; e < 8; ++e) o[e] = ((y[e] - mean) * rs * lw[e] + lb[e] + bn * v[e]) * g[e];
                *(u32x4*)(Z + row * ZW + CR + hc) = pack8(o); }
        }
    }
}

#define XB_TMO      128
#define XB_XCNT(j)  (256  + 64 * (j))
#define XB_XSUB(j)  (1280 + 64 * (j))
#define XB_XGEN(j)  (2304 + 64 * (j))
#define XB_TOP      3328
#define XB_TOPGEN   3392
#define XCD_BAR_WORDS 3456
#define XB_SPIN_CAP (1u << 22)
__device__ __forceinline__ unsigned xb_ld(unsigned* p)              { return __hip_atomic_load(p, __ATOMIC_RELAXED, __HIP_MEMORY_SCOPE_AGENT); }
__device__ __forceinline__ unsigned xb_add(unsigned* p, unsigned v) { return __hip_atomic_fetch_add(p, v, __ATOMIC_RELAXED, __HIP_MEMORY_SCOPE_AGENT); }
__device__ __forceinline__ unsigned xb_xcc_id() { return (unsigned)__builtin_amdgcn_s_getreg((3 << 11) | 20) & 0xFu; }
#define XB_SPIN(cond, bar) do { unsigned _sp = 0; while (cond) { __builtin_amdgcn_s_sleep(1); \
    if ((++_sp & 255u) == 0u) { if (xb_ld(&(bar)[XB_TMO])) break; if (_sp > XB_SPIN_CAP) { atomicAdd(&(bar)[XB_TMO], 1u); break; } } } } while (0)
struct XcdBarrier { unsigned* bar; unsigned x; volatile LAS unsigned* st; };
__device__ __forceinline__ XcdBarrier xcd_barrier_post(unsigned* bar, volatile LAS unsigned* st) {
    XcdBarrier b; b.bar = bar; b.x = xb_xcc_id(); b.st = st;
    if (threadIdx.x == 0) (void)xb_add(&bar[XB_XCNT(b.x)], 1u);
    return b;
}
__device__ __forceinline__ void xcd_barrier_complete(unsigned* bar, unsigned x, unsigned& nloc, unsigned& nx) {
    const unsigned G = gridDim.x * gridDim.y * gridDim.z;
    unsigned sum, cnt, mine, sp = 0u;
    for (;;) {
        sum = 0u; cnt = 0u; mine = 0u;
#pragma unroll
        for (unsigned j = 0; j < 16; ++j) { const unsigned c = xb_ld(&bar[XB_XCNT(j)]); sum += c; cnt += (c > 0u) ? 1u : 0u; mine = (j == x) ? c : mine; }
        if (sum == G) break;
        __builtin_amdgcn_s_sleep(1);
        if ((++sp & 255u) == 0u) { if (xb_ld(&bar[XB_TMO])) break; if (sp > XB_SPIN_CAP) { atomicAdd(&bar[XB_TMO], 1u); break; } }
    }
    nloc = mine > 0u ? mine : 1u; nx = cnt > 0u ? cnt : 1u;
}
__device__ __forceinline__ void xcd_barrier(const XcdBarrier& b) {
    asm volatile("s_waitcnt vmcnt(0)" ::: "memory");
    __syncthreads();
    if (threadIdx.x == 0) {
        unsigned* bar = b.bar;
        __builtin_amdgcn_s_waitcnt(0);
        unsigned nloc = b.st[0], nx = b.st[1];
        if (nloc == 0u) { xcd_barrier_complete(bar, b.x, nloc, nx); b.st[0] = nloc; b.st[1] = nx; }
        const unsigned old = xb_add(&bar[XB_XSUB(b.x)], 1u);
        const unsigned gen = old / nloc;
        if (old + 1u == (gen + 1u) * nloc) {
            __builtin_amdgcn_fence(__ATOMIC_RELEASE, "agent");
            asm volatile("s_waitcnt vmcnt(0)" ::: "memory");
            const unsigned og = xb_add(&bar[XB_TOP], 1u);
            const unsigned tg = og / nx;
            if (og + 1u == (tg + 1u) * nx) xb_add(&bar[XB_TOPGEN], 1u);
            else XB_SPIN(xb_ld(&bar[XB_TOPGEN]) == tg, bar);
            __builtin_amdgcn_fence(__ATOMIC_ACQUIRE, "agent");
            xb_add(&bar[XB_XGEN(b.x)], 1u);
            asm volatile("s_waitcnt vmcnt(0)" ::: "memory");
        } else {
            XB_SPIN(xb_ld(&bar[XB_XGEN(b.x)]) == gen, bar);
            __builtin_amdgcn_fence(__ATOMIC_ACQUIRE, "agent");
            asm volatile("s_waitcnt vmcnt(0)" ::: "memory");
        }
    }
    __syncthreads();
}

__global__ void __launch_bounds__(512, 2) mega_fwd(Params P) {
    extern __shared__ __attribute__((aligned(16))) unsigned char lds_raw[];
    LAS unsigned char* lds = (LAS unsigned char*)lds_raw;
    unsigned char* ws = P.ws;
    bf16_t* Z = (bf16_t*)(ws + WS_ZB); bf16_t* XNB = (bf16_t*)(ws + WS_XNB); bf16_t* LOB = (bf16_t*)(ws + WS_LOB); bf16_t* WT = (bf16_t*)(ws + WS_W);
    volatile LAS unsigned* bst = (volatile LAS unsigned*)(lds + 131072 + 512);
    if (threadIdx.x < 2) bst[threadIdx.x] = 0u;
    __syncthreads();
    XcdBarrier xbar = xcd_barrier_post((unsigned*)ws, bst);
    for (int ph = P.ph_lo; ph < P.ph_hi; ++ph) {
        if (ph == 0) { convert_weights(P, 0, lds); row_norm_pass(P, 0, 0); }
        else {
            const int l = (ph - 1) / NPH_LAYER, k = (ph - 1) % NPH_LAYER;
            GemmDesc g; g.sched = -1; g.lda = g.ldb = 1024; g.K = 1024; g.nM = 132; g.nN = 4; g.epi = 0; g.perm = 1; g.d0 = nullptr; g.ldc0 = 1024; g.d1 = nullptr; g.x = nullptr; g.z = Z; g.A = nullptr; g.B = nullptr; g.skip = 0; g.xs0 = nullptr; g.xs1 = nullptr;
            switch (k) {
            case 0: g.sched = 0; g.A = (const char*)XNB; g.B = (const char*)(WT + W_Z); g.nN = 21; g.d0 = Z; g.ldc0 = ZW; break;
            case 1: e1_phase(P, l, lds); break;
            case 2: p2_phase(P, l, lds); break;
            case 3: p3_phase(P, l, lds); break;
            case 4: g.sched = 0; g.A = (const char*)LOB; g.lda = 256; g.B = (const char*)(WT + W_BD); g.ldb = 256; g.K = 256; g.nN = 6; g.epi = 1; g.d0 = XNB; break;
            case 5: c2_phase(P, l, lds); break;
            case 6: scan_phase(P, l, lds); break;
            case 7: e2_phase(P, l); row_norm_pass(P, l, 1, ((int)gridDim.x >= 128 && 528 > 2 * (int)gridDim.x && 528 < 3 * (int)gridDim.x) ? 528 - 2 * (int)gridDim.x : 0); break;
            case 8: g.sched = 0; g.A = (const char*)XNB; g.B = (const char*)(WT + W_GL); g.nN = 12; g.epi = 2; g.d0 = Z; g.ldc0 = ZW; break;
            case 9: g.sched = 1; g.A = (const char*)Z; g.lda = ZW; g.B = (const char*)(WT + W_B); g.ldb = 512; g.K = 512; g.epi = 3; g.d0 = XNB; break;
            case 10: g.sched = 0; g.A = (const char*)XNB; g.B = (const char*)(WT + W_O); g.epi = 4; g.perm = 0; g.x = P.out; if (l == 0) { g.xs0 = PIN(0); g.xs1 = PIN(1); } break;
            case 11: row_norm_pass(P, l, 2); break;
            case 12: g.sched = 0; g.A = (const char*)Z; g.B = (const char*)(WT + W_GU); g.nN = 22; g.epi = 5; g.d0 = (bf16_t*)(ws + WS_H); g.ldc0 = FF; break;
            case 13: g.sched = 0; g.A = (const char*)(ws + WS_H); g.lda = FF; g.B = (const char*)(WT + W_D); g.ldb = FF; g.K = FF; g.epi = 4; g.perm = 0; g.x = P.out; g.d1 = (bf16_t*)(ws + WS_XB); break;
            case 14: g.sched = 0; g.A = (const char*)(ws + WS_XB); g.B = (const char*)(WT + W_PG); g.d0 = Z; break;
            default: finish_pass(P, l); if (l == 0) convert_weights(P, 1, lds); break;
            }
            for (int rep = 0; rep < (k == 13 ? 2 : 1); ++rep) {
                if (rep == 1) { g.A = (const char*)LOB; g.lda = 256; g.B = (const char*)(WT + W_P); g.ldb = 256; g.K = 256; g.epi = 0; g.perm = 1; g.d0 = XNB; g.ldc0 = 1024; g.d1 = nullptr; g.x = nullptr;
                    g.skip = ((int)gridDim.x >= 128 && 528 > 2 * (int)gridDim.x && 528 < 3 * (int)gridDim.x) ? 528 - 2 * (int)gridDim.x : 0; }
                if (g.sched >= 0) gemm_phase(lds, g);
            }
#ifdef DBG_REP_MASK
            if ((DBG_REP_MASK >> k) & 1) { cg::this_grid().sync(); if (g.sched >= 0) gemm_phase(lds, g); else if (k == 6) scan_phase(P, l, lds); else if (k == 2) p2_phase(P, l, lds); }
#endif
        }
        if (ph + 1 < P.ph_hi) { if (P.ph_hi < 0) cg::this_grid().sync(); else xcd_barrier(xbar); }
#ifdef DBG_EXTRA_SYNC
        if (ph + 1 < P.ph_hi) { cg::this_grid().sync(); cg::this_grid().sync(); }
#endif
    }
#ifdef DBG_DUMP_Z
    cg::this_grid().sync();
    for (size_t e = (size_t)blockIdx.x * 512 + threadIdx.x; e < (size_t)T_ALL * 512; e += (size_t)gridDim.x * 512) {
        const size_t r = e >> 9; const int c = (int)(e & 511);
        P.out[e] = bf2f(XNB[e]); (void)r; (void)c;
    }
#endif
}

extern "C" void kernel_launch(void* const* d_in, const int* in_sizes, int n_in, void* d_out, int out_size, void* d_ws, size_t ws_size, hipStream_t stream) {
    static int grid = 0;
    if (grid == 0) {
        if (n_in != 34 || out_size != 45603840 || ws_size < WS_END2) { fprintf(stderr, "kernel_launch: unexpected shapes n_in %d out %d ws %zu\n", n_in, out_size, ws_size); grid = -1; return; }
        int dev = 0, cus = 0, per_cu = 0;
        hipGetDevice(&dev); hipDeviceGetAttribute(&cus, hipDeviceAttributeMultiprocessorCount, dev);
        hipFuncSetAttribute((const void*)mega_fwd, hipFuncAttributeMaxDynamicSharedMemorySize, LDS_BYTES);
        hipOccupancyMaxActiveBlocksPerMultiprocessor(&per_cu, (const void*)mega_fwd, 512, LDS_BYTES);
        if (per_cu < 1) { fprintf(stderr, "kernel_launch: occupancy query says %d blocks per CU\n", per_cu); per_cu = 1; }
        (void)hipGetLastError();
        grid = cus * per_cu;
        fprintf(stderr, "kernel_launch: grid %d (cus %d x %d)\n", grid, cus, per_cu);
    }
    if (grid < 0) return;
#ifdef DBG_POISON
    (void)hipMemsetAsync(d_ws, 0xFF, WS_END, stream);
#endif
    (void)hipMemsetAsync(d_ws, 0, 16384, stream);
    Params p{};
    for (int i = 0; i < 34; ++i) p.in[i] = (const float*)d_in[i];
    p.out = (float*)d_out; p.ws = (unsigned char*)d_ws;
#if MK_PER_PHASE
    for (int ph = 0; ph < NPHASES; ++ph) { p.ph_lo = ph; p.ph_hi = ph + 1; hipLaunchKernelGGL(mega_fwd, dim3(grid), dim3(512), LDS_BYTES, stream, p); }
#else
#ifdef DBG_PH_HI
    p.ph_lo = 0; p.ph_hi = DBG_PH_HI;
#else
    p.ph_lo = 0; p.ph_hi = NPHASES;
#endif
    void* args[] = {&p};
    hipError_t e = hipLaunchCooperativeKernel((const void*)mega_fwd, dim3(grid), dim3(512), args, LDS_BYTES, stream);
    if (e != hipSuccess) fprintf(stderr, "cooperative launch failed: %s (grid %d)\n", hipGetErrorString(e), grid);
#endif
}
```
